# Optimizing an MI355X kernel written in HIP

```python
import math
import jax
import jax.numpy as jnp
from jax import lax
import numpy as np

D_MODEL = 1024
BATCH = 4
SEQ = 4096
DEPTH = 4

MOBA_HEADS = 8
MOBA_HEAD_DIM = 64
MOBA_BLOCK = 256
MOBA_TOPK = 3
MOBA_Q_CHUNK = 64
RG_WIDTH = D_MODEL
RG_BLOCKS = 16
RG_BLOCK_DIM = RG_WIDTH // RG_BLOCKS
RG_CONV = 4
RG_C = 8.0
RG_A_MIN = 0.9
RG_A_MAX = 0.999
DIFF_HEADS = 4
DIFF_HEAD_DIM = 64
DIFF_Q_BLOCK = 128
D_FF = 2816
FFN_CONV = 3
N_BRANCHES = 3
RMS_EPS = 1e-6

MOBA_WIDTH = MOBA_HEADS * MOBA_HEAD_DIM
DIFF_QK_WIDTH = DIFF_HEADS * 2 * DIFF_HEAD_DIM
DIFF_V_WIDTH = DIFF_HEADS * 2 * DIFF_HEAD_DIM
IN_WIDTHS = (MOBA_WIDTH, MOBA_WIDTH, MOBA_WIDTH, DIFF_QK_WIDTH, DIFF_QK_WIDTH, DIFF_V_WIDTH, RG_WIDTH, RG_WIDTH, N_BRANCHES * D_MODEL)
IN_COLS = sum(IN_WIDTHS)

kernel_name = 'hybrid_moba_rglru_diffattn_convffn'


def rms_norm(x, g):
    xf = x.astype(jnp.float32)
    y = xf * lax.rsqrt(jnp.mean(xf * xf, axis=-1, keepdims=True) + RMS_EPS)
    return (y * g.astype(jnp.float32)).astype(x.dtype)


def alibi_slopes(n):
    return 2.0 ** (-8.0 * jnp.arange(1, n + 1, dtype=jnp.float32) / n)


def causal_dwconv(x, w, b):
    k_w = w.shape[0]
    s = x.shape[1]
    xp = jnp.pad(x, ((0, 0), (k_w - 1, 0), (0, 0)))
    y = b
    for j in range(k_w):
        y = y + w[j] * xp[:, j:j + s]
    return y


def split_offsets():
    return np.cumsum(np.array(IN_WIDTHS[:-1])).tolist()


def moba_attention(q, k, v):
    B, S, H, D = q.shape
    nb = -(-S // MOBA_BLOCK)
    s_pad = nb * MOBA_BLOCK
    pad = ((0, 0), (0, s_pad - S), (0, 0), (0, 0))
    q, k, v = [jnp.pad(t, pad).transpose(0, 2, 1, 3) for t in (q, k, v)]
    kb = k.reshape(B, H, nb, MOBA_BLOCK, D)
    vb = v.reshape(B, H, nb, MOBA_BLOCK, D)
    slopes = alibi_slopes(H)[None, :, None, None]
    scale = D ** -0.5
    kmean = jnp.mean(kb.astype(jnp.float32), axis=3)
    gate = jnp.einsum('bhsd,bhnd->bhsn', q.astype(jnp.float32), kmean)
    q_blk = jnp.arange(s_pad) // MOBA_BLOCK
    past = jnp.arange(nb)[None, :] < q_blk[:, None]
    gate = jnp.where(past, gate, -jnp.inf)
    n_sel = min(MOBA_TOPK, nb)
    _, sel = lax.top_k(gate, n_sel)
    bi = jnp.arange(B)[:, None, None, None]
    hi = jnp.arange(H)[None, :, None, None]
    n_chunks = s_pad // MOBA_Q_CHUNK

    def chunk(c):
        q0 = c * MOBA_Q_CHUNK
        blk = q0 // MOBA_BLOCK
        qc = lax.dynamic_slice_in_dim(q, q0, MOBA_Q_CHUNK, axis=2)
        selc = lax.dynamic_slice_in_dim(sel, q0, MOBA_Q_CHUNK, axis=2)
        qpos = q0 + jnp.arange(MOBA_Q_CHUNK)
        k_own = lax.dynamic_index_in_dim(kb, blk, axis=2, keepdims=False)
        v_own = lax.dynamic_index_in_dim(vb, blk, axis=2, keepdims=False)
        kpos_own = blk * MOBA_BLOCK + jnp.arange(MOBA_BLOCK)
        dist_own = (qpos[:, None] - kpos_own[None, :]).astype(jnp.float32)
        l_own = jnp.einsum('bhqd,bhkd->bhqk', qc, k_own).astype(jnp.float32) * scale - slopes * dist_own
        l_own = jnp.where(dist_own >= 0, l_own, -jnp.inf)
        k_sel = kb[bi, hi, selc]
        v_sel = vb[bi, hi, selc]
        kpos_sel = selc[..., None] * MOBA_BLOCK + jnp.arange(MOBA_BLOCK)
        dist_sel = (qpos[None, None, :, None, None] - kpos_sel).astype(jnp.float32)
        l_sel = jnp.einsum('bhqd,bhqnkd->bhqnk', qc, k_sel).astype(jnp.float32) * scale - slopes[..., None] * dist_sel
        valid = (selc < blk)[..., None]
        l_sel = jnp.where(valid, l_sel, -jnp.inf)
        n_keys = n_sel * MOBA_BLOCK
        logits = jnp.concatenate([l_sel.reshape(B, H, MOBA_Q_CHUNK, n_keys), l_own], axis=-1)
        p = jax.nn.softmax(logits, axis=-1).astype(v.dtype)
        p_sel = p[..., :n_keys].reshape(B, H, MOBA_Q_CHUNK, n_sel, MOBA_BLOCK)
        p_own = p[..., n_keys:]
        return (jnp.einsum('bhqnk,bhqnkd->bhqd', p_sel, v_sel)
                + jnp.einsum('bhqk,bhkd->bhqd', p_own, v_own))

    out = lax.map(chunk, jnp.arange(n_chunks))
    out = out.transpose(1, 0, 3, 2, 4).reshape(B, s_pad, H, D)
    return out[:, :S]


def diff_attention(q, k, v, lam, lam_init, subln_g):
    B, S, H, _, Dh = q.shape
    q = q.transpose(0, 2, 3, 1, 4)
    k = k.transpose(0, 2, 3, 1, 4)
    v = v.transpose(0, 2, 1, 3)
    slopes = alibi_slopes(H)[None, :, None, None, None]
    scale = Dh ** -0.5
    kpos = jnp.arange(S)
    n_blocks = S // DIFF_Q_BLOCK

    def block(c):
        q0 = c * DIFF_Q_BLOCK
        qc = lax.dynamic_slice_in_dim(q, q0, DIFF_Q_BLOCK, axis=3)
        qpos = q0 + jnp.arange(DIFF_Q_BLOCK)
        dist = (qpos[:, None] - kpos[None, :]).astype(jnp.float32)
        logits = jnp.einsum('bhmqd,bhmkd->bhmqk', qc, k).astype(jnp.float32) * scale - slopes * dist
        logits = jnp.where(dist >= 0, logits, -jnp.inf)
        p = jax.nn.softmax(logits, axis=-1)
        w = p[:, :, 0] - lam * p[:, :, 1]
        return jnp.einsum('bhqk,bhkd->bhqd', w.astype(v.dtype), v)

    out = lax.map(block, jnp.arange(n_blocks))
    out = out.transpose(1, 0, 3, 2, 4).reshape(B, S, H, 2 * Dh)
    out = rms_norm(out, subln_g) * (1.0 - lam_init)
    return out.reshape(B, S, H * 2 * Dh)


def rg_lru(x, w_a, b_a, w_x, b_x, lam):
    B, S, C = x.shape
    xb = x.reshape(B, S, RG_BLOCKS, RG_BLOCK_DIM)
    r = jax.nn.sigmoid(jnp.einsum('bsnc,ncd->bsnd', xb, w_a).reshape(B, S, C) + b_a)
    i = jax.nn.sigmoid(jnp.einsum('bsnc,ncd->bsnd', xb, w_x).reshape(B, S, C) + b_x)
    log_a = -RG_C * r.astype(jnp.float32) * jax.nn.softplus(-lam.astype(jnp.float32))
    a = jnp.exp(log_a)
    mult = jnp.sqrt(-jnp.expm1(2.0 * log_a))
    b = mult * (i * x).astype(jnp.float32)

    def combine(left, right):
        a1, b1 = left
        a2, b2 = right
        return a1 * a2, a2 * b1 + b2

    _, h = lax.associative_scan(combine, (a, b), axis=1)
    return h.astype(x.dtype)


def setup_inputs(seed: int = 0) -> dict:
    key = jax.random.key(seed)
    ks = jax.random.split(key, 26)
    f32 = jnp.float32
    L = DEPTH

    def nrm(k, shape, scale):
        return jax.random.normal(k, shape, f32) * scale

    def gain(k, shape):
        return 1.0 + nrm(k, shape, 0.01)

    a_c = jax.random.uniform(ks[10], (L, RG_WIDTH), f32, RG_A_MIN, RG_A_MAX)
    a0 = a_c ** (1.0 / RG_C)
    return {
        'x': nrm(ks[0], (BATCH, SEQ, D_MODEL), 1.0),
        'norm_mix_g': gain(ks[1], (L, D_MODEL)),
        'w_in': nrm(ks[2], (L, D_MODEL, IN_COLS), D_MODEL ** -0.5),
        'b_gate': nrm(ks[3], (L, N_BRANCHES * D_MODEL), 0.01),
        'rg_conv_w': nrm(ks[4], (L, RG_CONV, RG_WIDTH), RG_CONV ** -0.5),
        'rg_conv_b': nrm(ks[5], (L, RG_WIDTH), 0.01),
        'rg_w_a': nrm(ks[6], (L, RG_BLOCKS, RG_BLOCK_DIM, RG_BLOCK_DIM), RG_BLOCK_DIM ** -0.5),
        'rg_b_a': nrm(ks[7], (L, RG_WIDTH), 0.01),
        'rg_w_x': nrm(ks[8], (L, RG_BLOCKS, RG_BLOCK_DIM, RG_BLOCK_DIM), RG_BLOCK_DIM ** -0.5),
        'rg_b_x': nrm(ks[9], (L, RG_WIDTH), 0.01),
        'rg_lambda': jnp.log(a0) - jnp.log1p(-a0),
        'diff_lq1': nrm(ks[11], (L, DIFF_HEAD_DIM), 0.1),
        'diff_lk1': nrm(ks[12], (L, DIFF_HEAD_DIM), 0.1),
        'diff_lq2': nrm(ks[13], (L, DIFF_HEAD_DIM), 0.1),
        'diff_lk2': nrm(ks[14], (L, DIFF_HEAD_DIM), 0.1),
        'diff_subln_g': gain(ks[15], (L, 2 * DIFF_HEAD_DIM)),
        'w_branch_a': nrm(ks[16], (L, MOBA_WIDTH, D_MODEL), MOBA_WIDTH ** -0.5),
        'w_branch_b': nrm(ks[17], (L, RG_WIDTH, D_MODEL), RG_WIDTH ** -0.5),
        'w_branch_c': nrm(ks[18], (L, DIFF_V_WIDTH, D_MODEL), DIFF_V_WIDTH ** -0.5),
        'w_out': nrm(ks[19], (L, D_MODEL, D_MODEL), D_MODEL ** -0.5),
        'norm_ffn_g': gain(ks[20], (L, D_MODEL)),
        'ffn_up': nrm(ks[21], (L, D_MODEL, 2 * D_FF), D_MODEL ** -0.5),
        'ffn_conv_w': nrm(ks[22], (L, FFN_CONV, 2 * D_FF), FFN_CONV ** -0.5),
        'ffn_conv_b': nrm(ks[23], (L, 2 * D_FF), 0.01),
        'ffn_down': nrm(ks[24], (L, D_FF, D_MODEL), D_FF ** -0.5),
        'final_norm_g': gain(ks[25], (D_MODEL,)),
    }


def reference(x, norm_mix_g, w_in, b_gate, rg_conv_w, rg_conv_b, rg_w_a, rg_b_a, rg_w_x, rg_b_x,
              rg_lambda, diff_lq1, diff_lk1, diff_lq2, diff_lk2, diff_subln_g, w_branch_a, w_branch_b,
              w_branch_c, w_out, norm_ffn_g, ffn_up, ffn_conv_w, ffn_conv_b, ffn_down, final_norm_g):
    B, S = x.shape[0], x.shape[1]
    offs = split_offsets()
    for l in range(DEPTH):
        h = rms_norm(x, norm_mix_g[l])
        proj = h @ w_in[l]
        qa, ka, va, qc, kc, vc, rx, rgate, gates = jnp.split(proj, offs, axis=-1)
        ya = moba_attention(qa.reshape(B, S, MOBA_HEADS, MOBA_HEAD_DIM),
                            ka.reshape(B, S, MOBA_HEADS, MOBA_HEAD_DIM),
                            va.reshape(B, S, MOBA_HEADS, MOBA_HEAD_DIM)).reshape(B, S, MOBA_WIDTH)
        xr = causal_dwconv(rx, rg_conv_w[l], rg_conv_b[l])
        yb = rg_lru(xr, rg_w_a[l], rg_b_a[l], rg_w_x[l], rg_b_x[l], rg_lambda[l]) * jax.nn.gelu(rgate)
        lam_init = 0.8 - 0.6 * math.exp(-0.3 * l)
        lam = (jnp.exp(jnp.sum(diff_lq1[l].astype(jnp.float32) * diff_lk1[l].astype(jnp.float32)))
               - jnp.exp(jnp.sum(diff_lq2[l].astype(jnp.float32) * diff_lk2[l].astype(jnp.float32)))
               + lam_init)
        yc = diff_attention(qc.reshape(B, S, DIFF_HEADS, 2, DIFF_HEAD_DIM),
                            kc.reshape(B, S, DIFF_HEADS, 2, DIFF_HEAD_DIM),
                            vc.reshape(B, S, DIFF_HEADS, 2 * DIFF_HEAD_DIM),
                            lam, lam_init, diff_subln_g[l])
        g = jax.nn.sigmoid(gates + b_gate[l]).reshape(B, S, N_BRANCHES, D_MODEL)
        merged = (g[:, :, 0] * (ya @ w_branch_a[l])
                  + g[:, :, 1] * (yb @ w_branch_b[l])
                  + g[:, :, 2] * (yc @ w_branch_c[l]))
        x = x + merged @ w_out[l]
        h = rms_norm(x, norm_ffn_g[l])
        u = causal_dwconv(h @ ffn_up[l], ffn_conv_w[l], ffn_conv_b[l])
        u_gate, u_val = jnp.split(u, 2, axis=-1)
        x = x + (jax.nn.gelu(u_gate) * u_val) @ ffn_down[l]
    return rms_norm(x, final_norm_g)
```

```cpp
#include <hip/hip_runtime.h>
#include <cstdio>
#include <cstdint>
namespace pg8 {
#define PG8_LAS __attribute__((address_space(3)))
typedef unsigned short bf16_t;
typedef short bf16x8 __attribute__((ext_vector_type(8)));
typedef float f32x4 __attribute__((ext_vector_type(4)));
typedef unsigned u32x4 __attribute__((ext_vector_type(4)));
constexpr int BM = 256, BK = 64, HALF = 128, HTB = HALF * BK * 2  , STAGE_BYTES = 8 * HTB, NXCD = 8, WGM = 8;

__host__ __device__ __forceinline__ int lds_byte(int r, int c) { const int st = (r >> 4) * 2 + (c >> 5), rr = r & 15, cc = c & 31, ob = rr * 64 + cc * 2; return st * 1024 + (ob ^ (((ob >> 9) & 1) << 5)); }
__host__ __device__ __forceinline__ void stage_rc(int b, int& R, int& C) { const int st = b / 1024, sb = b % 1024, swz = sb ^ (((sb >> 9) & 1) << 5); R = (st >> 1) * 16 + swz / 64; C = (st & 1) * 32 + (swz % 64) / 2; }
__host__ __device__ __forceinline__ int perm32(int rho) { const int n = rho >> 4, i = rho & 15; return 8 * (i >> 2) + 4 * n + (i & 3); }

struct Unit { int pm, pn; };
struct Gemm { const bf16_t* A; const bf16_t* Bt; int M, N, K; };

struct StaticOrder {
    int nM, nN, nwg, G, c;
    __host__ __device__ void init(int M, int N, int G_, int c_) { nM = M / BM; nN = N / BM; nwg = nM * nN; G = G_; c = c_; }
    __host__ __device__ bool next(int i, Unit& u) const {
        const long L = (long)i * G + c; if (L >= nwg) return false;
        int wgid = (int)L; { const int q = nwg / NXCD, r = nwg % NXCD, xcd = wgid % NXCD, off = wgid / NXCD; wgid = (xcd < r ? xcd * (q + 1) : r * (q + 1) + (xcd - r) * q) + off; }
        const int nig = WGM * nN, gid = wgid / nig, fm = gid * WGM, gsz = (nM - fm) < WGM ? (nM - fm) : WGM;
        u.pm = fm + ((wgid % nig) % gsz); u.pn = (wgid % nig) / gsz; return true;
    }
    __device__ __forceinline__ void a_ready(const Unit&) const {}
    __device__ __forceinline__ void done(const Unit&) const {}
};

__device__ __forceinline__ unsigned cvt_pk_bf16(float lo, float hi) { unsigned r; asm volatile("v_cvt_pk_bf16_f32 %0, %1, %2" : "=v"(r) : "v"(lo), "v"(hi)); return r; }
typedef float f32x2 __attribute__((ext_vector_type(2)));
__device__ __forceinline__ f32x2 gelu_pk(f32x2 v) {
    const f32x2 av = __builtin_elementwise_abs(v), d = av * 0.2316418882f + 1.0f;
    f32x2 t; t.x = __builtin_amdgcn_rcpf(d.x); t.y = __builtin_amdgcn_rcpf(d.y);
    f32x2 q = t * 0.5307027145f + (-0.7265760135f); q = q * t + 0.7107068705f; q = q * t + (-0.142248368f); q = q * t + 0.127414796f; q = q * t;
    const f32x2 s = (v * v) * (-0.72134752044f);
    f32x2 e; e.x = __builtin_amdgcn_exp2f(s.x); e.y = __builtin_amdgcn_exp2f(s.y);
    const f32x2 m = v * (q * e), r = v - m;
    f32x2 o; o.x = v.x < 0.f ? m.x : r.x; o.y = v.y < 0.f ? m.y : r.y; return o;
}

constexpr float RMS_EPS_F = 1e-6f, LOG2E_F = 1.4426950408889634f;
constexpr float QSCALE = 0.125f * 1.4426950408889634f;
__device__ __forceinline__ float gelu_tanh_f(float x) {
    const float z = x * (1.0f + 0.044715f * x * x);
    const float e = __builtin_amdgcn_exp2f(z * (-2.0f * 0.7978845608028654f * LOG2E_F));
    return x * __builtin_amdgcn_rcpf(1.0f + e);
}
__device__ __forceinline__ float sigmoid_f(float x) { return __builtin_amdgcn_rcpf(1.0f + __builtin_amdgcn_exp2f(-x * LOG2E_F)); }
__device__ __forceinline__ float row_rs(const float* ssp, int row) {
    const f32x4* sp = (const f32x4*)(ssp + (size_t)row * 16);
    const f32x4 a = (sp[0] + sp[1]) + (sp[2] + sp[3]);
    return rsqrtf(((a[0] + a[1]) + (a[2] + a[3])) * (1.0f / 1024.0f) + RMS_EPS_F);
}
__device__ __forceinline__ void rs_table_update(PG8_LAS float* tab, const float* ssp, int pm) {
    const int tag = ((volatile PG8_LAS int*)tab)[256];
    if (tag != pm + 1) {
        asm volatile("s_waitcnt lgkmcnt(0)" ::: "memory"); __builtin_amdgcn_s_barrier(); asm volatile("" ::: "memory");
        if (threadIdx.x < 256) tab[threadIdx.x] = row_rs(ssp, pm * BM + (int)threadIdx.x);
        if (threadIdx.x == 0) ((volatile PG8_LAS int*)tab)[256] = pm + 1;
        asm volatile("s_waitcnt vmcnt(0) lgkmcnt(0)" ::: "memory"); __builtin_amdgcn_s_barrier(); asm volatile("" ::: "memory");
    }
}
struct EpiInProj {
    static constexpr bool PERM = true, AFTER_DRAIN = false;
    bf16_t *QA, *KA, *VA, *QC, *KC, *VC, *RX, *RG, *GT; const float* ssp; const float* bgate; PG8_LAS float* tab;
    __device__ __forceinline__ void operator()(const f32x4 (&acc)[2][2][4][2], const Unit& u, int wr, int wc, int fr, int fq) const {
        rs_table_update(tab, ssp, u.pm);
        const int pn = u.pn;
        bf16_t* base; int ldc, colt, mode;
        if (pn < 12) { const int seg = pn >> 1; base = seg == 0 ? QA : seg == 1 ? KA : seg == 2 ? VA : seg == 3 ? QC : seg == 4 ? KC : VC; ldc = 512; colt = (pn & 1) * 256; mode = (seg == 0 || seg == 3) ? 1 : 0; }
        else if (pn < 16) { base = RX; ldc = 1024; colt = (pn - 12) * 256; mode = 0; }
        else if (pn < 20) { base = RG; ldc = 1024; colt = (pn - 16) * 256; mode = 2; }
        else { base = GT; ldc = 3072; colt = (pn - 20) * 256; mode = 3; }
        const int row0 = u.pm * BM + wr * 64 + fr, col0 = colt + wc * 32 + 8 * fq;
        f32x4 bv[2][2];
#pragma unroll
        for (int bj = 0; bj < 2; ++bj)
#pragma unroll
            for (int n = 0; n < 2; ++n) bv[bj][n] = (mode == 3) ? *(const f32x4*)(bgate + col0 + bj * HALF + 4 * n) : (f32x4){0.f, 0.f, 0.f, 0.f};
        const float sc = (mode == 1) ? QSCALE : 1.0f;
#pragma unroll
        for (int ai = 0; ai < 2; ++ai)
#pragma unroll
            for (int m = 0; m < 4; ++m) { const int row = row0 + ai * HALF + m * 16; const float rs = tab[ai * HALF + wr * 64 + m * 16 + fr] * sc; bf16_t* rowp = base + (size_t)row * ldc + col0;
#pragma unroll
                for (int bj = 0; bj < 2; ++bj) { f32x4 v0 = acc[ai][bj][m][0] * rs, v1 = acc[ai][bj][m][1] * rs;
                    if (mode == 2) {
#pragma unroll
                        for (int e = 0; e < 4; ++e) { v0[e] = gelu_tanh_f(v0[e]); v1[e] = gelu_tanh_f(v1[e]); } }
                    if (mode == 3) { v0 = v0 + bv[bj][0]; v1 = v1 + bv[bj][1];
#pragma unroll
                        for (int e = 0; e < 4; ++e) { v0[e] = sigmoid_f(v0[e]); v1[e] = sigmoid_f(v1[e]); } }
                    u32x4 w; w.x = cvt_pk_bf16(v0[0], v0[1]); w.y = cvt_pk_bf16(v0[2], v0[3]); w.z = cvt_pk_bf16(v1[0], v1[1]); w.w = cvt_pk_bf16(v1[2], v1[3]);
                    *(u32x4*)(rowp + bj * HALF) = w; } }
    }
};
struct EpiUp {
    static constexpr bool PERM = true, AFTER_DRAIN = false;
    bf16_t* U; int ldc; const float* ssp; PG8_LAS float* tab;
    __device__ __forceinline__ void operator()(const f32x4 (&acc)[2][2][4][2], const Unit& u, int wr, int wc, int fr, int fq) const {
        rs_table_update(tab, ssp, u.pm);
        const int row0 = u.pm * BM + wr * 64 + fr, col0 = u.pn * BM + wc * 32 + 8 * fq;
#pragma unroll
        for (int ai = 0; ai < 2; ++ai)
#pragma unroll
            for (int m = 0; m < 4; ++m) { const int row = row0 + ai * HALF + m * 16; const float rs = tab[ai * HALF + wr * 64 + m * 16 + fr]; bf16_t* rowp = U + (size_t)row * ldc + col0;
#pragma unroll
                for (int bj = 0; bj < 2; ++bj) { const f32x4 v0 = acc[ai][bj][m][0] * rs, v1 = acc[ai][bj][m][1] * rs;
                    u32x4 w; w.x = cvt_pk_bf16(v0[0], v0[1]); w.y = cvt_pk_bf16(v0[2], v0[3]); w.z = cvt_pk_bf16(v1[0], v1[1]); w.w = cvt_pk_bf16(v1[2], v1[3]);
                    *(u32x4*)(rowp + bj * HALF) = w; } }
    }
};
__device__ __forceinline__ float bf_lo(unsigned w) { return __uint_as_float(w << 16); }
__device__ __forceinline__ float bf_hi(unsigned w) { return __uint_as_float(w & 0xffff0000u); }
template <bool FIRST> struct EpiBranch {
    static constexpr bool PERM = true, AFTER_DRAIN = false;
    bf16_t* MG; const bf16_t* GT; int gcol;
    __device__ __forceinline__ void operator()(const f32x4 (&acc)[2][2][4][2], const Unit& u, int wr, int wc, int fr, int fq) const {
        const int row0 = u.pm * BM + wr * 64 + fr, col0 = u.pn * BM + wc * 32 + 8 * fq;
#pragma unroll
        for (int ai = 0; ai < 2; ++ai)
#pragma unroll
            for (int m = 0; m < 4; ++m) { const int row = row0 + ai * HALF + m * 16; bf16_t* rowp = MG + (size_t)row * 1024 + col0; const bf16_t* gp = GT + (size_t)row * 3072 + gcol + col0;
#pragma unroll
                for (int bj = 0; bj < 2; ++bj) { const u32x4 g = *(const u32x4*)(gp + bj * HALF); const f32x4 a0 = acc[ai][bj][m][0], a1 = acc[ai][bj][m][1];
                    f32x4 v0, v1;
                    v0[0] = bf_lo(g.x) * a0[0]; v0[1] = bf_hi(g.x) * a0[1]; v0[2] = bf_lo(g.y) * a0[2]; v0[3] = bf_hi(g.y) * a0[3];
                    v1[0] = bf_lo(g.z) * a1[0]; v1[1] = bf_hi(g.z) * a1[1]; v1[2] = bf_lo(g.w) * a1[2]; v1[3] = bf_hi(g.w) * a1[3];
                    if (!FIRST) { const u32x4 p = *(const u32x4*)(rowp + bj * HALF);
                        v0[0] += bf_lo(p.x); v0[1] += bf_hi(p.x); v0[2] += bf_lo(p.y); v0[3] += bf_hi(p.y); v1[0] += bf_lo(p.z); v1[1] += bf_hi(p.z); v1[2] += bf_lo(p.w); v1[3] += bf_hi(p.w); }
                    u32x4 w; w.x = cvt_pk_bf16(v0[0], v0[1]); w.y = cvt_pk_bf16(v0[2], v0[3]); w.z = cvt_pk_bf16(v1[0], v1[1]); w.w = cvt_pk_bf16(v1[2], v1[3]);
                    *(u32x4*)(rowp + bj * HALF) = w; }
                asm volatile("" ::: "memory"); }
    }
};
struct EpiResid {
    static constexpr bool PERM = false, AFTER_DRAIN = false;
    const float* base; float* out; bf16_t* xb; float* ssp;
    __device__ __forceinline__ void operator()(const f32x4 (&acc)[2][2][4][2], const Unit& u, int wr, int wc, int fr, int fq) const {
        typedef unsigned u32x2v __attribute__((ext_vector_type(2)));
        const int row0 = u.pm * BM + wr * 64 + fr, col0 = u.pn * BM + wc * 32 + 4 * fq;
#pragma unroll
        for (int ai = 0; ai < 2; ++ai)
#pragma unroll
            for (int m = 0; m < 4; ++m) { const int row = row0 + ai * HALF + m * 16; const size_t off = (size_t)row * 1024 + col0; float s = 0.f;
#pragma unroll
                for (int bj = 0; bj < 2; ++bj)
#pragma unroll
                    for (int n = 0; n < 2; ++n) { const f32x4 bs = *(const f32x4*)(base + off + bj * HALF + n * 16); const f32x4 o = bs + acc[ai][bj][m][n];
                        *(f32x4*)(out + off + bj * HALF + n * 16) = o; s += (o[0] * o[0] + o[1] * o[1]) + (o[2] * o[2] + o[3] * o[3]);
                        u32x2v w; w.x = cvt_pk_bf16(o[0], o[1]); w.y = cvt_pk_bf16(o[2], o[3]); *(u32x2v*)(xb + off + bj * HALF + n * 16) = w; }
                s += __shfl_xor(s, 16); s += __shfl_xor(s, 32);
                if (fq == 0) ssp[(size_t)row * 16 + u.pn * 4 + wc] = s;
                asm volatile("" ::: "memory"); }
    }
};
template <class Epi, class Sched, bool ALIGN_EPI = false, bool SP2 = false>
__device__ __forceinline__ void gemm_phase(PG8_LAS unsigned char* lds, const Gemm g, const Sched& S, const Epi& E) {
    int tid_ = threadIdx.x; asm volatile("" : "+v"(tid_));
    const int tid = tid_, wid = __builtin_amdgcn_readfirstlane(tid >> 6), lane = tid & 63, wr = wid >> 2, wc = wid & 3, fr = lane & 15, fq = lane >> 4;
    const int K = g.K, nt = K / BK;
    unsigned voffA[2], voffB[2];
#pragma unroll
    for (int i = 0; i < 2; ++i) { int R, C; stage_rc(tid * 16 + i * 8192, R, C); const int Rb = Epi::PERM ? ((R & ~31) + perm32(R & 31)) : R;
        voffA[i] = (unsigned)(R * K + C) * 2u; voffB[i] = (unsigned)(Rb * K + C) * 2u; }
    const size_t kstep = (size_t)(BK * 2);
    const size_t hstep = (size_t)HALF * K * 2;
    const size_t tstep = 2 * hstep;
    const unsigned ldsw = (unsigned)wid * 1024u;
    const int aoff = lds_byte(wr * 64 + fr, fq * 8), boff = lds_byte(wc * 32 + fr, fq * 8);
#define PG8_SA(b, h) (((b) * 2 + (h)) * HTB)
#define PG8_SB(b, h) ((4 + (b) * 2 + (h)) * HTB)
#define PG8_STAGE(bufoff, gbase, voff) do { _Pragma("unroll") for (int _i = 0; _i < 2; ++_i) \
        __builtin_amdgcn_global_load_lds((const unsigned*)((const char*)(gbase) + (voff)[_i]), (PG8_LAS unsigned*)(lds + (bufoff) + ldsw + _i * 8192), 16, 0, 0); } while (0)
#define PG8_LDA(dst, b, h) do { _Pragma("unroll") for (int m = 0; m < 4; ++m) _Pragma("unroll") for (int k = 0; k < 2; ++k) dst[m][k] = *(const PG8_LAS bf16x8*)(lds + PG8_SA(b, h) + aoff + m * 2048 + k * 1024); } while (0)
#define PG8_LDB(dst, b, h) do { _Pragma("unroll") for (int n = 0; n < 2; ++n) _Pragma("unroll") for (int k = 0; k < 2; ++k) dst[n][k] = *(const PG8_LAS bf16x8*)(lds + PG8_SB(b, h) + boff + n * 2048 + k * 1024); } while (0)
#define PG8_MMA(ai, bj, At, Bt) do { __builtin_amdgcn_s_setprio(1); _Pragma("unroll") for (int m = 0; m < 4; ++m) _Pragma("unroll") for (int n = 0; n < 2; ++n) _Pragma("unroll") for (int k = 0; k < 2; ++k) \
        acc[ai][bj][m][n] = __builtin_amdgcn_mfma_f32_16x16x32_bf16(Bt[n][k], At[m][k], acc[ai][bj][m][n], 0, 0, 0); __builtin_amdgcn_s_setprio(0); } while (0)
#define PG8_WAIT_V(n) asm volatile("s_waitcnt vmcnt(" #n ")" ::: "memory")
#define PG8_WAIT_L(n) asm volatile("s_waitcnt lgkmcnt(" #n ")" ::: "memory")
#define PG8_BAR __builtin_amdgcn_s_barrier()
#define PG8_SCHED __builtin_amdgcn_sched_barrier(0)
    Unit cur, nxt; int ui = 0;
    if (!S.next(0, cur)) return;
    f32x4 acc[2][2][4][2];
#pragma unroll
    for (int a = 0; a < 2; ++a)
#pragma unroll
        for (int b = 0; b < 2; ++b)
#pragma unroll
            for (int m = 0; m < 4; ++m)
#pragma unroll
                for (int n = 0; n < 2; ++n) acc[a][b][m][n] = (f32x4){0.f, 0.f, 0.f, 0.f};
    bf16x8 At[4][2], B0[2][2], B1[2][2];
    const char* cA = (const char*)g.A + (size_t)cur.pm * tstep; const char* cB = (const char*)g.Bt + (size_t)cur.pn * tstep;
    S.a_ready(cur);
    if constexpr (SP2) {
        PG8_STAGE(PG8_SB(0, 0), cB, voffB); PG8_STAGE(PG8_SB(0, 1), cB + hstep, voffB); PG8_STAGE(PG8_SA(0, 0), cA, voffA); PG8_STAGE(PG8_SA(0, 1), cA + hstep, voffA);
        if (wr == 1) PG8_BAR;
        PG8_WAIT_V(2); PG8_BAR;
        PG8_STAGE(PG8_SB(1, 0), cB + kstep, voffB); PG8_STAGE(PG8_SA(1, 0), cA + kstep, voffA); PG8_STAGE(PG8_SB(1, 1), cB + hstep + kstep, voffB);
        PG8_WAIT_V(6); PG8_BAR;
    } else {
        PG8_STAGE(PG8_SB(0, 0), cB, voffB); PG8_STAGE(PG8_SA(0, 0), cA, voffA); PG8_STAGE(PG8_SB(0, 1), cB + hstep, voffB); PG8_STAGE(PG8_SA(0, 1), cA + hstep, voffA);
        if (wr == 1) PG8_BAR;
        PG8_WAIT_V(4); PG8_BAR;
        PG8_STAGE(PG8_SB(1, 0), cB + kstep, voffB); PG8_STAGE(PG8_SA(1, 0), cA + kstep, voffA); PG8_STAGE(PG8_SB(1, 1), cB + hstep + kstep, voffB);
        PG8_WAIT_V(6); PG8_BAR;
    }
    for (;;) {
        const bool has_next = S.next(ui + 1, nxt);
        const char* nA = has_next ? (const char*)g.A + (size_t)nxt.pm * tstep : cA; const char* nB = has_next ? (const char*)g.Bt + (size_t)nxt.pn * tstep : cB;
        for (int t = 0; t < nt; t += 2) {
            const bool last = (t == nt - 2);
            const char* a1 = cA + (size_t)(t + 1) * kstep;
            const char* a2 = last ? nA : cA + (size_t)(t + 2) * kstep; const char* b2 = last ? nB : cB + (size_t)(t + 2) * kstep;
            const char* a3 = a2 + kstep; const char* b3 = b2 + kstep;
            if (last && has_next) S.a_ready(nxt);
            if constexpr (SP2) {
            PG8_LDB(B0, 0, 0); PG8_LDB(B1, 0, 1); PG8_SCHED; PG8_LDA(At, 0, 0); PG8_STAGE(PG8_SA(1, 1), a1 + hstep, voffA);
            PG8_WAIT_V(8); PG8_WAIT_L(0); PG8_BAR; PG8_MMA(0, 0, At, B0); PG8_MMA(0, 1, At, B1); PG8_BAR; PG8_SCHED;
            PG8_LDA(At, 0, 1); PG8_STAGE(PG8_SB(0, 0), b2, voffB); PG8_STAGE(PG8_SB(0, 1), b2 + hstep, voffB); PG8_STAGE(PG8_SA(0, 0), a2, voffA);
            PG8_WAIT_V(8); PG8_WAIT_L(0); PG8_BAR; PG8_MMA(1, 0, At, B0); PG8_MMA(1, 1, At, B1); PG8_BAR; PG8_SCHED;
            PG8_LDB(B0, 1, 0); PG8_LDB(B1, 1, 1); PG8_SCHED; PG8_LDA(At, 1, 0); PG8_STAGE(PG8_SA(0, 1), a2 + hstep, voffA);
            PG8_WAIT_V(8); PG8_WAIT_L(0); PG8_BAR; PG8_MMA(0, 0, At, B0); PG8_MMA(0, 1, At, B1); PG8_BAR; PG8_SCHED;
            PG8_LDA(At, 1, 1); PG8_STAGE(PG8_SB(1, 0), b3, voffB); PG8_STAGE(PG8_SB(1, 1), b3 + hstep, voffB); PG8_STAGE(PG8_SA(1, 0), a3, voffA);
            PG8_WAIT_V(8); PG8_WAIT_L(0); PG8_BAR; PG8_MMA(1, 0, At, B0); PG8_MMA(1, 1, At, B1); PG8_BAR; PG8_SCHED;
            } else {
            PG8_LDB(B0, 0, 0); PG8_SCHED; PG8_LDA(At, 0, 0); PG8_STAGE(PG8_SA(1, 1), a1 + hstep, voffA);
            PG8_WAIT_L(8); PG8_BAR; PG8_WAIT_L(0); PG8_MMA(0, 0, At, B0); PG8_BAR; PG8_SCHED;
            PG8_LDB(B1, 0, 1); PG8_STAGE(PG8_SB(0, 0), b2, voffB);
            PG8_BAR; PG8_WAIT_L(0); PG8_MMA(0, 1, At, B1); PG8_BAR;
            PG8_LDA(At, 0, 1); PG8_STAGE(PG8_SA(0, 0), a2, voffA);
            PG8_BAR; PG8_WAIT_L(0); PG8_MMA(1, 0, At, B0); PG8_BAR; PG8_SCHED;
            PG8_STAGE(PG8_SB(0, 1), b2 + hstep, voffB);
            PG8_WAIT_V(6); PG8_BAR; PG8_MMA(1, 1, At, B1); PG8_BAR;
            PG8_LDB(B0, 1, 0); PG8_SCHED; PG8_LDA(At, 1, 0); PG8_STAGE(PG8_SA(0, 1), a2 + hstep, voffA);
            PG8_WAIT_L(8); PG8_BAR; PG8_WAIT_L(0); PG8_MMA(0, 0, At, B0); PG8_BAR; PG8_SCHED;
            PG8_LDB(B1, 1, 1); PG8_STAGE(PG8_SB(1, 0), b3, voffB);
            PG8_BAR; PG8_WAIT_L(0); PG8_MMA(0, 1, At, B1); PG8_BAR;
            PG8_LDA(At, 1, 1); PG8_STAGE(PG8_SA(1, 0), a3, voffA);
            PG8_BAR; PG8_WAIT_L(0); PG8_MMA(1, 0, At, B0); PG8_BAR; PG8_SCHED;
            PG8_STAGE(PG8_SB(1, 1), b3 + hstep, voffB);
            PG8_WAIT_V(6); PG8_BAR; PG8_MMA(1, 1, At, B1); PG8_BAR;
            }
        }
        if constexpr (ALIGN_EPI) { if (wr == 0) PG8_BAR; }
        if constexpr (!Epi::AFTER_DRAIN) { E(acc, cur, wr, wc, fr, fq); S.done(cur); }
        if (!has_next) break;
#pragma unroll
        for (int a = 0; a < 2; ++a)
#pragma unroll
            for (int b = 0; b < 2; ++b)
#pragma unroll
                for (int m = 0; m < 4; ++m)
#pragma unroll
                    for (int n = 0; n < 2; ++n) acc[a][b][m][n] = (f32x4){0.f, 0.f, 0.f, 0.f};
        cur = nxt; cA = nA; cB = nB; ++ui;
        if constexpr (ALIGN_EPI) { if (wr == 1) PG8_BAR; }
    }
    PG8_WAIT_V(0);
    if constexpr (!ALIGN_EPI) { if (wr == 0) PG8_BAR; }
    PG8_BAR;
    if constexpr (Epi::AFTER_DRAIN) { E.fused(acc, cur, wr, wc, fr, fq, lds, wid, lane); S.done(cur); }
#undef PG8_SA
#undef PG8_SB
#undef PG8_STAGE
#undef PG8_LDA
#undef PG8_LDB
#undef PG8_MMA
#undef PG8_WAIT_V
#undef PG8_WAIT_L
#undef PG8_BAR
#undef PG8_SCHED
}
}
using pg8::bf_lo; using pg8::bf_hi;
#include <cmath>

constexpr int NWAVES = 8;
#ifndef MK_ONE_LAUNCH
#define MK_ONE_LAUNCH 1
#endif

constexpr int BATCH = 4, SEQ = 4096, D = 1024, DEPTH = 4;
constexpr int M = BATCH * SEQ;
constexpr int IN_COLS = 8192, DFF = 2816, DFF2 = 5632;
constexpr int MOBA_H = 8, MOBA_BLK = 256, MOBA_NB = SEQ / MOBA_BLK;
constexpr int DIFF_H = 4;
constexpr int RG_NB = 16, RG_CHUNK = 64, RG_NCH = SEQ / RG_CHUNK;
constexpr float LOG2E = 1.4426950408889634f;

constexpr size_t MiB = 1u << 20;
constexpr size_t WS_CTL = 0, CTL_ZERO_BYTES = 1 * MiB;
constexpr size_t WS_WIN = 1 * MiB;
constexpr size_t WS_WA = 17 * MiB;
constexpr size_t WS_WB = 18 * MiB;
constexpr size_t WS_WC = 20 * MiB;
constexpr size_t WS_WO = 21 * MiB;
constexpr size_t WS_WUP = 23 * MiB;
constexpr size_t WS_WDN = 34 * MiB;
constexpr size_t WS_SS = 40 * MiB;
constexpr size_t WS_KMEAN = 41 * MiB;
constexpr size_t WS_AGG = 42 * MiB;
constexpr size_t WS_CARRY = 44 * MiB;
constexpr size_t WS_PROJ = 48 * MiB;
constexpr size_t WS_QA = WS_PROJ, WS_KA = WS_QA + 16 * MiB, WS_VA = WS_KA + 16 * MiB, WS_QC = WS_VA + 16 * MiB, WS_KC = WS_QC + 16 * MiB, WS_VC = WS_KC + 16 * MiB;
constexpr size_t WS_RX = WS_VC + 16 * MiB, WS_RG = WS_RX + 32 * MiB;
constexpr size_t WS_GT = WS_RG + 32 * MiB;
constexpr size_t WS_XB = 304 * MiB;
constexpr size_t WS_YA = 336 * MiB, WS_YB = 352 * MiB, WS_YC = 384 * MiB;
constexpr size_t WS_MG = 400 * MiB;
constexpr size_t WS_U = WS_PROJ;
constexpr size_t WS_ACT = 336 * MiB;
constexpr size_t WS_DSCR = WS_MG;
constexpr size_t WS_X32 = 432 * MiB;
constexpr size_t WS_END = 496 * MiB;
static_assert(WS_GT + (size_t)M * 3072 * 2 == WS_XB && WS_U + (size_t)M * DFF2 * 2 <= WS_XB && WS_ACT + (size_t)M * DFF * 2 <= WS_X32 && WS_X32 + (size_t)M * D * 4 <= WS_END, "d_ws map");
constexpr int CW_BAR = 4096;

constexpr int RING_OFF = 0, RING_BYTES = 131072;
constexpr int LDSCTL_OFF = RING_BYTES, MISC_OFF = LDSCTL_OFF + 320;
constexpr int RSTAB_OFF = LDSCTL_OFF + 1024;
constexpr int LDS_BYTES = 147456;

#define GAS __attribute__((address_space(1)))
#define LAS __attribute__((address_space(3)))
typedef unsigned short bf16;
typedef unsigned v4u __attribute__((ext_vector_type(4)));
typedef float f32x4 __attribute__((ext_vector_type(4)));
typedef short bf16x8 __attribute__((ext_vector_type(8)));
typedef GAS unsigned gu32;
typedef GAS unsigned long long gu64;
#define RLX_AGENT __ATOMIC_RELAXED, __HIP_MEMORY_SCOPE_AGENT
#define LDS_WAIT() asm volatile("s_waitcnt lgkmcnt(0)" ::: "memory")
#define VM_WAIT() asm volatile("s_waitcnt vmcnt(0)" ::: "memory")
__device__ __forceinline__ unsigned long long rt() { return __builtin_amdgcn_s_memrealtime(); }
__device__ __forceinline__ unsigned f2bf(float f) { unsigned u = __builtin_bit_cast(unsigned, f); return (u + 0x7fffu + ((u >> 16) & 1u)) >> 16; }
__device__ __forceinline__ unsigned pk2(float lo, float hi) { return f2bf(lo) | (f2bf(hi) << 16); }

#define XB_TMO      128
#define XB_XCNT(j)  (256  + 64 * (j))
#define XB_XSUB(j)  (1280 + 64 * (j))
#define XB_XGEN(j)  (2304 + 64 * (j))
#define XB_TOP      3328
#define XB_TOPGEN   3392
#define XCD_BAR_WORDS 3456
#define XB_SPIN_CAP (1u << 24)

__device__ __forceinline__ unsigned xb_ld(unsigned* p)              { return __hip_atomic_load(p, __ATOMIC_RELAXED, __HIP_MEMORY_SCOPE_AGENT); }
__device__ __forceinline__ unsigned xb_add(unsigned* p, unsigned v) { return __hip_atomic_fetch_add(p, v, __ATOMIC_RELAXED, __HIP_MEMORY_SCOPE_AGENT); }
__device__ __forceinline__ unsigned xb_xcc_id() { return (unsigned)__builtin_amdgcn_s_getreg((3 << 11) | 20) & 0xFu; }
#define XB_SPIN(cond, bar) do { unsigned _sp = 0; while (cond) { __builtin_amdgcn_s_sleep(1); \
    if ((++_sp & 255u) == 0u) { if (xb_ld(&(bar)[XB_TMO])) break; if (_sp > XB_SPIN_CAP) { atomicAdd(&(bar)[XB_TMO], 1u); break; } } } } while (0)

struct XcdBarrier {
    unsigned* bar; unsigned x;
    volatile LAS unsigned* st;
};

__device__ __forceinline__ XcdBarrier xcd_barrier_post(unsigned* bar, volatile LAS unsigned* st) {
    XcdBarrier b; b.bar = bar; b.x = xb_xcc_id(); b.st = st;
    if (threadIdx.x == 0) (void)xb_add(&bar[XB_XCNT(b.x)], 1u);
    return b;
}
__device__ __forceinline__ void xcd_barrier_complete(unsigned* bar, unsigned x, unsigned& nloc, unsigned& nx) {
    const unsigned G = gridDim.x * gridDim.y * gridDim.z;
    unsigned sum, cnt, mine, sp = 0u;
    for (;;) {
        sum = 0u; cnt = 0u; mine = 0u;
#pragma unroll
        for (unsigned j = 0; j < 16; ++j) { const unsigned c = xb_ld(&bar[XB_XCNT(j)]); sum += c; cnt += (c > 0u) ? 1u : 0u; mine = (j == x) ? c : mine; }
        if (sum == G) break;
        __builtin_amdgcn_s_sleep(1);
        if ((++sp & 255u) == 0u) { if (xb_ld(&bar[XB_TMO])) break; if (sp > XB_SPIN_CAP) { atomicAdd(&bar[XB_TMO], 1u); break; } }
    }
    nloc = mine > 0u ? mine : 1u; nx = cnt > 0u ? cnt : 1u;
}

__device__ __forceinline__ void xcd_barrier(const XcdBarrier& b) {
    asm volatile("s_waitcnt vmcnt(0)" ::: "memory");
    __syncthreads();
    if (threadIdx.x == 0) {
        unsigned* bar = b.bar;
        __builtin_amdgcn_s_waitcnt(0);
        unsigned nloc = b.st[0], nx = b.st[1];
        if (nloc == 0u) { xcd_barrier_complete(bar, b.x, nloc, nx); b.st[0] = nloc; b.st[1] = nx; }
        const unsigned old = xb_add(&bar[XB_XSUB(b.x)], 1u);
        const unsigned gen = old / nloc;
        if (old + 1u == (gen + 1u) * nloc) {
            __builtin_amdgcn_fence(__ATOMIC_RELEASE, "agent");
            asm volatile("s_waitcnt vmcnt(0)" ::: "memory");
            const unsigned og = xb_add(&bar[XB_TOP], 1u);
            const unsigned tg = og / nx;
            if (og + 1u == (tg + 1u) * nx) xb_add(&bar[XB_TOPGEN], 1u);
            else XB_SPIN(xb_ld(&bar[XB_TOPGEN]) == tg, bar);
            __builtin_amdgcn_fence(__ATOMIC_ACQUIRE, "agent");
            xb_add(&bar[XB_XGEN(b.x)], 1u);
            asm volatile("s_waitcnt vmcnt(0)" ::: "memory");
        } else {
            XB_SPIN(xb_ld(&bar[XB_XGEN(b.x)]) == gen, bar);
            __builtin_amdgcn_fence(__ATOMIC_ACQUIRE, "agent");
            asm volatile("s_waitcnt vmcnt(0)" ::: "memory");
        }
    }
    __syncthreads();
}

struct Frame {
    LAS unsigned char* lds;
    volatile LAS unsigned* MISC;
    gu32* ctl;
    int tid, lane, wave;
    int vcu, G;
    unsigned char* ws;
};
__device__ __forceinline__ float bf2f(bf16 b) { return __uint_as_float(((unsigned)b) << 16); }
__device__ __forceinline__ float wave_sum(float v) {
#pragma unroll
    for (int o = 1; o < 64; o <<= 1) v += __shfl_xor(v, o);
    return v;
}
__device__ __forceinline__ void p0_transpose_item(const float* W, int K, int N, bf16* WT, const float* gain, LAS float* scr, int item, int lane) {
    const int nblk = N / 32, kb = item / nblk, nb = item % nblk, k0 = 64 * kb, n0 = 32 * nb;
#pragma unroll 8
    for (int i = 0; i < 32; ++i) { const int kk = 2 * i + (lane >> 5); float v = W[(size_t)(k0 + kk) * N + n0 + (lane & 31)]; if (gain) v *= gain[k0 + kk]; scr[kk * 33 + (lane & 31)] = v; }
    LDS_WAIT(); asm volatile("" ::: "memory");
    const int c = lane & 7;
#pragma unroll
    for (int j = 0; j < 4; ++j) { const int n = (lane >> 3) + 8 * j; const LAS float* s = scr + (8 * c) * 33 + n;
        v4u o; o.x = pk2(s[0 * 33], s[1 * 33]); o.y = pk2(s[2 * 33], s[3 * 33]); o.z = pk2(s[4 * 33], s[5 * 33]); o.w = pk2(s[6 * 33], s[7 * 33]);
        *(GAS v4u*)(WT + (size_t)(n0 + n) * K + k0 + 8 * c) = o; }
    LDS_WAIT(); asm volatile("" ::: "memory");
}
__device__ __forceinline__ void ph_xprologue(Frame& F, const float* x) {
    const int gw = F.vcu * NWAVES + F.wave, NGW = F.G * NWAVES;
    bf16* XB = (bf16*)(F.ws + WS_XB); float* ssp = (float*)(F.ws + WS_SS);
    for (int m = gw; m < M; m += NGW) {
        const GAS f32x4* xr = (const GAS f32x4*)(x + (size_t)m * D) + F.lane;
        f32x4 v[4]; float s = 0.f;
#pragma unroll
        for (int j = 0; j < 4; ++j) { v[j] = xr[64 * j]; s += (v[j].x * v[j].x + v[j].y * v[j].y) + (v[j].z * v[j].z + v[j].w * v[j].w); }
        s = wave_sum(s);
        GAS unsigned long long* o8 = (GAS unsigned long long*)(XB + (size_t)m * D) + F.lane;
#pragma unroll
        for (int j = 0; j < 4; ++j) o8[64 * j] = (unsigned long long)pk2(v[j].x, v[j].y) | ((unsigned long long)pk2(v[j].z, v[j].w) << 32);
        if (F.lane < 16) ssp[(size_t)m * 16 + F.lane] = (F.lane == 0) ? s : 0.f;
    }
}
struct LayerW { const float *w_in, *g_mix, *wa, *wb, *wc, *wo, *up, *g_ffn, *dn; };
__device__ __forceinline__ void ph_weights(Frame& F, const LayerW& W) {
    LAS float* scr = (LAS float*)(F.lds + RING_OFF + F.wave * 16384);
    const int gw = F.vcu * NWAVES + F.wave, NGW = F.G * NWAVES;
    constexpr int I_IN = (D / 64) * (IN_COLS / 32), I_A = (512 / 64) * (D / 32), I_B = (D / 64) * (D / 32), I_UP = (D / 64) * (DFF2 / 32), I_DN = (DFF / 64) * (D / 32);
    constexpr int NITEMS = I_IN + I_A + I_B + I_A + I_B + I_UP + I_DN;
    for (int it = gw; it < NITEMS; it += NGW) {
        int r = it;
        if (r < I_IN) { p0_transpose_item(W.w_in, D, IN_COLS, (bf16*)(F.ws + WS_WIN), W.g_mix, scr, r, F.lane); continue; } r -= I_IN;
        if (r < I_A) { p0_transpose_item(W.wa, 512, D, (bf16*)(F.ws + WS_WA), nullptr, scr, r, F.lane); continue; } r -= I_A;
        if (r < I_B) { p0_transpose_item(W.wb, D, D, (bf16*)(F.ws + WS_WB), nullptr, scr, r, F.lane); continue; } r -= I_B;
        if (r < I_A) { p0_transpose_item(W.wc, 512, D, (bf16*)(F.ws + WS_WC), nullptr, scr, r, F.lane); continue; } r -= I_A;
        if (r < I_B) { p0_transpose_item(W.wo, D, D, (bf16*)(F.ws + WS_WO), nullptr, scr, r, F.lane); continue; } r -= I_B;
        if (r < I_UP) { p0_transpose_item(W.up, D, DFF2, (bf16*)(F.ws + WS_WUP), W.g_ffn, scr, r, F.lane); continue; } r -= I_UP;
        p0_transpose_item(W.dn, DFF, D, (bf16*)(F.ws + WS_WDN), nullptr, scr, r, F.lane);
    }
}
__device__ __forceinline__ void ph_kmean(Frame& F) {
    const int gw = F.vcu * NWAVES + F.wave, NGW = F.G * NWAVES;
    const bf16* KA = (const bf16*)(F.ws + WS_KA); float* KM = (float*)(F.ws + WS_KMEAN);
    for (int u = gw; u < BATCH * MOBA_NB * MOBA_H; u += NGW) {
        const int h = u % MOBA_H, blk = (u / MOBA_H) % MOBA_NB, b = u / (MOBA_H * MOBA_NB);
        const bf16* p = KA + ((size_t)b * SEQ + blk * MOBA_BLK) * 512 + h * 64 + F.lane;
        float s0 = 0.f, s1 = 0.f, s2 = 0.f, s3 = 0.f;
        for (int r = 0; r < MOBA_BLK; r += 4) { s0 += bf2f(p[(size_t)r * 512]); s1 += bf2f(p[(size_t)(r + 1) * 512]); s2 += bf2f(p[(size_t)(r + 2) * 512]); s3 += bf2f(p[(size_t)(r + 3) * 512]); }
        KM[((size_t)(b * MOBA_H + h) * MOBA_NB + blk) * 64 + F.lane] = ((s0 + s1) + (s2 + s3)) * (1.0f / MOBA_BLK);
    }
}
struct RgP { const float *conv_w, *conv_b, *w_a, *b_a, *w_x, *b_x, *lam; };
template <bool FIX> __device__ __forceinline__ void ph_rglru(Frame& F, const RgP& P) {
    const int gw = F.vcu * NWAVES + F.wave, NGW = F.G * NWAVES;
    const bf16* RX = (const bf16*)(F.ws + WS_RX); const bf16* RG = (const bf16*)(F.ws + WS_RG); bf16* YB = (bf16*)(F.ws + WS_YB);
    float* AG = (float*)(F.ws + WS_AGG); float* BG = AG + (size_t)BATCH * RG_NCH * D; const float* CI = (const float*)(F.ws + WS_CARRY);
    for (int u = gw; u < BATCH * RG_NCH * RG_NB; u += NGW) {
        const int n = u % RG_NB, c = (u / RG_NB) % RG_NCH, b = u / (RG_NB * RG_NCH);
        const int ch = n * 64 + F.lane;
        float wa[64], wx[64];
#pragma unroll
        for (int k = 0; k < 64; ++k) { wa[k] = P.w_a[(size_t)n * 4096 + k * 64 + F.lane]; wx[k] = P.w_x[(size_t)n * 4096 + k * 64 + F.lane]; }
        const float ba = P.b_a[ch], bx = P.b_x[ch], c8 = -8.0f * log1pf(expf(-P.lam[ch]));
        const float cw0 = P.conv_w[ch], cw1 = P.conv_w[D + ch], cw2 = P.conv_w[2 * D + ch], cw3 = P.conv_w[3 * D + ch], cb = P.conv_b[ch];
        const int t0 = c * RG_CHUNK; const size_t rb = (size_t)b * SEQ;
        float x3 = (t0 >= 3) ? bf2f(RX[(rb + t0 - 3) * D + ch]) : 0.f, x2 = (t0 >= 2) ? bf2f(RX[(rb + t0 - 2) * D + ch]) : 0.f, x1 = (t0 >= 1) ? bf2f(RX[(rb + t0 - 1) * D + ch]) : 0.f;
        const size_t aidx = ((size_t)b * RG_NCH + c) * D + ch;
        float h = FIX ? CI[aidx] : 0.f, pa = 1.f;
        for (int t = 0; t < RG_CHUNK; ++t) {
            const float x0 = bf2f(RX[(rb + t0 + t) * D + ch]);
            const float xr = cb + cw0 * x3 + cw1 * x2 + cw2 * x1 + cw3 * x0; x3 = x2; x2 = x1; x1 = x0;
            float rp = ba, ip = bx;
#pragma unroll
            for (int k = 0; k < 64; ++k) { const float s = __uint_as_float(__builtin_amdgcn_readlane(__float_as_uint(xr), k)); rp += s * wa[k]; ip += s * wx[k]; }
            const float r = 1.0f / (1.0f + expf(-rp)), ig = 1.0f / (1.0f + expf(-ip));
            const float la = c8 * r, a = expf(la), mult = sqrtf(-expm1f(2.0f * la));
            h = a * h + mult * (ig * xr); pa *= a;
            if (FIX) YB[(rb + t0 + t) * D + ch] = (bf16)f2bf(h * bf2f(RG[(rb + t0 + t) * D + ch]));
        }
        if (!FIX) { AG[aidx] = pa; BG[aidx] = h; }
    }
}
__device__ __forceinline__ void ph_carry(Frame& F) {
    const float* AG = (const float*)(F.ws + WS_AGG); const float* BG = AG + (size_t)BATCH * RG_NCH * D; float* CI = (float*)(F.ws + WS_CARRY);
    const int gt = F.vcu * (NWAVES * 64) + F.tid;
    if (gt < BATCH * D) { const int b = gt / D, ch = gt % D; float carry = 0.f;
        for (int c = 0; c < RG_NCH; ++c) { const size_t i = ((size_t)b * RG_NCH + c) * D + ch; CI[i] = carry; carry = AG[i] * carry + BG[i]; } }
}
template <int DV  , int VW  >
__device__ __forceinline__ void naive_tile(const LAS float* Ks, const LAS float* Vs, const float (&q)[16], float (&o)[DV], float& mr, float& lr, int qpos, int kpos0, float slope2, bool mine, int qd) {
#pragma unroll 2
    for (int j = 63; j >= 0; --j) {
        const LAS f32x4* kr = (const LAS f32x4*)(Ks + j * 64 + qd * 16);
        const f32x4 k0 = kr[0], k1 = kr[1], k2 = kr[2], k3 = kr[3];
        float d = ((q[0] * k0[0] + q[1] * k0[1]) + (q[2] * k0[2] + q[3] * k0[3])) + ((q[4] * k1[0] + q[5] * k1[1]) + (q[6] * k1[2] + q[7] * k1[3]))
                + ((q[8] * k2[0] + q[9] * k2[1]) + (q[10] * k2[2] + q[11] * k2[3])) + ((q[12] * k3[0] + q[13] * k3[1]) + (q[14] * k3[2] + q[15] * k3[3]));
        d += __shfl_xor(d, 1); d += __shfl_xor(d, 2);
        const int dist = qpos - (kpos0 + j);
        if (mine && dist >= 0) {
            const float sv = d - slope2 * (float)dist;
            if (sv > mr) { const float sc = __builtin_amdgcn_exp2f(mr - sv); lr *= sc; mr = sv;
#pragma unroll
                for (int e = 0; e < DV; ++e) o[e] *= sc; }
            const float p = __builtin_amdgcn_exp2f(sv - mr); lr += p; const LAS f32x4* vr = (const LAS f32x4*)(Vs + j * VW + qd * DV);
#pragma unroll
            for (int i = 0; i < DV / 4; ++i) { const f32x4 v = vr[i]; o[4 * i] += p * v[0]; o[4 * i + 1] += p * v[1]; o[4 * i + 2] += p * v[2]; o[4 * i + 3] += p * v[3]; }
        }
    }
}
template <int VW> __device__ __forceinline__ void naive_stage(Frame& F, LAS float* Ks, LAS float* Vs, const bf16* Kg, const bf16* Vg) {
    { const int r = F.tid >> 3, c = (F.tid & 7) * 8; const v4u w = *(const GAS v4u*)(Kg + (size_t)r * 512 + c); LAS float* d = Ks + r * 64 + c;
      d[0] = bf_lo(w.x); d[1] = bf_hi(w.x); d[2] = bf_lo(w.y); d[3] = bf_hi(w.y); d[4] = bf_lo(w.z); d[5] = bf_hi(w.z); d[6] = bf_lo(w.w); d[7] = bf_hi(w.w); }
#pragma unroll
    for (int i = 0; i < VW / 64; ++i) { const int e = (F.tid + i * 512) * 8, r = e / VW, c = e % VW; const v4u w = *(const GAS v4u*)(Vg + (size_t)r * 512 + c); LAS float* d = Vs + r * VW + c;
      d[0] = bf_lo(w.x); d[1] = bf_hi(w.x); d[2] = bf_lo(w.y); d[3] = bf_hi(w.y); d[4] = bf_lo(w.z); d[5] = bf_hi(w.z); d[6] = bf_lo(w.w); d[7] = bf_hi(w.w); }
}
__device__ __forceinline__ void load_q16(float (&q)[16], const bf16* p) {
#pragma unroll
    for (int i = 0; i < 2; ++i) { const v4u w = *(const GAS v4u*)(p + 8 * i); q[8 * i] = bf_lo(w.x); q[8 * i + 1] = bf_hi(w.x); q[8 * i + 2] = bf_lo(w.y); q[8 * i + 3] = bf_hi(w.y); q[8 * i + 4] = bf_lo(w.z); q[8 * i + 5] = bf_hi(w.z); q[8 * i + 6] = bf_lo(w.w); q[8 * i + 7] = bf_hi(w.w); }
}
__device__ __forceinline__ void causal_unit(int idx, int nbh, bool four, int& bh, int& qt) {
    bh = idx % nbh; const int j = idx / nbh;
    if (four) qt = (j < 8) ? 31 - j : (j < 16) ? j - 8 : (j < 24) ? 39 - j : j - 16;
    else qt = (j < 16) ? 31 - j : j - 16;
}

struct DiffP { const float *lq1, *lk1, *lq2, *lk2, *subln_g; float lam_init; };
__device__ __forceinline__ void ph_diffattn_naive(Frame& F, const DiffP& P) {
    LAS float* Ks = (LAS float*)(F.lds + RING_OFF); LAS float* Vs = Ks + 64 * 64;
    const bf16* QC = (const bf16*)(F.ws + WS_QC); const bf16* KC = (const bf16*)(F.ws + WS_KC); const bf16* VC = (const bf16*)(F.ws + WS_VC); bf16* YC = (bf16*)(F.ws + WS_YC);
    float* DS = (float*)(F.ws + WS_DSCR);
    float d1 = 0.f, d2 = 0.f;
    for (int i = 0; i < 64; ++i) { d1 += P.lq1[i] * P.lk1[i]; d2 += P.lq2[i] * P.lk2[i]; }
    const float lam = expf(d1) - expf(d2) + P.lam_init;
    const int row = F.tid >> 2, qd = F.tid & 3;
    for (int idx = F.vcu; idx < BATCH * DIFF_H * 32; idx += F.G) {
        int bh, qt; causal_unit(idx, BATCH * DIFF_H, false, bh, qt);
        const int b = bh / DIFF_H, h = bh % DIFF_H; const int qpos = qt * 128 + row; const size_t grow = (size_t)b * SEQ + qpos;
        const float slope2 = exp2f(-2.0f * (float)(h + 1)) * LOG2E;
        float* dsp = DS + (grow * DIFF_H + h) * 128 + qd * 32;
        for (int m = 0; m < 2; ++m) {
            float q[16]; load_q16(q, QC + grow * 512 + h * 128 + m * 64 + qd * 16);
            float o[32]; float mr = -INFINITY, lr = 0.f;
#pragma unroll
            for (int d = 0; d < 32; ++d) o[d] = 0.f;
            for (int kt = 2 * qt + 1; kt >= 0; --kt) {
                __syncthreads();
                const size_t krow = (size_t)b * SEQ + kt * 64;
                naive_stage<128>(F, Ks, Vs, KC + krow * 512 + h * 128 + m * 64, VC + krow * 512 + h * 128);
                __syncthreads();
                naive_tile<32, 128>(Ks, Vs, q, o, mr, lr, qpos, kt * 64, slope2, true, qd);
            }
            const float il = 1.0f / lr;
            if (m == 0) {
#pragma unroll
                for (int d = 0; d < 32; d += 4) *(f32x4*)(dsp + d) = (f32x4){o[d] * il, o[d + 1] * il, o[d + 2] * il, o[d + 3] * il};
            } else {
                float ss = 0.f;
#pragma unroll
                for (int d = 0; d < 32; d += 4) { const f32x4 o1 = *(const f32x4*)(dsp + d);
#pragma unroll
                    for (int e = 0; e < 4; ++e) { o[d + e] = o1[e] - lam * (o[d + e] * il); ss += o[d + e] * o[d + e]; } }
                ss += __shfl_xor(ss, 1); ss += __shfl_xor(ss, 2);
                const float rs = rsqrtf(ss * (1.0f / 128.0f) + 1e-6f) * (1.0f - P.lam_init);
                bf16* yp = YC + grow * 512 + h * 128 + qd * 32; const float* gp = P.subln_g + qd * 32;
#pragma unroll
                for (int d = 0; d < 32; d += 8) { v4u w;
                    w.x = pk2(o[d] * rs * gp[d], o[d + 1] * rs * gp[d + 1]); w.y = pk2(o[d + 2] * rs * gp[d + 2], o[d + 3] * rs * gp[d + 3]);
                    w.z = pk2(o[d + 4] * rs * gp[d + 4], o[d + 5] * rs * gp[d + 5]); w.w = pk2(o[d + 6] * rs * gp[d + 6], o[d + 7] * rs * gp[d + 7]);
                    *(GAS v4u*)(yp + d) = w; }
            }
        }
    }
    __syncthreads();
}
__device__ __forceinline__ void ph_moba_naive(Frame& F) {
    LAS float* Ks = (LAS float*)(F.lds + RING_OFF); LAS float* Vs = Ks + 64 * 64; LAS float* Km = Vs + 64 * 64; LAS unsigned* msk = (LAS unsigned*)(Km + MOBA_NB * 64);
    const bf16* QA = (const bf16*)(F.ws + WS_QA); const bf16* KA = (const bf16*)(F.ws + WS_KA); const bf16* VA = (const bf16*)(F.ws + WS_VA); bf16* YA = (bf16*)(F.ws + WS_YA);
    const float* KM = (const float*)(F.ws + WS_KMEAN);
    const int row = F.tid >> 2, qd = F.tid & 3;
    for (int idx = F.vcu; idx < BATCH * MOBA_H * 32; idx += F.G) {
        int bh, qt; causal_unit(idx, BATCH * MOBA_H, true, bh, qt);
        const int b = bh / MOBA_H, h = bh % MOBA_H, blk = qt >> 1; const int qpos = qt * 128 + row; const size_t grow = (size_t)b * SEQ + qpos;
        const float slope2 = exp2f(-(float)(h + 1)) * LOG2E;
        __syncthreads();
        for (int i = F.tid; i < MOBA_NB * 64; i += NWAVES * 64) Km[i] = KM[(size_t)bh * MOBA_NB * 64 + i];
        if (F.tid == 0) msk[0] = 0u;
        __syncthreads();
        float q[16]; load_q16(q, QA + grow * 512 + h * 64 + qd * 16);
        float b0 = -INFINITY, b1 = -INFINITY, b2 = -INFINITY; int i0 = -1, i1 = -1, i2 = -1;
        for (int j = 0; j < blk; ++j) { float g = 0.f;
#pragma unroll
            for (int d = 0; d < 16; ++d) g += q[d] * Km[j * 64 + qd * 16 + d];
            g += __shfl_xor(g, 1); g += __shfl_xor(g, 2);
            if (g > b0) { b2 = b1; i2 = i1; b1 = b0; i1 = i0; b0 = g; i0 = j; } else if (g > b1) { b2 = b1; i2 = i1; b1 = g; i1 = j; } else if (g > b2) { b2 = g; i2 = j; } }
        unsigned mym = 0u; if (i0 >= 0) mym |= 1u << i0; if (i1 >= 0) mym |= 1u << i1; if (i2 >= 0) mym |= 1u << i2;
        atomicOr((unsigned*)msk, mym);
        __syncthreads();
        const unsigned wgm = msk[0];
        float o[16]; float mr = -INFINITY, lr = 0.f;
#pragma unroll
        for (int d = 0; d < 16; ++d) o[d] = 0.f;
        for (int jb = blk; jb >= 0; --jb) {
            if (jb != blk && !((wgm >> jb) & 1u)) continue;
            const bool mine = (jb == blk) || ((mym >> jb) & 1u);
            const int ktop = (jb == blk) ? (2 * (qt & 1) + 1) : 3;
            for (int kt = ktop; kt >= 0; --kt) {
                __syncthreads();
                const size_t krow = (size_t)b * SEQ + jb * 256 + kt * 64;
                naive_stage<64>(F, Ks, Vs, KA + krow * 512 + h * 64, VA + krow * 512 + h * 64);
                __syncthreads();
                naive_tile<16, 64>(Ks, Vs, q, o, mr, lr, qpos, jb * 256 + kt * 64, slope2, mine, qd);
            }
        }
        const float il = 1.0f / lr; bf16* yp = YA + grow * 512 + h * 64 + qd * 16;
#pragma unroll
        for (int d = 0; d < 16; d += 8) { v4u w; w.x = pk2(o[d] * il, o[d + 1] * il); w.y = pk2(o[d + 2] * il, o[d + 3] * il); w.z = pk2(o[d + 4] * il, o[d + 5] * il); w.w = pk2(o[d + 6] * il, o[d + 7] * il); *(GAS v4u*)(yp + d) = w; }
    }
    __syncthreads();
}
__device__ __forceinline__ void ph_ffnact(Frame& F, const float* cw  , const float* cbias  ) {
    const bf16* U = (const bf16*)(F.ws + WS_U); bf16* ACT = (bf16*)(F.ws + WS_ACT);
    const size_t total = (size_t)M * (DFF / 8), stride = (size_t)F.G * NWAVES * 64;
    for (size_t i = (size_t)F.vcu * NWAVES * 64 + F.tid; i < total; i += stride) {
        const int row = (int)(i / (DFF / 8)), c = (int)(i % (DFF / 8)) * 8, t = row % SEQ;
        float ug[8], uv[8];
#pragma unroll
        for (int e = 0; e < 8; ++e) { ug[e] = cbias[c + e]; uv[e] = cbias[DFF + c + e]; }
#pragma unroll
        for (int j = 0; j < 3; ++j) { if (t - 2 + j < 0) continue;
            const bf16* up = U + (size_t)(row - 2 + j) * DFF2 + c; const v4u g = *(const GAS v4u*)up, v = *(const GAS v4u*)(up + DFF);
            const float* wg = cw + (size_t)j * DFF2 + c; const float* wv = wg + DFF;
            ug[0] += wg[0] * bf_lo(g.x); ug[1] += wg[1] * bf_hi(g.x); ug[2] += wg[2] * bf_lo(g.y); ug[3] += wg[3] * bf_hi(g.y); ug[4] += wg[4] * bf_lo(g.z); ug[5] += wg[5] * bf_hi(g.z); ug[6] += wg[6] * bf_lo(g.w); ug[7] += wg[7] * bf_hi(g.w);
            uv[0] += wv[0] * bf_lo(v.x); uv[1] += wv[1] * bf_hi(v.x); uv[2] += wv[2] * bf_lo(v.y); uv[3] += wv[3] * bf_hi(v.y); uv[4] += wv[4] * bf_lo(v.z); uv[5] += wv[5] * bf_hi(v.z); uv[6] += wv[6] * bf_lo(v.w); uv[7] += wv[7] * bf_hi(v.w); }
        v4u w; w.x = pk2(pg8::gelu_tanh_f(ug[0]) * uv[0], pg8::gelu_tanh_f(ug[1]) * uv[1]); w.y = pk2(pg8::gelu_tanh_f(ug[2]) * uv[2], pg8::gelu_tanh_f(ug[3]) * uv[3]);
        w.z = pk2(pg8::gelu_tanh_f(ug[4]) * uv[4], pg8::gelu_tanh_f(ug[5]) * uv[5]); w.w = pk2(pg8::gelu_tanh_f(ug[6]) * uv[6], pg8::gelu_tanh_f(ug[7]) * uv[7]);
        *(GAS v4u*)(ACT + (size_t)row * DFF + c) = w;
    }
}
__device__ __forceinline__ void ph_final(Frame& F, const float* xin, float* out, const float* g) {
    const int gw = F.vcu * NWAVES + F.wave, NGW = F.G * NWAVES;
    for (int m = gw; m < M; m += NGW) {
        const GAS f32x4* xr = (const GAS f32x4*)(xin + (size_t)m * D) + F.lane; GAS f32x4* orow = (GAS f32x4*)(out + (size_t)m * D) + F.lane;
        f32x4 v[4]; float s = 0.f;
#pragma unroll
        for (int j = 0; j < 4; ++j) { v[j] = xr[64 * j]; s += (v[j].x * v[j].x + v[j].y * v[j].y) + (v[j].z * v[j].z + v[j].w * v[j].w); }
        const float rs = rsqrtf(wave_sum(s) * (1.0f / D) + 1e-6f);
#pragma unroll
        for (int j = 0; j < 4; ++j) { const f32x4 gg = *((const GAS f32x4*)g + F.lane + 64 * j); orow[64 * j] = v[j] * rs * gg; }
    }
}

constexpr int NPL = 10;
constexpr int NPH = 1 + DEPTH * NPL + 1;
struct Args { const float* in[26]; float* out; unsigned char* ws; int ph_lo, ph_hi; };
__global__ void __launch_bounds__(NWAVES * 64, 2) mk_fwd(Args args) {
    extern __shared__ __attribute__((aligned(16))) unsigned char lds[];
    Frame F;
    F.lds = (LAS unsigned char*)lds;
    F.MISC = (volatile LAS unsigned*)(F.lds + MISC_OFF);
    F.tid = threadIdx.x; F.lane = F.tid & 63; F.wave = __builtin_amdgcn_readfirstlane(F.tid >> 6);
    F.G = gridDim.x; { const int bx = blockIdx.x; F.vcu = (F.G % 8 == 0) ? (bx % 8) * (F.G / 8) + bx / 8 : bx; }
    F.ws = args.ws; F.ctl = (gu32*)(args.ws + WS_CTL);
    for (int u = F.tid; u < (LDS_BYTES - LDSCTL_OFF) / 4; u += NWAVES * 64) ((LAS unsigned*)(F.lds + LDSCTL_OFF))[u] = 0u;
    __syncthreads();
    const int lo = args.ph_lo, hi = args.ph_hi;
    XcdBarrier bar; bar.bar = (unsigned*)(F.ctl + CW_BAR); bar.x = 0; bar.st = nullptr;
    if (hi - lo > 1) bar = xcd_barrier_post((unsigned*)(F.ctl + CW_BAR), F.MISC + 8);
#define IN(k) (lo <= (k) && (k) < hi)
#define RELAUNDER() do { int t_ = threadIdx.x; asm volatile("" : "+v"(t_)); F.tid = t_; F.lane = t_ & 63; } while (0)
#define SEAM(k) do { if ((k) + 1 < hi) xcd_barrier(bar); } while (0)
    #define in args.in
    bf16* XB = (bf16*)(F.ws + WS_XB); float* SSP = (float*)(F.ws + WS_SS); LAS float* RSTAB = (LAS float*)(F.lds + RSTAB_OFF); float* X32 = (float*)(F.ws + WS_X32);

    if (IN(0)) { RELAUNDER(); ph_xprologue(F, in[0]); SEAM(0); }

    for (int l = 0; l < DEPTH; ++l) {
        const int pb = 1 + l * NPL;
        if (IN(pb + 0)) {
            LayerW W{in[2] + (size_t)l * D * IN_COLS, in[1] + (size_t)l * D, in[16] + (size_t)l * 512 * D, in[17] + (size_t)l * D * D, in[18] + (size_t)l * 512 * D, in[19] + (size_t)l * D * D,
                     in[21] + (size_t)l * D * DFF2, in[20] + (size_t)l * D, in[24] + (size_t)l * DFF * D};
            RELAUNDER(); ph_weights(F, W); SEAM(pb + 0);
        }
        if (IN(pb + 1)) {
            pg8::Gemm g{XB, (const bf16*)(F.ws + WS_WIN), M, IN_COLS, D}; pg8::StaticOrder S; S.init(M, IN_COLS, F.G, (int)blockIdx.x);
            pg8::EpiInProj E{(bf16*)(F.ws + WS_QA), (bf16*)(F.ws + WS_KA), (bf16*)(F.ws + WS_VA), (bf16*)(F.ws + WS_QC), (bf16*)(F.ws + WS_KC), (bf16*)(F.ws + WS_VC),
                             (bf16*)(F.ws + WS_RX), (bf16*)(F.ws + WS_RG), (bf16*)(F.ws + WS_GT), SSP, in[3] + (size_t)l * 3 * D, RSTAB};
            if (F.tid == 0) ((volatile LAS int*)RSTAB)[256] = 0; __syncthreads();
#ifndef DIS_G1
            pg8::gemm_phase<pg8::EpiInProj, pg8::StaticOrder, true, true>(F.lds + RING_OFF, g, S, E);
#endif
            SEAM(pb + 1);
        }
        if (IN(pb + 2)) {

#ifndef DIS_KMEAN
            RELAUNDER(); ph_kmean(F);
#endif

            RgP P{in[4] + (size_t)l * 4 * D, in[5] + (size_t)l * D, in[6] + (size_t)l * RG_NB * 4096, in[7] + (size_t)l * D, in[8] + (size_t)l * RG_NB * 4096, in[9] + (size_t)l * D, in[10] + (size_t)l * D};

#ifndef DIS_RGA
            RELAUNDER(); ph_rglru<false>(F, P);
#endif

            DiffP DP{in[11] + l * 64, in[12] + l * 64, in[13] + l * 64, in[14] + l * 64, in[15] + l * 128, 0.8f - 0.6f * expf(-0.3f * (float)l)};

#ifndef DIS_DIFF
            RELAUNDER(); ph_diffattn_naive(F, DP);
#endif

            SEAM(pb + 2);
        }
        if (IN(pb + 3)) { RELAUNDER(); ph_carry(F);
#ifndef DIS_MOBA
 RELAUNDER(); ph_moba_naive(F);
#endif
 SEAM(pb + 3); }
        if (IN(pb + 4)) {
            RgP P{in[4] + (size_t)l * 4 * D, in[5] + (size_t)l * D, in[6] + (size_t)l * RG_NB * 4096, in[7] + (size_t)l * D, in[8] + (size_t)l * RG_NB * 4096, in[9] + (size_t)l * D, in[10] + (size_t)l * D};

#ifndef DIS_RGC
            RELAUNDER(); ph_rglru<true>(F, P);
#endif
 SEAM(pb + 4);
        }
        if (IN(pb + 5)) {
            pg8::StaticOrder S; S.init(M, D, F.G, (int)blockIdx.x);
            { pg8::Gemm g{(const bf16*)(F.ws + WS_YA), (const bf16*)(F.ws + WS_WA), M, D, 512}; pg8::EpiBranch<true> E{(bf16*)(F.ws + WS_MG), (const bf16*)(F.ws + WS_GT), 0};

#ifndef DIS_G2
              pg8::gemm_phase<pg8::EpiBranch<true>, pg8::StaticOrder, true, true>(F.lds + RING_OFF, g, S, E);
#endif
 }
            { pg8::Gemm g{(const bf16*)(F.ws + WS_YB), (const bf16*)(F.ws + WS_WB), M, D, D}; pg8::EpiBranch<false> E{(bf16*)(F.ws + WS_MG), (const bf16*)(F.ws + WS_GT), D};

#ifndef DIS_G2
              pg8::gemm_phase<pg8::EpiBranch<false>, pg8::StaticOrder, true, true>(F.lds + RING_OFF, g, S, E);
#endif
 }
            { pg8::Gemm g{(const bf16*)(F.ws + WS_YC), (const bf16*)(F.ws + WS_WC), M, D, 512}; pg8::EpiBranch<false> E{(bf16*)(F.ws + WS_MG), (const bf16*)(F.ws + WS_GT), 2 * D};

#ifndef DIS_G2
              pg8::gemm_phase<pg8::EpiBranch<false>, pg8::StaticOrder, true, true>(F.lds + RING_OFF, g, S, E);
#endif
 }
            SEAM(pb + 5);
        }
        if (IN(pb + 6)) {
            pg8::Gemm g{(const bf16*)(F.ws + WS_MG), (const bf16*)(F.ws + WS_WO), M, D, D}; pg8::StaticOrder S; S.init(M, D, F.G, (int)blockIdx.x);
            pg8::EpiResid E{l == 0 ? in[0] : (const float*)X32, X32, XB, SSP};
#ifndef DIS_G3
            pg8::gemm_phase<pg8::EpiResid, pg8::StaticOrder, true, true>(F.lds + RING_OFF, g, S, E);
#endif
            SEAM(pb + 6);
        }
        if (IN(pb + 7)) {
            pg8::Gemm g{XB, (const bf16*)(F.ws + WS_WUP), M, DFF2, D}; pg8::StaticOrder S; S.init(M, DFF2, F.G, (int)blockIdx.x);
            pg8::EpiUp E{(bf16*)(F.ws + WS_U), DFF2, SSP, RSTAB};
            if (F.tid == 0) ((volatile LAS int*)RSTAB)[256] = 0; __syncthreads();
#ifndef DIS_G4
            pg8::gemm_phase<pg8::EpiUp, pg8::StaticOrder, true, true>(F.lds + RING_OFF, g, S, E);
#endif
            SEAM(pb + 7);
        }
        if (IN(pb + 8)) {
#ifndef DIS_ACT
 RELAUNDER(); ph_ffnact(F, in[22] + (size_t)l * 3 * DFF2, in[23] + (size_t)l * DFF2);
#endif
 SEAM(pb + 8); }
        if (IN(pb + 9)) {
            pg8::Gemm g{(const bf16*)(F.ws + WS_ACT), (const bf16*)(F.ws + WS_WDN), M, D, DFF}; pg8::StaticOrder S; S.init(M, D, F.G, (int)blockIdx.x);
            pg8::EpiResid E{X32, X32, XB, SSP};
#ifndef DIS_G3
            pg8::gemm_phase<pg8::EpiResid, pg8::StaticOrder, true, true>(F.lds + RING_OFF, g, S, E);
#endif
            SEAM(pb + 9);
        }
    }
    if (IN(NPH - 1)) { RELAUNDER(); ph_final(F, X32, args.out, in[25]); }
#undef IN
#undef RELAUNDER
#undef in
#undef SEAM
}


#ifndef DBG_STOP
#define DBG_STOP 0
#endif
#define DBG_DUMP_OFF (WS_YA)
#define DBG_DUMP_PER 2
__global__ void dbg_dump(const unsigned short* buf, float* out, size_t n, int per) {
    for (size_t i = (size_t)blockIdx.x * blockDim.x + threadIdx.x; i < n; i += (size_t)gridDim.x * blockDim.x) { float a = 0.f; for (int j = 0; j < per; ++j) a += __uint_as_float(((unsigned)buf[i * per + j]) << 16); out[i] = a; }
}

#ifndef DBG_TWICE
#define DBG_TWICE 0
#endif
__global__ void dbg_cksum(const unsigned* w, size_t n, unsigned poison, unsigned long long* ck) {
    unsigned long long a = 0; for (size_t i = (size_t)blockIdx.x * blockDim.x + threadIdx.x; i < n; i += (size_t)gridDim.x * blockDim.x) { const unsigned v = w[i]; if (v != poison) a += (unsigned long long)v * (unsigned long long)((i & 1023) + 1); }
    atomicAdd(ck, a);
}
__global__ void dbg_fill(unsigned* w, size_t n, unsigned v) { for (size_t i = (size_t)blockIdx.x * blockDim.x + threadIdx.x; i < n; i += (size_t)gridDim.x * blockDim.x) w[i] = v; }
__global__ void dbg_decide(float* out, size_t n, const unsigned long long* ck, int nph) {
    int first = -1; for (int p = 0; p < nph; ++p) if (ck[p] != ck[64 + p]) { first = p; break; }
    const float K = first < 0 ? 0.f : sqrtf(exp2f((float)first));
    for (size_t i = (size_t)blockIdx.x * blockDim.x + threadIdx.x; i < n; i += (size_t)gridDim.x * blockDim.x) out[i] = K;
}
extern "C" void kernel_launch(void* const* d_in, const int* in_sizes, int n_in, void* d_out, int out_size, void* d_ws, size_t ws_size, hipStream_t stream) {
    static int grid = 0;
    if (grid == 0) {
        if (n_in != 26 || in_sizes[0] != M * D || out_size != M * D || ws_size < WS_END) { fprintf(stderr, "kernel_launch: unexpected shapes / workspace (n_in %d, ws %zu); nothing launched\n", n_in, ws_size); grid = -1; return; }
        int dev = 0, cus = 0, per_cu = 0;
        if (hipGetDevice(&dev) != hipSuccess || hipDeviceGetAttribute(&cus, hipDeviceAttributeMultiprocessorCount, dev) != hipSuccess) { grid = -1; return; }
        if (hipFuncSetAttribute((const void*)mk_fwd, hipFuncAttributeMaxDynamicSharedMemorySize, LDS_BYTES) != hipSuccess) { grid = -1; return; }
        if (hipOccupancyMaxActiveBlocksPerMultiprocessor(&per_cu, (const void*)mk_fwd, NWAVES * 64, LDS_BYTES) != hipSuccess || per_cu < 1) { fprintf(stderr, "kernel_launch: occupancy query reports %d\n", per_cu); }
        (void)hipGetLastError();
        grid = cus;
    }
    if (grid < 0) return;
    if (hipMemsetAsync((char*)d_ws + WS_CTL, 0, CTL_ZERO_BYTES, stream) != hipSuccess) return;
    Args a{};
    for (int i = 0; i < 26; ++i) a.in[i] = (const float*)d_in[i];
    a.out = (float*)d_out; a.ws = (unsigned char*)d_ws;
#if MK_ONE_LAUNCH
    a.ph_lo = 0; a.ph_hi = NPH;
    hipLaunchKernelGGL(mk_fwd, dim3(grid), dim3(NWAVES * 64), LDS_BYTES, stream, a);
#else
#if DBG_TWICE
    unsigned long long* ck = (unsigned long long*)((char*)d_ws + 512 * 1024);
    hipLaunchKernelGGL(dbg_fill, dim3(1), dim3(256), 0, stream, (unsigned*)ck, (size_t)256, 0u);
    for (int rep = 0; rep < 2; ++rep) {
        const int pb = rep ? 0x3C : 0x5A; const unsigned pw = rep ? 0x3C3C3C3Cu : 0x5A5A5A5Au;
        (void)pb; hipLaunchKernelGGL(dbg_fill, dim3(2048), dim3(256), 0, stream, (unsigned*)((char*)d_ws + MiB), (size_t)(WS_END - MiB) / 4, pw); hipLaunchKernelGGL(dbg_fill, dim3(2048), dim3(256), 0, stream, (unsigned*)d_out, (size_t)M * D, pw);
        for (int p = 0; p < NPH; ++p) { a.ph_lo = p; a.ph_hi = p + 1; hipLaunchKernelGGL(mk_fwd, dim3(grid), dim3(NWAVES * 64), LDS_BYTES, stream, a);
            hipLaunchKernelGGL(dbg_cksum, dim3(2048), dim3(256), 0, stream, (const unsigned*)((char*)d_ws + MiB), (size_t)(WS_END - MiB) / 4, pw, ck + 64 * rep + p);
            hipLaunchKernelGGL(dbg_cksum, dim3(2048), dim3(256), 0, stream, (const unsigned*)d_out, (size_t)M * D, pw, ck + 64 * rep + p); }
    }
    hipLaunchKernelGGL(dbg_decide, dim3(1024), dim3(256), 0, stream, (float*)d_out, (size_t)M * D, (const unsigned long long*)ck, NPH);
#else
    for (int p = 0; p < NPH; ++p) { a.ph_lo = p; a.ph_hi = p + 1; hipLaunchKernelGGL(mk_fwd, dim3(grid), dim3(NWAVES * 64), LDS_BYTES, stream, a); }
#endif
#endif
}
```

```cpp
#include <hip/hip_runtime.h>
#include <cstdio>
#include <cstdint>
namespace pg8 {
#define PG8_LAS __attribute__((address_space(3)))
#define PG8_GAS __attribute__((address_space(1)))
typedef unsigned short bf16_t;
typedef short bf16x8 __attribute__((ext_vector_type(8)));
typedef float f32x4 __attribute__((ext_vector_type(4)));
typedef unsigned u32x4 __attribute__((ext_vector_type(4)));
constexpr int BM = 256, BK = 64, HALF = 128, HTB = HALF * BK * 2  , STAGE_BYTES = 8 * HTB, NXCD = 8, WGM = 8;

__host__ __device__ __forceinline__ int lds_byte(int r, int c) { const int st = (r >> 4) * 2 + (c >> 5), rr = r & 15, cc = c & 31, ob = rr * 64 + cc * 2; return st * 1024 + (ob ^ (((ob >> 9) & 1) << 5)); }
__host__ __device__ __forceinline__ void stage_rc(int b, int& R, int& C) { const int st = b / 1024, sb = b % 1024, swz = sb ^ (((sb >> 9) & 1) << 5); R = (st >> 1) * 16 + swz / 64; C = (st & 1) * 32 + (swz % 64) / 2; }
__host__ __device__ __forceinline__ int perm32(int rho) { const int n = rho >> 4, i = rho & 15; return 8 * (i >> 2) + 4 * n + (i & 3); }

struct Unit { int pm, pn; };
struct Gemm { const bf16_t* A; const bf16_t* Bt; int M, N, K; };

struct StaticOrder {
    int nM, nN, nwg, G, c;
    __host__ __device__ void init(int M, int N, int G_, int c_) { nM = M / BM; nN = N / BM; nwg = nM * nN; G = G_; c = c_; }
    __host__ __device__ __forceinline__ bool next(int i, Unit& u) const {
        const long L = (long)i * G + c; if (L >= nwg) return false;
        int wgid = (int)L; { const int q = nwg / NXCD, r = nwg % NXCD, xcd = wgid % NXCD, off = wgid / NXCD; wgid = (xcd < r ? xcd * (q + 1) : r * (q + 1) + (xcd - r) * q) + off; }
        const int nig = WGM * nN, gid = wgid / nig, fm = gid * WGM, gsz = (nM - fm) < WGM ? (nM - fm) : WGM;
        u.pm = fm + ((wgid % nig) % gsz); u.pn = (wgid % nig) / gsz; return true;
    }
    __device__ __forceinline__ void a_ready(const Unit&) const {}
    __device__ __forceinline__ void done(const Unit&) const {}
};

__device__ __forceinline__ unsigned cvt_pk_bf16(float lo, float hi) { unsigned r; asm volatile("v_cvt_pk_bf16_f32 %0, %1, %2" : "=v"(r) : "v"(lo), "v"(hi)); return r; }
typedef float f32x2 __attribute__((ext_vector_type(2)));
__device__ __forceinline__ f32x2 gelu_pk(f32x2 v) {
    const f32x2 av = __builtin_elementwise_abs(v), d = av * 0.2316418882f + 1.0f;
    f32x2 t; t.x = __builtin_amdgcn_rcpf(d.x); t.y = __builtin_amdgcn_rcpf(d.y);
    f32x2 q = t * 0.5307027145f + (-0.7265760135f); q = q * t + 0.7107068705f; q = q * t + (-0.142248368f); q = q * t + 0.127414796f; q = q * t;
    const f32x2 s = (v * v) * (-0.72134752044f);
    f32x2 e; e.x = __builtin_amdgcn_exp2f(s.x); e.y = __builtin_amdgcn_exp2f(s.y);
    const f32x2 m = v * (q * e), r = v - m;
    f32x2 o; o.x = v.x < 0.f ? m.x : r.x; o.y = v.y < 0.f ? m.y : r.y; return o;
}

constexpr float RMS_EPS_F = 1e-6f, LOG2E_F = 1.4426950408889634f;
constexpr float QSCALE = 0.125f * 1.4426950408889634f;
__device__ __forceinline__ float gelu_tanh_f(float x) {
    constexpr float KG = -2.0f * 0.7978845608028654f * LOG2E_F;
    const float e = __builtin_amdgcn_exp2f(x * __builtin_fmaf(x * x, KG * 0.044715f, KG));
    return x * __builtin_amdgcn_rcpf(1.0f + e);
}
__device__ __forceinline__ float sigmoid_f(float x) { return __builtin_amdgcn_rcpf(1.0f + __builtin_amdgcn_exp2f(-x * LOG2E_F)); }
__device__ __forceinline__ float row_rs(const float* ssp, int row) {
    const PG8_GAS f32x4* sp = (const PG8_GAS f32x4*)(ssp + (size_t)row * 16);
    const f32x4 s0 = sp[0], s1 = sp[1], s2 = sp[2], s3 = sp[3]; __builtin_amdgcn_sched_barrier(0);
    const f32x4 a = (s0 + s1) + (s2 + s3);
    return rsqrtf(((a[0] + a[1]) + (a[2] + a[3])) * (1.0f / 1024.0f) + RMS_EPS_F);
}
__device__ __forceinline__ int mk_lane() { int l_; asm volatile("v_mbcnt_lo_u32_b32 %0, -1, 0\n\tv_mbcnt_hi_u32_b32 %0, -1, %0" : "=v"(l_)); return l_; }
__device__ __forceinline__ int mk_shfl_xor(int v, int m) { return __builtin_amdgcn_ds_bpermute((mk_lane() ^ m) << 2, v); }
__device__ __forceinline__ float mk_shfl_xor(float v, int m) { return __int_as_float(__builtin_amdgcn_ds_bpermute((mk_lane() ^ m) << 2, __float_as_int(v))); }
__device__ __forceinline__ void rs_table_update(PG8_LAS float* tab, const float* ssp, int pm, int wid) {
    const int tag = ((volatile PG8_LAS int*)tab)[256];
    if (tag != pm + 1) {
        asm volatile("s_waitcnt lgkmcnt(0)" ::: "memory"); __builtin_amdgcn_s_barrier(); asm volatile("" ::: "memory");
        int t_ = wid * 64 + mk_lane(); asm volatile("" : "+v"(t_));
        if (t_ < 256) tab[t_] = row_rs(ssp, pm * BM + t_);
        if (t_ == 0) ((volatile PG8_LAS int*)tab)[256] = pm + 1;
        asm volatile("s_waitcnt vmcnt(0) lgkmcnt(0)" ::: "memory"); __builtin_amdgcn_s_barrier(); asm volatile("" ::: "memory");
    }
}
__device__ __forceinline__ void st16_stream(void* p, const u32x4& v) { asm volatile("global_store_dwordx4 %0, %1, off sc1 nt\n\ts_nop 1" :: "v"(p), "v"(v) : "memory"); }
struct EpiInProj {
    static constexpr bool PERM = true, AFTER_DRAIN = false, HAS_MID = false;
    bf16_t *QA, *KA, *VA, *QC, *KC, *VC, *RX, *RG, *GT; const float* ssp; const float* bgate; PG8_LAS float* tab;
    __device__ __forceinline__ void operator()(const f32x4 (&acc)[2][2][4][2], const Unit& u, int wr, int wc, int fr, int fq) const {
        rs_table_update(tab, ssp, u.pm, wr * 4 + wc);
        const int pn = u.pn;
        bf16_t* base; int ldc, colt, mode;
        if (pn < 12) { const int seg = pn >> 1; base = seg == 0 ? QA : seg == 1 ? KA : seg == 2 ? VA : seg == 3 ? QC : seg == 4 ? KC : VC; ldc = 512; colt = (pn & 1) * 256; mode = (seg == 0 || seg == 3) ? 1 : 0; }
        else if (pn < 16) { base = RX; ldc = 1024; colt = (pn - 12) * 256; mode = 0; }
        else if (pn < 20) { base = RG; ldc = 1024; colt = (pn - 16) * 256; mode = 2; }
        else { base = GT; ldc = 3072; colt = (pn - 20) * 256; mode = 3; }
        const int row0 = u.pm * BM + wr * 64 + fr, col0 = colt + wc * 32 + 8 * fq;
        f32x4 bv[2][2];
#pragma unroll
        for (int bj = 0; bj < 2; ++bj)
#pragma unroll
            for (int n = 0; n < 2; ++n) bv[bj][n] = (mode == 3) ? *(const f32x4*)(bgate + col0 + bj * HALF + 4 * n) * (-LOG2E_F) : (f32x4){0.f, 0.f, 0.f, 0.f};
        const float sc = (mode == 1) ? QSCALE : 1.0f;
        float rsv[2][4];
#pragma unroll
        for (int ai = 0; ai < 2; ++ai)
#pragma unroll
            for (int m = 0; m < 4; ++m) rsv[ai][m] = tab[ai * HALF + wr * 64 + m * 16 + fr];
#pragma unroll
        for (int ai = 0; ai < 2; ++ai)
#pragma unroll
            for (int m = 0; m < 4; ++m) { const int row = row0 + ai * HALF + m * 16; const float rs = rsv[ai][m] * sc; bf16_t* rowp = base + (size_t)row * ldc + col0;
#pragma unroll
                for (int bj = 0; bj < 2; ++bj) { f32x4 v0 = acc[ai][bj][m][0] * rs, v1 = acc[ai][bj][m][1] * rs;
                    if (mode == 2) {
#pragma unroll
                        for (int e = 0; e < 4; ++e) { v0[e] = gelu_tanh_f(v0[e]); v1[e] = gelu_tanh_f(v1[e]); } }
                    if (mode == 3) { const float rsn = -rs * LOG2E_F;
#pragma unroll
                        for (int e = 0; e < 4; ++e) { v0[e] = __builtin_amdgcn_rcpf(1.0f + __builtin_amdgcn_exp2f(__builtin_fmaf(acc[ai][bj][m][0][e], rsn, bv[bj][0][e]))); v1[e] = __builtin_amdgcn_rcpf(1.0f + __builtin_amdgcn_exp2f(__builtin_fmaf(acc[ai][bj][m][1][e], rsn, bv[bj][1][e]))); } }
                    u32x4 w; w.x = cvt_pk_bf16(v0[0], v0[1]); w.y = cvt_pk_bf16(v0[2], v0[3]); w.z = cvt_pk_bf16(v1[0], v1[1]); w.w = cvt_pk_bf16(v1[2], v1[3]);
                    st16_stream(rowp + bj * HALF, w); } }
    }
};
struct EpiUp {
    static constexpr bool PERM = true, AFTER_DRAIN = false, HAS_MID = false;
    bf16_t* U; int ldc; const float* ssp; PG8_LAS float* tab;
    __device__ __forceinline__ void operator()(const f32x4 (&acc)[2][2][4][2], const Unit& u, int wr, int wc, int fr, int fq) const {
        rs_table_update(tab, ssp, u.pm, wr * 4 + wc);
        const int row0 = u.pm * BM + wr * 64 + fr, col0 = u.pn * BM + wc * 32 + 8 * fq;
#pragma unroll
        for (int ai = 0; ai < 2; ++ai)
#pragma unroll
            for (int m = 0; m < 4; ++m) { const int row = row0 + ai * HALF + m * 16; const float rs = tab[ai * HALF + wr * 64 + m * 16 + fr]; bf16_t* rowp = U + (size_t)row * ldc + col0;
#pragma unroll
                for (int bj = 0; bj < 2; ++bj) { const f32x4 v0 = acc[ai][bj][m][0] * rs, v1 = acc[ai][bj][m][1] * rs;
                    u32x4 w; w.x = cvt_pk_bf16(v0[0], v0[1]); w.y = cvt_pk_bf16(v0[2], v0[3]); w.z = cvt_pk_bf16(v1[0], v1[1]); w.w = cvt_pk_bf16(v1[2], v1[3]);
                    *(u32x4*)(rowp + bj * HALF) = w; } }
    }
};
__device__ __forceinline__ float dpp_prev(float cur, float prevgrp, int n  ) {
    const int rot = n == 1 ? __builtin_amdgcn_update_dpp(0, __float_as_int(prevgrp), 0x121, 0xf, 0xf, false) : __builtin_amdgcn_update_dpp(0, __float_as_int(prevgrp), 0x122, 0xf, 0xf, false);
    const int r = n == 1 ? __builtin_amdgcn_update_dpp(rot, __float_as_int(cur), 0x111, 0xf, 0xf, false) : __builtin_amdgcn_update_dpp(rot, __float_as_int(cur), 0x112, 0xf, 0xf, false);
    return __int_as_float(r);
}
struct EpiUpAct {
    static constexpr bool PERM = true, AFTER_DRAIN = false, HAS_MID = false;
    bf16_t* ACT; bf16_t* UH; const float* ssp; PG8_LAS float* tab; const float* cw; const float* cb; PG8_LAS float* ctw;
    __device__ __forceinline__ void operator()(f32x4 (&acc)[2][2][4][2], const Unit& u, int wr, int wc, int fr, int fq) const {
        rs_table_update(tab, ssp, u.pm, wr * 4 + wc);
        int tl_ = mk_lane(); asm volatile("" : "+v"(tl_)); const int fr_ = tl_ & 15, fq_ = (tl_ >> 4) & 3; (void)fr; (void)fq;
        const int c0 = u.pn * 128 + wc * 32 + 8 * fq_;
        int t_ = (wr * 4 + wc) * 64 + mk_lane(); asm volatile("" : "+v"(t_));
        float cwv[2];
#pragma unroll
        for (int i = 0; i < 2; ++i) { const int idx = t_ + i * 512, bjk = idx >> 7, chl = idx & 127, bj = bjk >> 2, k = bjk & 3; cwv[i] = ((const PG8_GAS float*)(k < 3 ? cw + (size_t)k * 5632 : cb))[bj * 2816 + u.pn * 128 + chl]; }
        const PG8_LAS float* cl = ctw + wc * 32 + 8 * fq_;
        constexpr int DFF_ = 2816, DFF2_ = 5632;
#pragma unroll
        for (int ai = 0; ai < 2; ++ai) {
            __builtin_amdgcn_sched_barrier(0);
#pragma unroll
            for (int m = 0; m < 4; ++m) { const float rs = tab[ai * HALF + wr * 64 + m * 16 + fr_];
#pragma unroll
                for (int bj = 0; bj < 2; ++bj) { acc[ai][bj][m][0] = acc[ai][bj][m][0] * rs; acc[ai][bj][m][1] = acc[ai][bj][m][1] * rs; } }
            { const int slab = u.pm * 4 + ai * 2 + wr;
              int fh_ = fr_; asm volatile("" : "+v"(fh_));
              if (fh_ < 2 || fh_ >= 14) { const int mm = fh_ < 2 ? 0 : 3, k = fh_ < 2 ? fh_ : fh_ - 12; bf16_t* hp = UH + (unsigned)((slab * 4 + k) * DFF2_ + c0);
#pragma unroll
                  for (int bj = 0; bj < 2; ++bj) { const f32x4 v0 = mm == 0 ? acc[ai][bj][0][0] : acc[ai][bj][3][0], v1 = mm == 0 ? acc[ai][bj][0][1] : acc[ai][bj][3][1];
                      u32x4 w; w.x = cvt_pk_bf16(v0[0], v0[1]); w.y = cvt_pk_bf16(v0[2], v0[3]); w.z = cvt_pk_bf16(v1[0], v1[1]); w.w = cvt_pk_bf16(v1[2], v1[3]); *(PG8_GAS u32x4*)(hp + bj * DFF_) = w; } } }
            __builtin_amdgcn_sched_barrier(0);
        }
        ctw[t_] = cwv[0]; ctw[t_ + 512] = cwv[1];
        asm volatile("s_waitcnt lgkmcnt(0)" ::: "memory"); __builtin_amdgcn_s_barrier(); asm volatile("" ::: "memory");
#pragma unroll
        for (int ai = 0; ai < 2; ++ai) {
            __builtin_amdgcn_sched_barrier(0);
#pragma unroll
            for (int n = 0; n < 2; ++n) {
#pragma unroll
                for (int bj = 0; bj < 2; ++bj) {
                    const f32x4 w0 = *(const PG8_LAS f32x4*)(cl + (bj * 4 + 0) * 128 + 4 * n), w1 = *(const PG8_LAS f32x4*)(cl + (bj * 4 + 1) * 128 + 4 * n), w2 = *(const PG8_LAS f32x4*)(cl + (bj * 4 + 2) * 128 + 4 * n), bia = *(const PG8_LAS f32x4*)(cl + (bj * 4 + 3) * 128 + 4 * n);
#pragma unroll
                    for (int m = 3; m >= 0; --m) { f32x4 o; float t1[4], t2[4];
#pragma unroll
                        for (int e = 0; e < 4; ++e) { const float cur = acc[ai][bj][m][n][e], pg = m > 0 ? acc[ai][bj][m > 0 ? m - 1 : 0][n][e] : 0.f;
                            t1[e] = fr_ == 15 ? pg : cur; t2[e] = fr_ >= 14 ? pg : cur; o[e] = bia[e] + w2[e] * cur; }
                        __builtin_amdgcn_sched_barrier(0);
                        asm volatile("s_nop 1\n\t"
                                     "v_fmac_f32_dpp %0, %4, %12 row_ror:1 row_mask:0xf bank_mask:0xf\n\tv_fmac_f32_dpp %1, %5, %13 row_ror:1 row_mask:0xf bank_mask:0xf\n\t"
                                     "v_fmac_f32_dpp %2, %6, %14 row_ror:1 row_mask:0xf bank_mask:0xf\n\tv_fmac_f32_dpp %3, %7, %15 row_ror:1 row_mask:0xf bank_mask:0xf\n\t"
                                     "v_fmac_f32_dpp %0, %8, %16 row_ror:2 row_mask:0xf bank_mask:0xf\n\tv_fmac_f32_dpp %1, %9, %17 row_ror:2 row_mask:0xf bank_mask:0xf\n\t"
                                     "v_fmac_f32_dpp %2, %10, %18 row_ror:2 row_mask:0xf bank_mask:0xf\n\tv_fmac_f32_dpp %3, %11, %19 row_ror:2 row_mask:0xf bank_mask:0xf\n\ts_nop 0"
                                     : "+v"(o[0]), "+v"(o[1]), "+v"(o[2]), "+v"(o[3])
                                     : "v"(t1[0]), "v"(t1[1]), "v"(t1[2]), "v"(t1[3]), "v"(t2[0]), "v"(t2[1]), "v"(t2[2]), "v"(t2[3]),
                                       "v"(w1[0]), "v"(w1[1]), "v"(w1[2]), "v"(w1[3]), "v"(w0[0]), "v"(w0[1]), "v"(w0[2]), "v"(w0[3]));
                        acc[ai][bj][m][n] = o; __builtin_amdgcn_sched_barrier(0); }
                    __builtin_amdgcn_sched_barrier(0); }
#pragma unroll
                for (int m = 0; m < 4; ++m)
#pragma unroll
                    for (int e = 0; e < 4; ++e) { acc[ai][0][m][n][e] = gelu_tanh_f(acc[ai][0][m][n][e]) * acc[ai][1][m][n][e]; if (e == 3) __builtin_amdgcn_sched_barrier(0); }
            }
            int fs_ = fr_, cs_ = c0; asm volatile("" : "+v"(fs_), "+v"(cs_));
#pragma unroll
            for (int m = 0; m < 4; ++m) { __builtin_amdgcn_sched_barrier(0); const int row = u.pm * BM + ai * HALF + wr * 64 + m * 16 + fs_; const f32x4 v0 = acc[ai][0][m][0], v1 = acc[ai][0][m][1];
                u32x4 w; w.x = cvt_pk_bf16(v0[0], v0[1]); w.y = cvt_pk_bf16(v0[2], v0[3]); w.z = cvt_pk_bf16(v1[0], v1[1]); w.w = cvt_pk_bf16(v1[2], v1[3]);
                st16_stream(ACT + (unsigned)(row * DFF_ + cs_), w); }
        }
    }
};
__device__ __forceinline__ float bf_lo(unsigned w) { return __uint_as_float(w << 16); }
__device__ __forceinline__ float bf_hi(unsigned w) { return __uint_as_float(w & 0xffff0000u); }
template <bool FIRST> struct EpiBranch {
    static constexpr bool PERM = true, AFTER_DRAIN = false, HAS_MID = false;
    bf16_t* MG; const bf16_t* GT; int gcol;
    __device__ __forceinline__ void operator()(const f32x4 (&acc)[2][2][4][2], const Unit& u, int wr, int wc, int fr, int fq) const {
        const int row0 = u.pm * BM + wr * 64 + fr, col0 = u.pn * BM + wc * 32 + 8 * fq;
#pragma unroll
        for (int ai = 0; ai < 2; ++ai)
#pragma unroll
            for (int m = 0; m < 4; ++m) { const int row = row0 + ai * HALF + m * 16; bf16_t* rowp = MG + (size_t)row * 1024 + col0; const bf16_t* gp = GT + (size_t)row * 3072 + gcol + col0;
#pragma unroll
                for (int bj = 0; bj < 2; ++bj) { const u32x4 g = *(const u32x4*)(gp + bj * HALF); const f32x4 a0 = acc[ai][bj][m][0], a1 = acc[ai][bj][m][1];
                    f32x4 v0, v1;
                    v0[0] = bf_lo(g.x) * a0[0]; v0[1] = bf_hi(g.x) * a0[1]; v0[2] = bf_lo(g.y) * a0[2]; v0[3] = bf_hi(g.y) * a0[3];
                    v1[0] = bf_lo(g.z) * a1[0]; v1[1] = bf_hi(g.z) * a1[1]; v1[2] = bf_lo(g.w) * a1[2]; v1[3] = bf_hi(g.w) * a1[3];
                    if (!FIRST) { const u32x4 p = *(const u32x4*)(rowp + bj * HALF);
                        v0[0] += bf_lo(p.x); v0[1] += bf_hi(p.x); v0[2] += bf_lo(p.y); v0[3] += bf_hi(p.y); v1[0] += bf_lo(p.z); v1[1] += bf_hi(p.z); v1[2] += bf_lo(p.w); v1[3] += bf_hi(p.w); }
                    u32x4 w; w.x = cvt_pk_bf16(v0[0], v0[1]); w.y = cvt_pk_bf16(v0[2], v0[3]); w.z = cvt_pk_bf16(v1[0], v1[1]); w.w = cvt_pk_bf16(v1[2], v1[3]);
                    *(u32x4*)(rowp + bj * HALF) = w; }
                asm volatile("" ::: "memory"); }
    }
};
struct EpiBranchFused {
    static constexpr bool PERM = true, AFTER_DRAIN = false, HAS_MID = true;
    bf16_t* MG; const bf16_t* GT;
    __device__ __forceinline__ void scale(f32x4 (&acc)[2][2][4][2], const Unit& u, int wr, int wc, int fr, int fq, int gnum  , int gden  ) const {
        int fr_ = fr, fq_ = fq; asm volatile("" : "+v"(fr_), "+v"(fq_));
        const int row0 = u.pm * BM + wr * 64 + fr_, col0 = u.pn * BM + wc * 32 + 8 * fq_;
#pragma unroll
        for (int ai = 0; ai < 2; ++ai) {
            u32x4 gnv[4][2], gdv[4][2];
#pragma unroll
            for (int m = 0; m < 4; ++m) { const PG8_GAS bf16_t* gp = (const PG8_GAS bf16_t*)GT + (size_t)(row0 + ai * HALF + m * 16) * 3072 + col0;
#pragma unroll
                for (int bj = 0; bj < 2; ++bj) { gnv[m][bj] = *(const PG8_GAS u32x4*)(gp + gnum * 1024 + bj * HALF); if (gden >= 0) gdv[m][bj] = *(const PG8_GAS u32x4*)(gp + gden * 1024 + bj * HALF); } }
            __builtin_amdgcn_sched_barrier(0);
#pragma unroll
            for (int m = 0; m < 4; ++m)
#pragma unroll
                for (int bj = 0; bj < 2; ++bj) { const u32x4 gn = gnv[m][bj]; f32x4 r0, r1;
                    r0[0] = bf_lo(gn.x); r0[1] = bf_hi(gn.x); r0[2] = bf_lo(gn.y); r0[3] = bf_hi(gn.y); r1[0] = bf_lo(gn.z); r1[1] = bf_hi(gn.z); r1[2] = bf_lo(gn.w); r1[3] = bf_hi(gn.w);
                    if (gden >= 0) { const u32x4 gd = gdv[m][bj];
                        r0[0] *= __builtin_amdgcn_rcpf(bf_lo(gd.x)); r0[1] *= __builtin_amdgcn_rcpf(bf_hi(gd.x)); r0[2] *= __builtin_amdgcn_rcpf(bf_lo(gd.y)); r0[3] *= __builtin_amdgcn_rcpf(bf_hi(gd.y));
                        r1[0] *= __builtin_amdgcn_rcpf(bf_lo(gd.z)); r1[1] *= __builtin_amdgcn_rcpf(bf_hi(gd.z)); r1[2] *= __builtin_amdgcn_rcpf(bf_lo(gd.w)); r1[3] *= __builtin_amdgcn_rcpf(bf_hi(gd.w)); }
                    acc[ai][bj][m][0] = acc[ai][bj][m][0] * r0; acc[ai][bj][m][1] = acc[ai][bj][m][1] * r1; }
            __builtin_amdgcn_sched_barrier(0); }
    }
    __device__ __forceinline__ void mid(f32x4 (&acc)[2][2][4][2], const Unit& u, int t, int wr, int wc, int fr, int fq) const {
        if (t == 8) scale(acc, u, wr, wc, fr, fq, 0, 1); else if (t == 24) scale(acc, u, wr, wc, fr, fq, 1, 2);
    }
    __device__ __forceinline__ void operator()(f32x4 (&acc)[2][2][4][2], const Unit& u, int wr, int wc, int fr, int fq) const {
        scale(acc, u, wr, wc, fr, fq, 2, -1);
        const int row0 = u.pm * BM + wr * 64 + fr, col0 = u.pn * BM + wc * 32 + 8 * fq;
#pragma unroll
        for (int ai = 0; ai < 2; ++ai)
#pragma unroll
            for (int m = 0; m < 4; ++m) { bf16_t* rowp = MG + (size_t)(row0 + ai * HALF + m * 16) * 1024 + col0;
#pragma unroll
                for (int bj = 0; bj < 2; ++bj) { const f32x4 v0 = acc[ai][bj][m][0], v1 = acc[ai][bj][m][1];
                    u32x4 w; w.x = cvt_pk_bf16(v0[0], v0[1]); w.y = cvt_pk_bf16(v0[2], v0[3]); w.z = cvt_pk_bf16(v1[0], v1[1]); w.w = cvt_pk_bf16(v1[2], v1[3]);
                    *(PG8_GAS u32x4*)(rowp + bj * HALF) = w; } }
    }
};
#ifndef RESID_LO
#define RESID_LO 0
#endif
struct EpiResid {
    static constexpr bool PERM = true, AFTER_DRAIN = false, HAS_MID = false;
    const float* base32; bf16_t* xb; bf16_t* xl; float* ssp;
    __device__ __forceinline__ void operator()(const f32x4 (&acc)[2][2][4][2], const Unit& u, int wr, int wc, int fr, int fq) const {
        static_assert(RESID_LO == 0, "this epilogue keeps the residual stream in xb only");
        const int row0 = u.pm * BM + wr * 64 + fr, col0 = u.pn * BM + wc * 32 + 8 * fq;
        PG8_GAS bf16_t* xg = (PG8_GAS bf16_t*)xb; PG8_GAS float* sg = (PG8_GAS float*)ssp;
        u32x4 hb[2][4][2];
#pragma unroll
        for (int ai = 0; ai < 2; ++ai)
#pragma unroll
            for (int m = 0; m < 4; ++m)
#pragma unroll
                for (int bj = 0; bj < 2; ++bj) hb[ai][m][bj] = *(const PG8_GAS u32x4*)(xg + (size_t)(row0 + ai * HALF + m * 16) * 1024 + col0 + bj * HALF);
        __builtin_amdgcn_sched_barrier(0);
#pragma unroll
        for (int ai = 0; ai < 2; ++ai)
#pragma unroll
            for (int m = 0; m < 4; ++m) { const int row = row0 + ai * HALF + m * 16; const size_t off = (size_t)row * 1024 + col0; float s = 0.f;
#pragma unroll
                for (int bj = 0; bj < 2; ++bj) { const u32x4 hw = hb[ai][m][bj]; f32x4 b0, b1;
                    b0[0] = bf_lo(hw.x); b0[1] = bf_hi(hw.x); b0[2] = bf_lo(hw.y); b0[3] = bf_hi(hw.y); b1[0] = bf_lo(hw.z); b1[1] = bf_hi(hw.z); b1[2] = bf_lo(hw.w); b1[3] = bf_hi(hw.w);
                    const f32x4 o0 = b0 + acc[ai][bj][m][0], o1 = b1 + acc[ai][bj][m][1];
                    s += ((o0[0] * o0[0] + o0[1] * o0[1]) + (o0[2] * o0[2] + o0[3] * o0[3])) + ((o1[0] * o1[0] + o1[1] * o1[1]) + (o1[2] * o1[2] + o1[3] * o1[3]));
                    u32x4 w; w.x = cvt_pk_bf16(o0[0], o0[1]); w.y = cvt_pk_bf16(o0[2], o0[3]); w.z = cvt_pk_bf16(o1[0], o1[1]); w.w = cvt_pk_bf16(o1[2], o1[3]); *(PG8_GAS u32x4*)(xg + off + bj * HALF) = w; }
                s += mk_shfl_xor(s, 16); s += mk_shfl_xor(s, 32);
                if (fq == 0) sg[(size_t)row * 16 + u.pn * 4 + wc] = s; }
    }
};
template <class Epi, class Sched, bool ALIGN_EPI = false, bool SP2 = false>
__device__ __forceinline__ void gemm_phase(PG8_LAS unsigned char* lds, const Gemm g, const Sched& S, const Epi& E, int wave_id) {
    int tid_ = wave_id * 64 + mk_lane(); asm volatile("" : "+v"(tid_));
    const int tid = tid_, wid = __builtin_amdgcn_readfirstlane(tid >> 6), lane = tid & 63, wr = wid >> 2, wc = wid & 3, fr = lane & 15, fq = lane >> 4;
    const int K = g.K, nt = K / BK;
    unsigned voffA[2], voffB[2];
#define PG8_VOFF(T_) do { _Pragma("unroll") for (int i = 0; i < 2; ++i) { int R, C; stage_rc((T_) * 16 + i * 8192, R, C); const int Rb = Epi::PERM ? ((R & ~31) + perm32(R & 31)) : R; \
        voffA[i] = (unsigned)(R * K + C) * 2u; voffB[i] = (unsigned)(Rb * K + C) * 2u; } } while (0)
    PG8_VOFF(tid);
    const size_t kstep = (size_t)(BK * 2);
    const size_t hstep = (size_t)HALF * K * 2;
    const size_t tstep = 2 * hstep;
    const unsigned ldsw = (unsigned)wid * 1024u;
    const int aoff = lds_byte(wr * 64 + fr, fq * 8), boff = lds_byte(wc * 32 + fr, fq * 8);
#define PG8_SA(b, h) (((b) * 2 + (h)) * HTB)
#define PG8_SB(b, h) ((4 + (b) * 2 + (h)) * HTB)
#define PG8_STAGE(bufoff, gbase, voff) do { _Pragma("unroll") for (int _i = 0; _i < 2; ++_i) \
        __builtin_amdgcn_global_load_lds((const unsigned*)((const char*)(gbase) + (voff)[_i]), (PG8_LAS unsigned*)(lds + (bufoff) + ldsw + _i * 8192), 16, 0, 0); } while (0)
#define PG8_LDA(dst, b, h) do { _Pragma("unroll") for (int m = 0; m < 4; ++m) _Pragma("unroll") for (int k = 0; k < 2; ++k) dst[m][k] = *(const PG8_LAS bf16x8*)(lds + PG8_SA(b, h) + aoff + m * 2048 + k * 1024); } while (0)
#define PG8_LDB(dst, b, h) do { _Pragma("unroll") for (int n = 0; n < 2; ++n) _Pragma("unroll") for (int k = 0; k < 2; ++k) dst[n][k] = *(const PG8_LAS bf16x8*)(lds + PG8_SB(b, h) + boff + n * 2048 + k * 1024); } while (0)
#define PG8_MMA(ai, bj, At, Bt) do { __builtin_amdgcn_s_setprio(1); _Pragma("unroll") for (int m = 0; m < 4; ++m) _Pragma("unroll") for (int n = 0; n < 2; ++n) _Pragma("unroll") for (int k = 0; k < 2; ++k) \
        acc[ai][bj][m][n] = __builtin_amdgcn_mfma_f32_16x16x32_bf16(Bt[n][k], At[m][k], acc[ai][bj][m][n], 0, 0, 0); __builtin_amdgcn_s_setprio(0); } while (0)
#define PG8_WAIT_V(n) asm volatile("s_waitcnt vmcnt(" #n ")" ::: "memory")
#define PG8_WAIT_L(n) asm volatile("s_waitcnt lgkmcnt(" #n ")" ::: "memory")
#define PG8_BAR __builtin_amdgcn_s_barrier()
#define PG8_SCHED __builtin_amdgcn_sched_barrier(0)
    Unit cur, nxt; int ui = 0;
    if (!S.next(0, cur)) return;
    f32x4 acc[2][2][4][2];
#pragma unroll
    for (int a = 0; a < 2; ++a)
#pragma unroll
        for (int b = 0; b < 2; ++b)
#pragma unroll
            for (int m = 0; m < 4; ++m)
#pragma unroll
                for (int n = 0; n < 2; ++n) acc[a][b][m][n] = (f32x4){0.f, 0.f, 0.f, 0.f};
    bf16x8 At[4][2], B0[2][2], B1[2][2];
    const char* cA = (const char*)g.A + (size_t)cur.pm * tstep; const char* cB = (const char*)g.Bt + (size_t)cur.pn * tstep;
    S.a_ready(cur);
    if constexpr (SP2) {
        PG8_STAGE(PG8_SB(0, 0), cB, voffB); PG8_STAGE(PG8_SB(0, 1), cB + hstep, voffB); PG8_STAGE(PG8_SA(0, 0), cA, voffA); PG8_STAGE(PG8_SA(0, 1), cA + hstep, voffA);
        if (wr == 1) PG8_BAR;
        PG8_WAIT_V(2); PG8_BAR;
        PG8_STAGE(PG8_SB(1, 0), cB + kstep, voffB); PG8_STAGE(PG8_SA(1, 0), cA + kstep, voffA); PG8_STAGE(PG8_SB(1, 1), cB + hstep + kstep, voffB);
        PG8_WAIT_V(6); PG8_BAR;
    } else {
        PG8_STAGE(PG8_SB(0, 0), cB, voffB); PG8_STAGE(PG8_SA(0, 0), cA, voffA); PG8_STAGE(PG8_SB(0, 1), cB + hstep, voffB); PG8_STAGE(PG8_SA(0, 1), cA + hstep, voffA);
        if (wr == 1) PG8_BAR;
        PG8_WAIT_V(4); PG8_BAR;
        PG8_STAGE(PG8_SB(1, 0), cB + kstep, voffB); PG8_STAGE(PG8_SA(1, 0), cA + kstep, voffA); PG8_STAGE(PG8_SB(1, 1), cB + hstep + kstep, voffB);
        PG8_WAIT_V(6); PG8_BAR;
    }
    for (;;) {
        if (ui > 0) { int tu_ = wave_id * 64 + mk_lane(); asm volatile("" : "+v"(tu_)); PG8_VOFF(tu_); }
        const bool has_next = S.next(ui + 1, nxt);
        const char* nA = has_next ? (const char*)g.A + (size_t)nxt.pm * tstep : cA; const char* nB = has_next ? (const char*)g.Bt + (size_t)nxt.pn * tstep : cB;
#pragma unroll
        for (int seg_ = 0; seg_ < (Epi::HAS_MID ? 3 : 1); ++seg_) {
        int tb_ = 0, te_ = nt; if constexpr (Epi::HAS_MID) { tb_ = seg_ == 0 ? 0 : seg_ == 1 ? 8 : 24; te_ = seg_ == 0 ? 8 : seg_ == 1 ? 24 : nt; if (seg_ > 0) E.mid(acc, cur, tb_, wr, wc, fr, fq); }
        for (int t = tb_; t < te_; t += 2) {
            const bool last = (t == nt - 2);
            const char* a1 = cA + (size_t)(t + 1) * kstep;
            const char* a2 = last ? nA : cA + (size_t)(t + 2) * kstep; const char* b2 = last ? nB : cB + (size_t)(t + 2) * kstep;
            const char* a3 = a2 + kstep; const char* b3 = b2 + kstep;
            if (last && has_next) S.a_ready(nxt);
            if constexpr (SP2) {
            PG8_LDB(B0, 0, 0); PG8_LDB(B1, 0, 1); PG8_SCHED; PG8_LDA(At, 0, 0); PG8_STAGE(PG8_SA(1, 1), a1 + hstep, voffA);
            PG8_WAIT_V(8); PG8_WAIT_L(0); PG8_BAR; PG8_MMA(0, 0, At, B0); PG8_MMA(0, 1, At, B1); PG8_BAR; PG8_SCHED;
            PG8_LDA(At, 0, 1); PG8_STAGE(PG8_SB(0, 0), b2, voffB); PG8_STAGE(PG8_SB(0, 1), b2 + hstep, voffB); PG8_STAGE(PG8_SA(0, 0), a2, voffA);
            PG8_WAIT_V(8); PG8_WAIT_L(0); PG8_BAR; PG8_MMA(1, 0, At, B0); PG8_MMA(1, 1, At, B1); PG8_BAR; PG8_SCHED;
            PG8_LDB(B0, 1, 0); PG8_LDB(B1, 1, 1); PG8_SCHED; PG8_LDA(At, 1, 0); PG8_STAGE(PG8_SA(0, 1), a2 + hstep, voffA);
            PG8_WAIT_V(8); PG8_WAIT_L(0); PG8_BAR; PG8_MMA(0, 0, At, B0); PG8_MMA(0, 1, At, B1); PG8_BAR; PG8_SCHED;
            PG8_LDA(At, 1, 1); PG8_STAGE(PG8_SB(1, 0), b3, voffB); PG8_STAGE(PG8_SB(1, 1), b3 + hstep, voffB); PG8_STAGE(PG8_SA(1, 0), a3, voffA);
            PG8_WAIT_V(8); PG8_WAIT_L(0); PG8_BAR; PG8_MMA(1, 0, At, B0); PG8_MMA(1, 1, At, B1); PG8_BAR; PG8_SCHED;
            } else {
            PG8_LDB(B0, 0, 0); PG8_SCHED; PG8_LDA(At, 0, 0); PG8_STAGE(PG8_SA(1, 1), a1 + hstep, voffA);
            PG8_WAIT_L(8); PG8_BAR; PG8_WAIT_L(0); PG8_MMA(0, 0, At, B0); PG8_BAR; PG8_SCHED;
            PG8_LDB(B1, 0, 1); PG8_STAGE(PG8_SB(0, 0), b2, voffB);
            PG8_BAR; PG8_WAIT_L(0); PG8_MMA(0, 1, At, B1); PG8_BAR;
            PG8_LDA(At, 0, 1); PG8_STAGE(PG8_SA(0, 0), a2, voffA);
            PG8_BAR; PG8_WAIT_L(0); PG8_MMA(1, 0, At, B0); PG8_BAR; PG8_SCHED;
            PG8_STAGE(PG8_SB(0, 1), b2 + hstep, voffB);
            PG8_WAIT_V(6); PG8_BAR; PG8_MMA(1, 1, At, B1); PG8_BAR;
            PG8_LDB(B0, 1, 0); PG8_SCHED; PG8_LDA(At, 1, 0); PG8_STAGE(PG8_SA(0, 1), a2 + hstep, voffA);
            PG8_WAIT_L(8); PG8_BAR; PG8_WAIT_L(0); PG8_MMA(0, 0, At, B0); PG8_BAR; PG8_SCHED;
            PG8_LDB(B1, 1, 1); PG8_STAGE(PG8_SB(1, 0), b3, voffB);
            PG8_BAR; PG8_WAIT_L(0); PG8_MMA(0, 1, At, B1); PG8_BAR;
            PG8_LDA(At, 1, 1); PG8_STAGE(PG8_SA(1, 0), a3, voffA);
            PG8_BAR; PG8_WAIT_L(0); PG8_MMA(1, 0, At, B0); PG8_BAR; PG8_SCHED;
            PG8_STAGE(PG8_SB(1, 1), b3 + hstep, voffB);
            PG8_WAIT_V(6); PG8_BAR; PG8_MMA(1, 1, At, B1); PG8_BAR;
            }
        }
        }
        if constexpr (ALIGN_EPI) { if (wr == 0) PG8_BAR; }
        if constexpr (!Epi::AFTER_DRAIN) { E(acc, cur, wr, wc, fr, fq); S.done(cur); }
        if (!has_next) break;
#pragma unroll
        for (int a = 0; a < 2; ++a)
#pragma unroll
            for (int b = 0; b < 2; ++b)
#pragma unroll
                for (int m = 0; m < 4; ++m)
#pragma unroll
                    for (int n = 0; n < 2; ++n) acc[a][b][m][n] = (f32x4){0.f, 0.f, 0.f, 0.f};
        cur = nxt; cA = nA; cB = nB; ++ui;
        if constexpr (ALIGN_EPI) { if (wr == 1) PG8_BAR; }
    }
    PG8_WAIT_V(0);
    if constexpr (!ALIGN_EPI) { if (wr == 0) PG8_BAR; }
    PG8_BAR;
    if constexpr (Epi::AFTER_DRAIN) { E.fused(acc, cur, wr, wc, fr, fq, lds, wid, lane); S.done(cur); }
#undef PG8_VOFF
#undef PG8_SA
#undef PG8_SB
#undef PG8_STAGE
#undef PG8_LDA
#undef PG8_LDB
#undef PG8_MMA
#undef PG8_WAIT_V
#undef PG8_WAIT_L
#undef PG8_BAR
#undef PG8_SCHED
}
}
using pg8::bf_lo; using pg8::bf_hi; using pg8::mk_shfl_xor; using pg8::mk_lane;
#include <cmath>

constexpr int NWAVES = 8;
#ifndef USE_MFMA_DIFF
#define USE_MFMA_DIFF 1
#endif
#ifndef USE_ACT_FUSE
#define USE_ACT_FUSE 1
#endif
#ifndef USE_MFMA_RG
#define USE_MFMA_RG 1
#endif
#ifndef USE_MFMA_MOBA
#define USE_MFMA_MOBA 1
#endif
#ifndef DBG_TIMING
#define DBG_TIMING 0
#endif
#define DBG_SEL1 0
#define DBG_QOFF 0.0f
#define DBG_SEL2 1
#ifndef MK_ONE_LAUNCH
#define MK_ONE_LAUNCH 1
#endif

constexpr int BATCH = 4, SEQ = 4096, D = 1024, DEPTH = 4;
constexpr int M = BATCH * SEQ;
constexpr int IN_COLS = 8192, DFF = 2816, DFF2 = 5632;
constexpr int MOBA_H = 8, MOBA_BLK = 256, MOBA_NB = SEQ / MOBA_BLK;
constexpr int DIFF_H = 4;
constexpr int RG_NB = 16, RG_CHUNK = 64, RG_NCH = SEQ / RG_CHUNK;
constexpr float LOG2E = 1.4426950408889634f;

constexpr size_t MiB = 1u << 20;
constexpr size_t WS_CTL = 0, CTL_ZERO_BYTES = 1 * MiB;
constexpr size_t WS_WIN = 1 * MiB;
constexpr size_t WS_WA = 17 * MiB;
constexpr size_t WS_WB = 18 * MiB;
constexpr size_t WS_WC = 20 * MiB;
constexpr size_t WS_WO = 21 * MiB;
constexpr size_t WS_WUP = 23 * MiB;
constexpr size_t WS_WDN = 34 * MiB;
constexpr size_t WS_SS = 40 * MiB;
constexpr size_t WS_KMEAN = 41 * MiB;
constexpr size_t WS_AGG = 42 * MiB;
constexpr size_t WS_CARRY = 44 * MiB;
constexpr size_t WS_RGW = 45 * MiB;
constexpr size_t WS_PROJ = 48 * MiB;
constexpr size_t WS_QA = WS_PROJ, WS_KA = WS_QA + 16 * MiB, WS_VA = WS_KA + 16 * MiB, WS_QC = WS_VA + 16 * MiB, WS_KC = WS_QC + 16 * MiB, WS_VC = WS_KC + 16 * MiB;
constexpr size_t WS_RX = WS_VC + 16 * MiB, WS_RG = WS_RX + 32 * MiB;
constexpr size_t WS_GT = WS_RG + 32 * MiB;
constexpr size_t WS_XB = 304 * MiB;
constexpr size_t WS_Y = 336 * MiB;
constexpr int YP = 2048, YA_COL = 0, YB_COL = 512, YC_COL = 1536;
constexpr size_t WS_YA = WS_Y + YA_COL * 2, WS_YB = WS_Y + YB_COL * 2, WS_YC = WS_Y + YC_COL * 2;
constexpr size_t WS_MG = 400 * MiB;
constexpr size_t WS_U = WS_PROJ;
constexpr size_t WS_ACT = 336 * MiB;
constexpr size_t WS_DSCR = WS_MG;
constexpr size_t WS_XL = 432 * MiB;
constexpr size_t WS_X32 = 432 * MiB;
constexpr size_t WS_END = 464 * MiB;
static_assert(WS_GT + (size_t)M * 3072 * 2 == WS_XB && WS_U + (size_t)M * DFF2 * 2 <= WS_XB && WS_ACT + (size_t)M * DFF * 2 <= WS_XL && WS_XL + (size_t)M * D * 2 <= WS_END, "d_ws map");
constexpr int CW_BAR = 4096;

constexpr int RING_OFF = 0, RING_BYTES = 153600;
constexpr int LDSCTL_OFF = RING_BYTES, MISC_OFF = LDSCTL_OFF + 320;
constexpr int RSTAB_OFF = LDSCTL_OFF + 1024;
constexpr int LDS_BYTES = 163840;

#define GAS __attribute__((address_space(1)))
#define LAS __attribute__((address_space(3)))
typedef unsigned short bf16;
typedef unsigned v4u __attribute__((ext_vector_type(4)));
typedef float f32x4 __attribute__((ext_vector_type(4)));
typedef short bf16x8 __attribute__((ext_vector_type(8)));
typedef GAS unsigned gu32;
typedef GAS unsigned long long gu64;
#define RLX_AGENT __ATOMIC_RELAXED, __HIP_MEMORY_SCOPE_AGENT
#define LDS_WAIT() asm volatile("s_waitcnt lgkmcnt(0)" ::: "memory")
#define VM_WAIT() asm volatile("s_waitcnt vmcnt(0)" ::: "memory")
__device__ __forceinline__ unsigned long long rt() { return __builtin_amdgcn_s_memrealtime(); }
typedef float mk_f32x2 __attribute__((ext_vector_type(2))); typedef __bf16 mk_bf16x2 __attribute__((ext_vector_type(2)));
__device__ __forceinline__ unsigned pk2(float lo, float hi) { mk_f32x2 v = {lo, hi}; mk_bf16x2 b = __builtin_convertvector(v, mk_bf16x2); return __builtin_bit_cast(unsigned, b); }
__device__ __forceinline__ unsigned f2bf(float f) { return pk2(f, 0.f) & 0xffffu; }

#define XB_TMO      128
#define XB_XCNT(j)  (256  + 64 * (j))
#define XB_XSUB(j)  (1280 + 64 * (j))
#define XB_XGEN(j)  (2304 + 64 * (j))
#define XB_TOP      3328
#define XB_TOPGEN   3392
#define XCD_BAR_WORDS 3456
#define XB_SPIN_CAP (1u << 24)

__device__ __forceinline__ unsigned xb_ld(unsigned* p)              { return __hip_atomic_load(p, __ATOMIC_RELAXED, __HIP_MEMORY_SCOPE_AGENT); }
__device__ __forceinline__ unsigned xb_add(unsigned* p, unsigned v) { return __hip_atomic_fetch_add(p, v, __ATOMIC_RELAXED, __HIP_MEMORY_SCOPE_AGENT); }
__device__ __forceinline__ unsigned xb_xcc_id() { return (unsigned)__builtin_amdgcn_s_getreg((3 << 11) | 20) & 0xFu; }
#define XB_SPIN(cond, bar) do { unsigned _sp = 0; while (cond) { __builtin_amdgcn_s_sleep(1); \
    if ((++_sp & 255u) == 0u) { if (xb_ld(&(bar)[XB_TMO])) break; if (_sp > XB_SPIN_CAP) { atomicAdd(&(bar)[XB_TMO], 1u); break; } } } } while (0)

struct XcdBarrier {
    unsigned* bar; unsigned x;
    volatile LAS unsigned* st;
};

__device__ __forceinline__ XcdBarrier xcd_barrier_post(unsigned* bar, volatile LAS unsigned* st, bool leader  ) {
    XcdBarrier b; b.bar = bar; b.x = xb_xcc_id(); b.st = st;
    if (leader) (void)xb_add(&bar[XB_XCNT(b.x)], 1u);
    return b;
}
__device__ __forceinline__ void xcd_barrier_complete(unsigned* bar, unsigned x, unsigned& nloc, unsigned& nx) {
    const unsigned G = gridDim.x * gridDim.y * gridDim.z;
    unsigned sum, cnt, mine, sp = 0u;
    for (;;) {
        sum = 0u; cnt = 0u; mine = 0u;
#pragma unroll
        for (unsigned j = 0; j < 16; ++j) { const unsigned c = xb_ld(&bar[XB_XCNT(j)]); sum += c; cnt += (c > 0u) ? 1u : 0u; mine = (j == x) ? c : mine; }
        if (sum == G) break;
        __builtin_amdgcn_s_sleep(1);
        if ((++sp & 255u) == 0u) { if (xb_ld(&bar[XB_TMO])) break; if (sp > XB_SPIN_CAP) { atomicAdd(&bar[XB_TMO], 1u); break; } }
    }
    nloc = mine > 0u ? mine : 1u; nx = cnt > 0u ? cnt : 1u;
}

__device__ __forceinline__ void xcd_barrier(const XcdBarrier& b, bool leader  ) {
    asm volatile("s_waitcnt vmcnt(0)" ::: "memory");
    __syncthreads();
    if (leader) {
        unsigned* bar = b.bar;
        __builtin_amdgcn_s_waitcnt(0);
        unsigned nloc = b.st[0], nx = b.st[1];
        if (nloc == 0u) { xcd_barrier_complete(bar, b.x, nloc, nx); b.st[0] = nloc; b.st[1] = nx; }
        const unsigned old = xb_add(&bar[XB_XSUB(b.x)], 1u);
        const unsigned gen = old / nloc;
        if (old + 1u == (gen + 1u) * nloc) {
            __builtin_amdgcn_fence(__ATOMIC_RELEASE, "agent");
            asm volatile("s_waitcnt vmcnt(0)" ::: "memory");
            const unsigned og = xb_add(&bar[XB_TOP], 1u);
            const unsigned tg = og / nx;
            if (og + 1u == (tg + 1u) * nx) xb_add(&bar[XB_TOPGEN], 1u);
            else XB_SPIN(xb_ld(&bar[XB_TOPGEN]) == tg, bar);
            __builtin_amdgcn_fence(__ATOMIC_ACQUIRE, "agent");
            xb_add(&bar[XB_XGEN(b.x)], 1u);
            asm volatile("s_waitcnt vmcnt(0)" ::: "memory");
        } else {
            XB_SPIN(xb_ld(&bar[XB_XGEN(b.x)]) == gen, bar);
            __builtin_amdgcn_fence(__ATOMIC_ACQUIRE, "agent");
            asm volatile("s_waitcnt vmcnt(0)" ::: "memory");
        }
    }
    __syncthreads();
}

struct Frame {
    LAS unsigned char* lds;
    volatile LAS unsigned* MISC;
    gu32* ctl;
    int tid, lane, wave;
    int vcu, G;
    unsigned char* ws;
};
__device__ __forceinline__ float bf2f(bf16 b) { return __uint_as_float(((unsigned)b) << 16); }
__device__ __forceinline__ float wave_sum(float v) {
#pragma unroll
    for (int o = 1; o < 64; o <<= 1) v += mk_shfl_xor(v, o);
    return v;
}
__device__ __forceinline__ void p0_transpose_item(const float* W, int K, int N, bf16* WT, const float* gain, LAS float* scr, int item, int lane, int ldk = 0, int koff = 0, bool gv_pair = false) {
    if (ldk == 0) ldk = K;
    const int nblk = N / 32, kb = item / nblk, nb = item % nblk, k0 = 64 * kb, n0 = 32 * nb;
    float tv[32];
#pragma unroll
    for (int i = 0; i < 32; ++i) tv[i] = __builtin_nontemporal_load(&W[(size_t)(k0 + 2 * i + (lane >> 5)) * N + n0 + (lane & 31)]);
    const int c = lane & 7;
    f32x4 g0 = {1.f, 1.f, 1.f, 1.f}, g1 = g0;
    if (gain) { g0 = *(const GAS f32x4*)(gain + k0 + 8 * c); g1 = *(const GAS f32x4*)(gain + k0 + 8 * c + 4); }
#pragma unroll
    for (int i = 0; i < 32; ++i) { const int kk = 2 * i + (lane >> 5); scr[kk * 33 + (lane & 31)] = tv[i]; }
    LDS_WAIT(); asm volatile("" ::: "memory");
#pragma unroll
    for (int j = 0; j < 4; ++j) { const int n = (lane >> 3) + 8 * j; const LAS float* s = scr + (8 * c) * 33 + n;
        v4u o; o.x = pk2(s[0 * 33] * g0[0], s[1 * 33] * g0[1]); o.y = pk2(s[2 * 33] * g0[2], s[3 * 33] * g0[3]); o.z = pk2(s[4 * 33] * g1[0], s[5 * 33] * g1[1]); o.w = pk2(s[6 * 33] * g1[2], s[7 * 33] * g1[3]);
        int nd = n0 + n; if (gv_pair) { const int half = N / 2, isv = nd >= half ? 1 : 0, ch = nd - isv * half; nd = (ch >> 7) * 256 + isv * 128 + (ch & 127); }
        pg8::st16_stream(WT + (size_t)nd * ldk + koff + k0 + 8 * c, o); }
    LDS_WAIT(); asm volatile("" ::: "memory");
}
__device__ __forceinline__ void ph_xprologue(Frame& F, const float* x) {
    const int gw = F.vcu * NWAVES + F.wave, NGW = F.G * NWAVES;
    bf16* XB = (bf16*)(F.ws + WS_XB); float* ssp = (float*)(F.ws + WS_SS);
    for (int m = gw; m < M; m += 2 * NGW) {
        const int m1 = (m + NGW < M) ? m + NGW : m;
        const GAS f32x4* xr = (const GAS f32x4*)(x + (size_t)m * D) + F.lane; const GAS f32x4* xr1 = (const GAS f32x4*)(x + (size_t)m1 * D) + F.lane;
        f32x4 v[4], w[4]; float s = 0.f, s1 = 0.f;
#pragma unroll
        for (int j = 0; j < 4; ++j) { v[j] = xr[64 * j]; w[j] = xr1[64 * j]; }
        __builtin_amdgcn_sched_barrier(0);
#pragma unroll
        for (int j = 0; j < 4; ++j) { s += (v[j].x * v[j].x + v[j].y * v[j].y) + (v[j].z * v[j].z + v[j].w * v[j].w); s1 += (w[j].x * w[j].x + w[j].y * w[j].y) + (w[j].z * w[j].z + w[j].w * w[j].w); }
        s = wave_sum(s); s1 = wave_sum(s1);
        GAS unsigned long long* o8 = (GAS unsigned long long*)(XB + (size_t)m * D) + F.lane; GAS unsigned long long* o9 = (GAS unsigned long long*)(XB + (size_t)m1 * D) + F.lane;
#pragma unroll
        for (int j = 0; j < 4; ++j) { o8[64 * j] = (unsigned long long)pk2(v[j].x, v[j].y) | ((unsigned long long)pk2(v[j].z, v[j].w) << 32); o9[64 * j] = (unsigned long long)pk2(w[j].x, w[j].y) | ((unsigned long long)pk2(w[j].z, w[j].w) << 32); }
        if (F.lane < 16) { ((GAS float*)ssp)[(size_t)m * 16 + F.lane] = (F.lane == 0) ? s : 0.f; ((GAS float*)ssp)[(size_t)m1 * 16 + F.lane] = (F.lane == 0) ? s1 : 0.f; }
    }
}
struct LayerW { const float *w_in, *g_mix, *wa, *wb, *wc, *wo, *up, *g_ffn, *dn, *rg_a, *rg_x; };
#ifndef W_EARLY
#define W_EARLY 1
#endif
__device__ __forceinline__ void ph_weights(Frame& F, const LayerW& W, int which  , int wg = -1, int nwg = 0  ) {
    LAS float* scr = (LAS float*)(F.lds + RING_OFF + F.wave * 16384);
    const int gw = (wg >= 0 ? wg : F.vcu) * NWAVES + F.wave, NGW = (wg >= 0 ? nwg : F.G) * NWAVES;
    constexpr int I_IN = (D / 64) * (IN_COLS / 32), I_A = (512 / 64) * (D / 32), I_B = (D / 64) * (D / 32), I_UP = (D / 64) * (DFF2 / 32), I_DN = (DFF / 64) * (D / 32);
    constexpr int I_RG = 2 * RG_NB;
    constexpr int NITEMS = I_IN + I_A + I_B + I_A + I_B + I_UP + I_DN + I_RG;
    int it_lo = (which & 1) ? 0 : NITEMS - I_DN, it_hi = (which & 2) ? NITEMS : NITEMS - I_DN;
    if (which & 4) it_hi = I_IN;
    if (which & 8) it_lo = I_IN;
    for (int it = it_lo + gw; it < it_hi; it += NGW) {
        int r = it;
        if (r < I_IN) { p0_transpose_item(W.w_in, D, IN_COLS, (bf16*)(F.ws + WS_WIN), W.g_mix, scr, r, F.lane); continue; } r -= I_IN;
        if (r < I_RG) { const float* src = (r < RG_NB ? W.rg_a : W.rg_x) + (size_t)(r % RG_NB) * 4096; bf16* dst = (bf16*)(F.ws + WS_RGW) + (size_t)r * 4096 + (size_t)F.lane * 64;
            float v[64];
#pragma unroll
            for (int c = 0; c < 64; ++c) v[c] = src[c * 64 + F.lane];
#pragma unroll
            for (int c = 0; c < 64; c += 8) { v4u o; o.x = pk2(v[c], v[c + 1]); o.y = pk2(v[c + 2], v[c + 3]); o.z = pk2(v[c + 4], v[c + 5]); o.w = pk2(v[c + 6], v[c + 7]); *(GAS v4u*)(dst + c) = o; }
            continue; } r -= I_RG;
        if (r < I_A) { p0_transpose_item(W.wa, 512, D, (bf16*)(F.ws + WS_WA), nullptr, scr, r, F.lane, YP, YA_COL); continue; } r -= I_A;
        if (r < I_B) { p0_transpose_item(W.wb, D, D, (bf16*)(F.ws + WS_WA), nullptr, scr, r, F.lane, YP, YB_COL); continue; } r -= I_B;
        if (r < I_A) { p0_transpose_item(W.wc, 512, D, (bf16*)(F.ws + WS_WA), nullptr, scr, r, F.lane, YP, YC_COL); continue; } r -= I_A;
        if (r < I_B) { p0_transpose_item(W.wo, D, D, (bf16*)(F.ws + WS_WO), nullptr, scr, r, F.lane); continue; } r -= I_B;
        if (r < I_UP) { p0_transpose_item(W.up, D, DFF2, (bf16*)(F.ws + WS_WUP), W.g_ffn, scr, r, F.lane, 0, 0, USE_ACT_FUSE != 0); continue; } r -= I_UP;
        p0_transpose_item(W.dn, DFF, D, (bf16*)(F.ws + WS_WDN), nullptr, scr, r, F.lane);
    }
}
__device__ __forceinline__ void ph_kmean(Frame& F) {
    const int gw = F.vcu * NWAVES + F.wave, NGW = F.G * NWAVES;
    const bf16* KA = (const bf16*)(F.ws + WS_KA); float* KM = (float*)(F.ws + WS_KMEAN);
    for (int u = gw; u < BATCH * MOBA_NB * MOBA_H; u += NGW) {
        const int h = u % MOBA_H, blk = (u / MOBA_H) % MOBA_NB, b = u / (MOBA_H * MOBA_NB);
        const int dc = F.lane & 7, r0 = F.lane >> 3;
        const bf16* p = KA + ((size_t)b * SEQ + blk * MOBA_BLK + r0) * 512 + h * 64 + dc * 8;
        v4u w[32];
#pragma unroll
        for (int i = 0; i < 32; ++i) w[i] = *(const GAS v4u*)(p + (size_t)i * 8 * 512);
        float s[8] = {0.f, 0.f, 0.f, 0.f, 0.f, 0.f, 0.f, 0.f};
#pragma unroll
        for (int i = 0; i < 32; ++i) { s[0] += bf_lo(w[i].x); s[1] += bf_hi(w[i].x); s[2] += bf_lo(w[i].y); s[3] += bf_hi(w[i].y); s[4] += bf_lo(w[i].z); s[5] += bf_hi(w[i].z); s[6] += bf_lo(w[i].w); s[7] += bf_hi(w[i].w); }
#pragma unroll
        for (int e = 0; e < 8; ++e) { s[e] += mk_shfl_xor(s[e], 8); s[e] += mk_shfl_xor(s[e], 16); s[e] += mk_shfl_xor(s[e], 32); }
        if (r0 == 0) { float* o = KM + ((size_t)(b * MOBA_H + h) * MOBA_NB + blk) * 64 + dc * 8;
            *(GAS f32x4*)o = (f32x4){s[0], s[1], s[2], s[3]} * (1.0f / MOBA_BLK); *(GAS f32x4*)(o + 4) = (f32x4){s[4], s[5], s[6], s[7]} * (1.0f / MOBA_BLK); }
    }
}
struct RgP { const float *conv_w, *conv_b, *w_a, *b_a, *w_x, *b_x, *lam; };
template <bool FIX> __device__ __forceinline__ void ph_rglru(Frame& F, const RgP& P) {
    const int gw = F.vcu * NWAVES + F.wave, NGW = F.G * NWAVES;
    const bf16* RX = (const bf16*)(F.ws + WS_RX); const bf16* RG = (const bf16*)(F.ws + WS_RG); bf16* YB = (bf16*)(F.ws + WS_YB);
    float* AG = (float*)(F.ws + WS_AGG); float* BG = AG + (size_t)BATCH * RG_NCH * D; const float* CI = (const float*)(F.ws + WS_CARRY);
    for (int u = gw; u < BATCH * RG_NCH * RG_NB; u += NGW) {
        const int n = u % RG_NB, c = (u / RG_NB) % RG_NCH, b = u / (RG_NB * RG_NCH);
        const int ch = n * 64 + F.lane;
        float wa[64], wx[64];
#pragma unroll
        for (int k = 0; k < 64; ++k) { wa[k] = P.w_a[(size_t)n * 4096 + k * 64 + F.lane]; wx[k] = P.w_x[(size_t)n * 4096 + k * 64 + F.lane]; }
        const float ba = P.b_a[ch], bx = P.b_x[ch], c8 = -8.0f * log1pf(expf(-P.lam[ch]));
        const float cw0 = P.conv_w[ch], cw1 = P.conv_w[D + ch], cw2 = P.conv_w[2 * D + ch], cw3 = P.conv_w[3 * D + ch], cb = P.conv_b[ch];
        const int t0 = c * RG_CHUNK; const size_t rb = (size_t)b * SEQ;
        float x3 = (t0 >= 3) ? bf2f(RX[(rb + t0 - 3) * D + ch]) : 0.f, x2 = (t0 >= 2) ? bf2f(RX[(rb + t0 - 2) * D + ch]) : 0.f, x1 = (t0 >= 1) ? bf2f(RX[(rb + t0 - 1) * D + ch]) : 0.f;
        const size_t aidx = ((size_t)b * RG_NCH + c) * D + ch;
        float h = FIX ? CI[aidx] : 0.f, pa = 1.f;
        for (int t = 0; t < RG_CHUNK; ++t) {
            const float x0 = bf2f(RX[(rb + t0 + t) * D + ch]);
            const float xr = cb + cw0 * x3 + cw1 * x2 + cw2 * x1 + cw3 * x0; x3 = x2; x2 = x1; x1 = x0;
            float rp = ba, ip = bx;
#pragma unroll
            for (int k = 0; k < 64; ++k) { const float s = __uint_as_float(__builtin_amdgcn_readlane(__float_as_uint(xr), k)); rp += s * wa[k]; ip += s * wx[k]; }
            const float r = 1.0f / (1.0f + expf(-rp)), ig = 1.0f / (1.0f + expf(-ip));
            const float la = c8 * r, a = expf(la), mult = sqrtf(-expm1f(2.0f * la));
            h = a * h + mult * (ig * xr); pa *= a;
            if (FIX) YB[(rb + t0 + t) * YP + ch] = (bf16)f2bf(h * bf2f(RG[(rb + t0 + t) * D + ch]));
        }
        if (!FIX) { AG[aidx] = pa; BG[aidx] = h; }
    }
}
__device__ __forceinline__ void ph_carry(Frame& F) {
    const float* AG = (const float*)(F.ws + WS_AGG); const float* BG = AG + (size_t)BATCH * RG_NCH * D; float* CI = (float*)(F.ws + WS_CARRY);
    if (F.wave == 0) for (int task = F.vcu; task < BATCH * (D / 64); task += F.G) {
        const int b = task / (D / 64), ch = (task % (D / 64)) * 64 + F.lane; const size_t i0 = (size_t)b * RG_NCH * D + ch;
        float A[RG_NCH], Bv[RG_NCH];
#pragma unroll
        for (int c = 0; c < RG_NCH; ++c) { A[c] = AG[i0 + (size_t)c * D]; Bv[c] = BG[i0 + (size_t)c * D]; }
        float carry = 0.f;
#pragma unroll
        for (int c = 0; c < RG_NCH; ++c) { CI[i0 + (size_t)c * D] = carry; carry = A[c] * carry + Bv[c]; }
    }
}
template <int DV  , int VW  >
__device__ __forceinline__ void naive_tile(const LAS float* Ks, const LAS float* Vs, const float (&q)[16], float (&o)[DV], float& mr, float& lr, int qpos, int kpos0, float slope2, bool mine, int qd) {
#pragma unroll 2
    for (int j = 63; j >= 0; --j) {
        const LAS f32x4* kr = (const LAS f32x4*)(Ks + j * 64 + qd * 16);
        const f32x4 k0 = kr[0], k1 = kr[1], k2 = kr[2], k3 = kr[3];
        float d = ((q[0] * k0[0] + q[1] * k0[1]) + (q[2] * k0[2] + q[3] * k0[3])) + ((q[4] * k1[0] + q[5] * k1[1]) + (q[6] * k1[2] + q[7] * k1[3]))
                + ((q[8] * k2[0] + q[9] * k2[1]) + (q[10] * k2[2] + q[11] * k2[3])) + ((q[12] * k3[0] + q[13] * k3[1]) + (q[14] * k3[2] + q[15] * k3[3]));
        d += mk_shfl_xor(d, 1); d += mk_shfl_xor(d, 2);
        const int dist = qpos - (kpos0 + j);
        if (mine && dist >= 0) {
            const float sv = d - slope2 * (float)dist;
            if (sv > mr) { const float sc = __builtin_amdgcn_exp2f(mr - sv); lr *= sc; mr = sv;
#pragma unroll
                for (int e = 0; e < DV; ++e) o[e] *= sc; }
            const float p = __builtin_amdgcn_exp2f(sv - mr); lr += p; const LAS f32x4* vr = (const LAS f32x4*)(Vs + j * VW + qd * DV);
#pragma unroll
            for (int i = 0; i < DV / 4; ++i) { const f32x4 v = vr[i]; o[4 * i] += p * v[0]; o[4 * i + 1] += p * v[1]; o[4 * i + 2] += p * v[2]; o[4 * i + 3] += p * v[3]; }
        }
    }
}
template <int VW> __device__ __forceinline__ void naive_stage(Frame& F, LAS float* Ks, LAS float* Vs, const bf16* Kg, const bf16* Vg) {
    { const int r = F.tid >> 3, c = (F.tid & 7) * 8; const v4u w = *(const GAS v4u*)(Kg + (size_t)r * 512 + c); LAS float* d = Ks + r * 64 + c;
      d[0] = bf_lo(w.x); d[1] = bf_hi(w.x); d[2] = bf_lo(w.y); d[3] = bf_hi(w.y); d[4] = bf_lo(w.z); d[5] = bf_hi(w.z); d[6] = bf_lo(w.w); d[7] = bf_hi(w.w); }
#pragma unroll
    for (int i = 0; i < VW / 64; ++i) { const int e = (F.tid + i * 512) * 8, r = e / VW, c = e % VW; const v4u w = *(const GAS v4u*)(Vg + (size_t)r * 512 + c); LAS float* d = Vs + r * VW + c;
      d[0] = bf_lo(w.x); d[1] = bf_hi(w.x); d[2] = bf_lo(w.y); d[3] = bf_hi(w.y); d[4] = bf_lo(w.z); d[5] = bf_hi(w.z); d[6] = bf_lo(w.w); d[7] = bf_hi(w.w); }
}
__device__ __forceinline__ void load_q16(float (&q)[16], const bf16* p) {
#pragma unroll
    for (int i = 0; i < 2; ++i) { const v4u w = *(const GAS v4u*)(p + 8 * i); q[8 * i] = bf_lo(w.x); q[8 * i + 1] = bf_hi(w.x); q[8 * i + 2] = bf_lo(w.y); q[8 * i + 3] = bf_hi(w.y); q[8 * i + 4] = bf_lo(w.z); q[8 * i + 5] = bf_hi(w.z); q[8 * i + 6] = bf_lo(w.w); q[8 * i + 7] = bf_hi(w.w); }
}
__device__ __forceinline__ void causal_unit(int idx, int nbh, bool four, int& bh, int& qt) {
    bh = idx % nbh; const int j = idx / nbh;
    if (four) qt = (j < 8) ? 31 - j : (j < 16) ? j - 8 : (j < 24) ? 39 - j : j - 16;
    else qt = (j < 16) ? 31 - j : j - 16;
}

struct DiffP { const float *lq1, *lk1, *lq2, *lk2, *subln_g; float lam_init; };
__device__ __forceinline__ void ph_diffattn_naive(Frame& F, const DiffP& P) {
    LAS float* Ks = (LAS float*)(F.lds + RING_OFF); LAS float* Vs = Ks + 64 * 64;
    const bf16* QC = (const bf16*)(F.ws + WS_QC); const bf16* KC = (const bf16*)(F.ws + WS_KC); const bf16* VC = (const bf16*)(F.ws + WS_VC); bf16* YC = (bf16*)(F.ws + WS_YC);
    float* DS = (float*)(F.ws + WS_DSCR);
    float d1 = 0.f, d2 = 0.f;
    for (int i = 0; i < 64; ++i) { d1 += P.lq1[i] * P.lk1[i]; d2 += P.lq2[i] * P.lk2[i]; }
    const float lam = expf(d1) - expf(d2) + P.lam_init;
    const int row = F.tid >> 2, qd = F.tid & 3;
    for (int idx = F.vcu; idx < BATCH * DIFF_H * 32; idx += F.G) {
        int bh, qt; causal_unit(idx, BATCH * DIFF_H, false, bh, qt);
        const int b = bh / DIFF_H, h = bh % DIFF_H; const int qpos = qt * 128 + row; const size_t grow = (size_t)b * SEQ + qpos;
        const float slope2 = exp2f(-2.0f * (float)(h + 1)) * LOG2E;
        float* dsp = DS + (grow * DIFF_H + h) * 128 + qd * 32;
        for (int m = 0; m < 2; ++m) {
            float q[16]; load_q16(q, QC + grow * 512 + h * 128 + m * 64 + qd * 16);
            float o[32]; float mr = -INFINITY, lr = 0.f;
#pragma unroll
            for (int d = 0; d < 32; ++d) o[d] = 0.f;
            for (int kt = 2 * qt + 1; kt >= 0; --kt) {
                __syncthreads();
                const size_t krow = (size_t)b * SEQ + kt * 64;
                naive_stage<128>(F, Ks, Vs, KC + krow * 512 + h * 128 + m * 64, VC + krow * 512 + h * 128);
                __syncthreads();
                naive_tile<32, 128>(Ks, Vs, q, o, mr, lr, qpos, kt * 64, slope2, true, qd);
            }
            const float il = 1.0f / lr;
            if (m == 0) {
#pragma unroll
                for (int d = 0; d < 32; d += 4) *(f32x4*)(dsp + d) = (f32x4){o[d] * il, o[d + 1] * il, o[d + 2] * il, o[d + 3] * il};
            } else {
                float ss = 0.f;
#pragma unroll
                for (int d = 0; d < 32; d += 4) { const f32x4 o1 = *(const f32x4*)(dsp + d);
#pragma unroll
                    for (int e = 0; e < 4; ++e) { o[d + e] = o1[e] - lam * (o[d + e] * il); ss += o[d + e] * o[d + e]; } }
                ss += mk_shfl_xor(ss, 1); ss += mk_shfl_xor(ss, 2);
                const float rs = rsqrtf(ss * (1.0f / 128.0f) + 1e-6f) * (1.0f - P.lam_init);
                bf16* yp = YC + grow * YP + h * 128 + qd * 32; const float* gp = P.subln_g + qd * 32;
#pragma unroll
                for (int d = 0; d < 32; d += 8) { v4u w;
                    w.x = pk2(o[d] * rs * gp[d], o[d + 1] * rs * gp[d + 1]); w.y = pk2(o[d + 2] * rs * gp[d + 2], o[d + 3] * rs * gp[d + 3]);
                    w.z = pk2(o[d + 4] * rs * gp[d + 4], o[d + 5] * rs * gp[d + 5]); w.w = pk2(o[d + 6] * rs * gp[d + 6], o[d + 7] * rs * gp[d + 7]);
                    *(GAS v4u*)(yp + d) = w; }
            }
        }
    }
    __syncthreads();
}
namespace at {
using bf16x8 = __attribute__((ext_vector_type(8))) short;
using s16x4 = __attribute__((ext_vector_type(4))) short;
using f32x16 = __attribute__((ext_vector_type(16))) float;
using u32x4 = __attribute__((ext_vector_type(4))) unsigned;
typedef __attribute__((address_space(3))) const char* lds_cptr;
typedef short v4i16_t __attribute__((ext_vector_type(4)));
__device__ __forceinline__ int crow(int r, int hi) { return (r & 3) + 8 * (r >> 2) + 4 * hi; }
__device__ __forceinline__ void glds16(const void* gsrc, unsigned lds_dst) { unsigned keep;
    asm volatile("s_mov_b32 %0, m0\n\ts_mov_b32 m0, %2\n\ts_nop 0\n\tglobal_load_lds_dwordx4 %1, off\n\ts_mov_b32 m0, %0" : "=&s"(keep) : "v"(gsrc), "s"(lds_dst) : "memory"); }
typedef float f32x2_t __attribute__((ext_vector_type(2))); typedef __bf16 bf16x2_t __attribute__((ext_vector_type(2)));
__device__ __forceinline__ unsigned cvtpk(float lo, float hi) { f32x2_t v = {lo, hi}; bf16x2_t b = __builtin_convertvector(v, bf16x2_t); return __builtin_bit_cast(unsigned, b); }
__device__ __forceinline__ void kload8(bf16x8* kf, lds_cptr kp) {
#pragma unroll
    for (int d0 = 0; d0 < 4; ++d0) { kf[2 * d0] = *(const __attribute__((address_space(3))) bf16x8*)(kp + d0 * 2048); kf[2 * d0 + 1] = *(const __attribute__((address_space(3))) bf16x8*)(kp + d0 * 2048 + 512); }
}
__device__ __forceinline__ s16x4 vtr(lds_cptr p) { return __builtin_bit_cast(s16x4, __builtin_amdgcn_ds_read_tr16_b64_v4i16((__attribute__((address_space(3))) v4i16_t*)p)); }
__device__ __forceinline__ float rowmax(const f32x16& p0, const f32x16& p1) {
    float a = fmaxf(p0[0], p1[0]);
#pragma unroll
    for (int r = 1; r < 16; ++r) a = fmaxf(a, fmaxf(p0[r], p1[r]));
    auto rr = __builtin_amdgcn_permlane32_swap(__float_as_uint(a), __float_as_uint(a), false, false);
    return fmaxf(__uint_as_float(rr[0]), __uint_as_float(rr[1]));
}
__device__ __forceinline__ float max3f(float a, float b, float c) { float r; asm("v_max3_f32 %0, %1, %2, %3" : "=v"(r) : "v"(a), "v"(b), "v"(c)); return r; }
__device__ __forceinline__ float max2f(float a, float b) { float r; asm("v_max_f32_e32 %0, %1, %2" : "=v"(r) : "v"(a), "v"(b)); return r; }
__device__ __forceinline__ float fadd_s(float a, float b) { float r; asm("v_add_f32_e32 %0, %1, %2" : "=v"(r) : "v"(a), "v"(b)); return r; }
#define AT_WAIT_BAR(N) asm volatile("s_waitcnt vmcnt(" #N ") lgkmcnt(0)\n\ts_barrier" ::: "memory")
#define AT_MFMA(a, b, c) __builtin_amdgcn_mfma_f32_32x32x16_bf16(a, b, c, 0, 0, 0)
constexpr float THR = 8.0f;
template <bool MASK>
__device__ __forceinline__ bool tile_qk(lds_cptr kp  , const int (&koff)[4]  , lds_cptr qp  , float slope2, float tb, int qrel, int hi, int r32,
                                          float& mhat, float& lsum, __attribute__((address_space(3))) float* wsf, u32x4 (&pw)[4]) {
    bf16x8 kf[4];
#pragma unroll
    for (int d0 = 0; d0 < 2; ++d0) { kf[2 * d0] = *(const __attribute__((address_space(3))) bf16x8*)(kp + koff[d0]); kf[2 * d0 + 1] = *(const __attribute__((address_space(3))) bf16x8*)(kp + koff[d0] + 4096); }
    f32x16 p0, p1; { const float t0 = tb - mhat + slope2 * (float)(4 * hi), t1 = t0 + slope2 * 32.f;
        const float s8 = slope2 * 8.f; (void)t1;
        p0[0] = t0; p0[1] = p0[0] + slope2; p0[2] = p0[1] + slope2; p0[3] = p0[2] + slope2;
#pragma unroll
        for (int r = 4; r < 16; ++r) p0[r] = p0[r - 4] + s8;
        const float s32 = slope2 * 32.f;
#pragma unroll
        for (int r = 0; r < 16; ++r) p1[r] = p0[r] + s32; }
    bf16x8 qr[4];
#pragma unroll
    for (int d0 = 0; d0 < 4; ++d0) qr[d0] = *(const __attribute__((address_space(3))) bf16x8*)(qp + d0 * 1024);
    __builtin_amdgcn_sched_barrier(0);
#pragma unroll
    for (int d0 = 0; d0 < 2; ++d0) { p0 = AT_MFMA(kf[2 * d0], qr[d0], p0); p1 = AT_MFMA(kf[2 * d0 + 1], qr[d0], p1); }
#pragma unroll
    for (int d0 = 0; d0 < 2; ++d0) { kf[2 * d0] = *(const __attribute__((address_space(3))) bf16x8*)(kp + koff[d0 + 2]); kf[2 * d0 + 1] = *(const __attribute__((address_space(3))) bf16x8*)(kp + koff[d0 + 2] + 4096); }
    __builtin_amdgcn_sched_barrier(0);
#pragma unroll
    for (int d0 = 0; d0 < 2; ++d0) { p0 = AT_MFMA(kf[2 * d0], qr[d0 + 2], p0); p1 = AT_MFMA(kf[2 * d0 + 1], qr[d0 + 2], p1); }
    __builtin_amdgcn_sched_barrier(0);
    if (MASK) {
#pragma unroll
        for (int r = 0; r < 16; ++r) { const int kv = crow(r, hi); if (kv > qrel) p0[r] = -INFINITY; if (kv + 32 > qrel) p1[r] = -INFINITY; } }
    const float rm = rowmax(p0, p1);
    const bool resc = __any(rm > THR);
    if (resc) { const float dl = fmaxf(rm, 0.f); mhat += dl;
#pragma unroll
        for (int r = 0; r < 16; ++r) { p0[r] -= dl; p1[r] -= dl; }
        const float f = __builtin_amdgcn_exp2f(-dl); lsum *= f; if (hi == 0) wsf[r32] = f; }
    float sacc = 0.f;
#pragma unroll
    for (int r = 0; r < 16; ++r) { p0[r] = __builtin_amdgcn_exp2f(p0[r]); p1[r] = __builtin_amdgcn_exp2f(p1[r]); sacc += p0[r] + p1[r]; }
    lsum += sacc;
#pragma unroll
    for (int s = 0; s < 2; ++s) { pw[s] = (u32x4){cvtpk(p0[8 * s], p0[8 * s + 1]), cvtpk(p0[8 * s + 2], p0[8 * s + 3]), cvtpk(p0[8 * s + 4], p0[8 * s + 5]), cvtpk(p0[8 * s + 6], p0[8 * s + 7])};
                                  pw[2 + s] = (u32x4){cvtpk(p1[8 * s], p1[8 * s + 1]), cvtpk(p1[8 * s + 2], p1[8 * s + 3]), cvtpk(p1[8 * s + 4], p1[8 * s + 5]), cvtpk(p1[8 * s + 6], p1[8 * s + 7])}; }
    return resc;
}
template <int NDB>
__device__ __forceinline__ void tile_pv(lds_cptr vp, const u32x4 (&pw)[4], bool resc, int hi, f32x16 (&o)[NDB], __attribute__((address_space(3))) float* wsf) {
    if (resc) { asm volatile("s_waitcnt lgkmcnt(0)" ::: "memory");
#pragma unroll
        for (int r = 0; r < 16; ++r) { const float f = (wsf + 4 * hi)[(r & 3) + 8 * (r >> 2)];
#pragma unroll
            for (int db = 0; db < NDB; ++db) o[db][r] *= f; } }
    __builtin_amdgcn_sched_barrier(0);
#pragma unroll
    for (int ks = 0; ks < 4; ++ks) {
        s16x4 lo[NDB], hv[NDB];
#pragma unroll
        for (int db = 0; db < NDB; ++db) { lo[db] = vtr(vp + db * 4096 + ks * 1024); hv[db] = vtr(vp + db * 4096 + ks * 1024 + 512); }
#pragma unroll
        for (int db = 0; db < NDB; ++db) { const bf16x8 vf = (bf16x8){lo[db][0], lo[db][1], lo[db][2], lo[db][3], hv[db][0], hv[db][1], hv[db][2], hv[db][3]};
            o[db] = AT_MFMA(__builtin_bit_cast(bf16x8, pw[ks]), vf, o[db]); }
        __builtin_amdgcn_sched_barrier(0); }
}

#define AT_SB() __builtin_amdgcn_sched_barrier(0)
typedef __attribute__((address_space(3))) float* lds_fptr;
template <int NDB> __device__ __forceinline__ void ld_v(s16x4 (&lo)[NDB], s16x4 (&hv)[NDB], lds_cptr vp, int ks) {
#pragma unroll
    for (int db = 0; db < NDB; ++db) { lo[db] = vtr(vp + db * 4096 + ks * 1024); hv[db] = vtr(vp + db * 4096 + ks * 1024 + 512); } }
template <int NDB> __device__ __forceinline__ void pv_mm(f32x16 (&o)[NDB], const u32x4& pk, const s16x4 (&lo)[NDB], const s16x4 (&hv)[NDB]) {
#pragma unroll
    for (int db = 0; db < NDB; ++db) { const bf16x8 vf = (bf16x8){lo[db][0], lo[db][1], lo[db][2], lo[db][3], hv[db][0], hv[db][1], hv[db][2], hv[db][3]};
        o[db] = AT_MFMA(__builtin_bit_cast(bf16x8, pk), vf, o[db]); } }
template <int NDB> __device__ __forceinline__ void pv_tile(f32x16 (&o)[NDB], const u32x4 (&pw)[4], lds_cptr vp, bool resc, int hi, lds_fptr wsf, s16x4 (&alo)[NDB], s16x4 (&ahv)[NDB], s16x4 (&blo)[NDB], s16x4 (&bhv)[NDB]) {
    if (resc) { asm volatile("s_waitcnt lgkmcnt(0)" ::: "memory");
#pragma unroll
        for (int r = 0; r < 16; ++r) { const float f = (wsf + 4 * hi)[(r & 3) + 8 * (r >> 2)];
#pragma unroll
            for (int db = 0; db < NDB; ++db) o[db][r] *= f; } }
    AT_SB();
    pv_mm<NDB>(o, pw[0], alo, ahv); ld_v<NDB>(alo, ahv, vp, 2); AT_SB();
    pv_mm<NDB>(o, pw[1], blo, bhv); ld_v<NDB>(blo, bhv, vp, 3); AT_SB();
    pv_mm<NDB>(o, pw[2], alo, ahv); AT_SB();
    pv_mm<NDB>(o, pw[3], blo, bhv); AT_SB(); }
__device__ __forceinline__ void ld_kq(bf16x8 (&kf)[8], bf16x8 (&qr)[4], lds_cptr kp, const int (&koff)[4], lds_cptr qp) {
#pragma unroll
    for (int d0 = 0; d0 < 4; ++d0) { const unsigned a_ = (unsigned)(uintptr_t)kp + (unsigned)koff[d0]; __builtin_assume(a_ < 0x28000u);
        kf[2 * d0] = *(const __attribute__((address_space(3))) bf16x8*)(uintptr_t)a_; kf[2 * d0 + 1] = *(const __attribute__((address_space(3))) bf16x8*)(uintptr_t)(a_ + 4096u); }
#pragma unroll
    for (int d0 = 0; d0 < 4; ++d0) qr[d0] = *(const __attribute__((address_space(3))) bf16x8*)(qp + d0 * 1024); }
template <bool CM = false>
__device__ __forceinline__ bool qk_softmax(const bf16x8 (&kf)[8], const bf16x8 (&qr)[4], bool msk, float slope2, float tb, int qrel, int hi, int r32, float& mhat, float& lsum, lds_fptr wsf, u32x4 (&pw)[4]) {
    asm volatile("" : "+v"(hi), "+v"(slope2));
    f32x16 p0, p1;
    if (CM) {
        const float c_ = tb - mhat, ak = hi ? 1.0f : slope2 * (float)r32, b0 = hi ? c_ : 1.0f, b1 = hi ? c_ + slope2 * 32.f : 1.0f;
        p0 = __builtin_amdgcn_mfma_f32_32x32x2f32(ak, b0, f32x16{}, 0, 0, 0); p1 = __builtin_amdgcn_mfma_f32_32x32x2f32(ak, b1, f32x16{}, 0, 0, 0);
    } else { const float t0 = tb - mhat + slope2 * (float)(4 * hi), s8 = slope2 * 8.f, s32 = slope2 * 32.f;
        p0[0] = t0; p0[1] = fadd_s(p0[0], slope2); p0[2] = fadd_s(p0[1], slope2); p0[3] = fadd_s(p0[2], slope2);
#pragma unroll
        for (int r = 4; r < 16; ++r) p0[r] = fadd_s(p0[r - 4], s8);
#pragma unroll
        for (int r = 0; r < 16; ++r) p1[r] = fadd_s(p0[r], s32); }
    if (!CM) asm volatile("s_nop 3" ::: "memory");
    AT_SB();
#pragma unroll
    for (int d0 = 0; d0 < 4; ++d0) { p0 = AT_MFMA(kf[2 * d0], qr[d0], p0); p1 = AT_MFMA(kf[2 * d0 + 1], qr[d0], p1); }
    AT_SB();
    if (msk) { const int qh = qrel - 4 * hi;
#pragma unroll
        for (int r = 0; r < 16; ++r) { const int kc = (r & 3) + 8 * (r >> 2); if (kc > qh) p0[r] = -INFINITY; if (kc + 32 > qh) p1[r] = -INFINITY; } }
    p1[15] += 0.0f; p0[15] += 0.0f;
    AT_SB();
    float rm; { float m0 = max3f(p0[0], p0[1], p1[0]), m1 = max3f(p0[2], p0[3], p1[1]); m0 = max3f(m0, p1[2], p1[3]);
#pragma unroll
        for (int r = 4; r < 16; r += 4) { m0 = max3f(m0, p0[r], p0[r + 1]); m1 = max3f(m1, p0[r + 2], p0[r + 3]); m0 = max3f(m0, p1[r], p1[r + 1]); m1 = max3f(m1, p1[r + 2], p1[r + 3]); }
        const float a = fmaxf(m0, m1); auto rr = __builtin_amdgcn_permlane32_swap(__float_as_uint(a), __float_as_uint(a), false, false);
        rm = fmaxf(__uint_as_float(rr[0]), __uint_as_float(rr[1])); }
    const bool resc = __any(rm > THR);
    if (resc) { const float dl = fmaxf(rm, 0.f); mhat += dl;
#pragma unroll
        for (int r = 0; r < 16; ++r) { p0[r] -= dl; p1[r] -= dl; }
        const float f = __builtin_amdgcn_exp2f(-dl); lsum *= f; if (hi == 0) wsf[r32] = f; }
#pragma unroll
    for (int r = 0; r < 16; ++r) { p0[r] = __builtin_amdgcn_exp2f(p0[r]); p1[r] = __builtin_amdgcn_exp2f(p1[r]); }
    AT_SB();
    float s0 = p0[0], s1 = p1[0];
#pragma unroll
    for (int r = 1; r < 16; ++r) { s0 = fadd_s(s0, p0[r]); s1 = fadd_s(s1, p1[r]); }
    lsum += s0 + s1;
#pragma unroll
    for (int s = 0; s < 2; ++s) { pw[s] = (u32x4){cvtpk(p0[8 * s], p0[8 * s + 1]), cvtpk(p0[8 * s + 2], p0[8 * s + 3]), cvtpk(p0[8 * s + 4], p0[8 * s + 5]), cvtpk(p0[8 * s + 6], p0[8 * s + 7])};
                                  pw[2 + s] = (u32x4){cvtpk(p1[8 * s], p1[8 * s + 1]), cvtpk(p1[8 * s + 2], p1[8 * s + 3]), cvtpk(p1[8 * s + 4], p1[8 * s + 5]), cvtpk(p1[8 * s + 6], p1[8 * s + 7])}; }
    return resc;
}
}

__device__ __forceinline__ void ph_diffattn_mfma(Frame& F, const DiffP& P) {
    using namespace at;
    const int wid = F.wave, mh = wid >> 2, w4 = wid & 3;
    LAS unsigned char* shm = F.lds + RING_OFF; const unsigned lds0 = (unsigned)(uintptr_t)shm;
    constexpr int KSTG = 16384, VSTG = 16384, OFF_K2 = 8192, OFF_V = 3 * KSTG, OFF_WS = OFF_V + 4 * VSTG, OFF_Q = OFF_WS + 2048, OFF_Y = OFF_Q;
    LAS float* wsf = (LAS float*)(shm + OFF_WS) + wid * 64;
    const bf16* QC = (const bf16*)(F.ws + WS_QC); const bf16* KC = (const bf16*)(F.ws + WS_KC); const bf16* VC = (const bf16*)(F.ws + WS_VC); bf16* YC = (bf16*)(F.ws + WS_YC);
    float d1 = 0.f, d2 = 0.f;
    for (int i = 0; i < 64; ++i) { d1 += P.lq1[i] * P.lk1[i]; d2 += P.lq2[i] * P.lk2[i]; }
    const float lam = expf(d1) - expf(d2) + P.lam_init;
    const lds_cptr kp0 = (lds_cptr)shm + mh * OFF_K2;
    for (int idx = F.vcu, it_ = 0; idx < BATCH * DIFF_H * 32; idx += F.G, ++it_) {
        int bh = idx % (BATCH * DIFF_H), j = idx / (BATCH * DIFF_H), qb = (j < 16) ? 31 - j : j - 16;
        if (F.G == 256) { const int xcd = F.vcu >> 5, w = F.vcu & 31; bh = 2 * xcd + it_; qb = it_ == 0 ? 31 - w : w; }
        const int b = bh / DIFF_H, h = bh % DIFF_H, q0 = qb * 128, q0w = q0 + w4 * 32, NT = 2 * qb + 2;
        const float slope2 = exp2f(-2.0f * (float)(h + 1)) * LOG2E;
        const size_t rowb = (size_t)b * SEQ;
        int lu = mk_lane(); asm volatile("" : "+v"(lu));
        const int lane = lu, r32 = lane & 31, hi = lane >> 5;
        int koff[4];
#pragma unroll
        for (int d0 = 0; d0 < 4; ++d0) koff[d0] = r32 * 128 + (((2 * d0 + hi) ^ ((r32 >> 1) & 7)) << 4);
        const lds_cptr vp0 = (lds_cptr)shm + OFF_V + ((lane >> 4) & 1) * 32 + (lane & 3) * 8 + (4 * hi + ((lane & 15) >> 2)) * 64;
        const lds_cptr qp = (lds_cptr)shm + OFF_Q + wid * 4096 + lu * 16;
        { const bf16* Qw = QC + (rowb + q0w + (lu & 31)) * 512 + h * 128 + mh * 64;
#pragma unroll
          for (int d0 = 0; d0 < 4; ++d0) *(__attribute__((address_space(3))) bf16x8*)((LAS unsigned char*)shm + OFF_Q + wid * 4096 + lu * 16 + d0 * 1024) = *(const GAS bf16x8*)(Qw + d0 * 16 + (lu >> 5) * 8); }
        const bf16* ks1 = KC + (rowb + 8 * wid + (lu >> 3)) * 512 + h * 128 + (((lu & 7) ^ (((8 * wid + (lu >> 3)) >> 1) & 7)) << 3);
        const int pA = 2 * wid;
        const bf16* vsA = VC + (rowb + 16 * (pA & 3) + (lu >> 2)) * 512 + h * 128 + (pA >> 2) * 32 + (lu & 3) * 8;
#define DF_DMA(t) do { const size_t go_ = (size_t)(t) * 64 * 512; const unsigned kb_ = lds0 + (unsigned)((t) % 3) * KSTG, vb_ = lds0 + OFF_V + (unsigned)((t) & 3) * VSTG; \
        glds16(ks1 + go_, (unsigned)__builtin_amdgcn_readfirstlane(kb_ + wid * 1024)); glds16(ks1 + go_ + 64, (unsigned)__builtin_amdgcn_readfirstlane(kb_ + OFF_K2 + wid * 1024)); \
        glds16(vsA + go_, (unsigned)__builtin_amdgcn_readfirstlane(vb_ + pA * 1024)); glds16(vsA + go_ + 16 * 512, (unsigned)__builtin_amdgcn_readfirstlane(vb_ + (pA + 1) * 1024)); } while (0)
        f32x16 o[4]; float mhat = 0.f, lsum = 0.f;
#pragma unroll
        for (int db = 0; db < 4; ++db) o[db] = f32x16{};
        u32x4 pw[4]; bool pend = false, presc = false; int pvt = 0;
        DF_DMA(0); DF_DMA(1);
        for (int t = 0; t <= NT; ++t) {
            const bool live = t < NT;
            if (mh == 1 && live) { if (t + 1 < NT) { AT_WAIT_BAR(4); } else { AT_WAIT_BAR(0); } if (t + 2 < NT) DF_DMA(t + 2); }
            const int k0 = t * 64; const bool doqk = live && (k0 <= q0w + 31);
            unsigned ks_ = (unsigned)(t % 3) * KSTG; asm volatile("" : "+s"(ks_));
            const lds_cptr kp = kp0 + ks_;
            bf16x8 kf[8], qr[4]; s16x4 alo[4], ahv[4], blo[4], bhv[4]; const lds_cptr vp = vp0 + (pvt & 3) * VSTG;
            if (pend) { ld_v<4>(alo, ahv, vp, 0); ld_v<4>(blo, bhv, vp, 1); }
            if (mh == 1 && doqk) ld_kq(kf, qr, kp, koff, qp);
            AT_SB();
            if (pend) { pv_tile<4>(o, pw, vp, presc, hi, wsf, alo, ahv, blo, bhv); pend = false; }
            if (mh == 0 && live) { if (t + 1 < NT) { AT_WAIT_BAR(4); } else { AT_WAIT_BAR(0); } if (t + 2 < NT) DF_DMA(t + 2); }
            if (doqk) {
                if (mh == 0) ld_kq(kf, qr, kp, koff, qp);
                presc = qk_softmax(kf, qr, k0 + 63 > q0w, slope2, slope2 * (float)(k0 - q0w), q0w + r32 - k0, hi, r32, mhat, lsum, wsf, pw);
                pend = true; pvt = t; }
        }
        AT_WAIT_BAR(0);
#undef DF_DMA
        { auto rr = __builtin_amdgcn_permlane32_swap(__float_as_uint(lsum), __float_as_uint(lsum), false, false); lsum = __uint_as_float(rr[0]) + __uint_as_float(rr[1]); }
        if (hi == 0) wsf[32 + r32] = lsum;
        asm volatile("s_waitcnt lgkmcnt(0)" ::: "memory");
        float rli[16];
#pragma unroll
        for (int r = 0; r < 16; ++r) rli[r] = 1.0f / (wsf + 32 + 4 * hi)[(r & 3) + 8 * (r >> 2)];
        int le_ = mk_lane(); asm volatile("" : "+v"(le_));
        LAS float* X = (LAS float*)shm + (w4 * 32 + 4 * (le_ >> 5)) * 128 + (le_ & 31);
        if (mh == 1) {
#pragma unroll
            for (int db = 0; db < 4; ++db)
#pragma unroll
                for (int r = 0; r < 16; ++r) X[((r & 3) + 8 * (r >> 2)) * 128 + db * 32] = o[db][r] * rli[r];
        }
        AT_WAIT_BAR(0);
        if (mh == 0) {
            float ssr[16];
#pragma unroll
            for (int r = 0; r < 16; ++r) { float a = 0.f;
#pragma unroll
                for (int db = 0; db < 4; ++db) { const float v = o[db][r] * rli[r] - lam * X[((r & 3) + 8 * (r >> 2)) * 128 + db * 32]; o[db][r] = v; a += v * v; }
                ssr[r] = a; }
#pragma unroll
            for (int r = 0; r < 16; ++r) { float a = ssr[r]; a += mk_shfl_xor(a, 1); a += mk_shfl_xor(a, 2); a += mk_shfl_xor(a, 4); a += mk_shfl_xor(a, 8); a += mk_shfl_xor(a, 16); ssr[r] = rsqrtf(a * (1.0f / 128.0f) + 1e-6f) * (1.0f - P.lam_init); }
            float gsl[4];
#pragma unroll
            for (int db = 0; db < 4; ++db) gsl[db] = ((const GAS float*)P.subln_g)[db * 32 + (le_ & 31)];
            LAS bf16* Y = (LAS bf16*)(shm + OFF_Y) + (w4 * 32 + 4 * (le_ >> 5)) * 128 + (le_ & 31);
#pragma unroll
            for (int db = 0; db < 4; ++db) { const float g = gsl[db];
#pragma unroll
                for (int r = 0; r < 16; ++r) Y[((r & 3) + 8 * (r >> 2)) * 128 + db * 32] = (bf16)f2bf(o[db][r] * ssr[r] * g); }
        }
        AT_WAIT_BAR(0);
        { int tid_ = F.tid; asm volatile("" : "+v"(tid_));
#pragma unroll
        for (int i = 0; i < 4; ++i) { const int id = tid_ + i * 512, row = id >> 4, pc = id & 15;
            const v4u w = *(const LAS v4u*)(shm + OFF_Y + row * 256 + pc * 16);
            *(GAS v4u*)(YC + (rowb + q0 + row) * YP + h * 128 + pc * 8) = w; } }
        AT_WAIT_BAR(0);
    }
}
__device__ __forceinline__ void ph_diffattn_pipe(Frame& F, const DiffP& P) {
    using namespace at;
    const int wid = F.wave, mh = wid >> 2, w4 = wid & 3;
    LAS unsigned char* shm = F.lds + RING_OFF; const unsigned lds0 = (unsigned)(uintptr_t)shm;
    constexpr int KSTG = 16384, VSTG = 16384, OFF_K2 = 8192, OFF_V = 3 * KSTG, OFF_WS = OFF_V + 4 * VSTG, OFF_Q = OFF_WS + 2048, OFF_Y = OFF_Q;
    LAS float* wsf = (LAS float*)(shm + OFF_WS) + wid * 64;
    const bf16* QC = (const bf16*)(F.ws + WS_QC); const bf16* KC = (const bf16*)(F.ws + WS_KC); const bf16* VC = (const bf16*)(F.ws + WS_VC); bf16* YC = (bf16*)(F.ws + WS_YC);
    float d1 = 0.f, d2 = 0.f;
    for (int i = 0; i < 64; ++i) { d1 += P.lq1[i] * P.lk1[i]; d2 += P.lq2[i] * P.lk2[i]; }
    const float lam = expf(d1) - expf(d2) + P.lam_init;
    const lds_cptr kp0 = (lds_cptr)shm + mh * OFF_K2;
    for (int idx = F.vcu, it_ = 0; idx < BATCH * DIFF_H * 32; idx += F.G, ++it_) {
        int bh = idx % (BATCH * DIFF_H), j = idx / (BATCH * DIFF_H), qb = (j < 16) ? 31 - j : j - 16;
        if (F.G == 256) { const int xcd = F.vcu >> 5, w = F.vcu & 31; bh = 2 * xcd + it_; qb = it_ == 0 ? 31 - w : w; }
        const int b = bh / DIFF_H, h = bh % DIFF_H, q0 = qb * 128, q0w = q0 + w4 * 32, NT = 2 * qb + 2;
        const float slope2 = exp2f(-2.0f * (float)(h + 1)) * LOG2E;
        const size_t rowb = (size_t)b * SEQ;
        int lu = mk_lane(); asm volatile("" : "+v"(lu));
        const int lane = lu, r32 = lane & 31, hi = lane >> 5;
        int koff[4];
#pragma unroll
        for (int d0 = 0; d0 < 4; ++d0) koff[d0] = r32 * 128 + (((2 * d0 + hi) ^ ((r32 >> 1) & 7)) << 4);
        const lds_cptr vp0 = (lds_cptr)shm + OFF_V + ((lane >> 4) & 1) * 32 + (lane & 3) * 8 + (4 * hi + ((lane & 15) >> 2)) * 64;
        const lds_cptr qp = (lds_cptr)shm + OFF_Q + wid * 4096 + lu * 16;
        { const bf16* Qw = QC + (rowb + q0w + (lu & 31)) * 512 + h * 128 + mh * 64;
          bf16x8 qv_[4];
#pragma unroll
          for (int d0 = 0; d0 < 4; ++d0) qv_[d0] = *(const GAS bf16x8*)(Qw + d0 * 16 + (lu >> 5) * 8);
          __builtin_amdgcn_sched_barrier(0);
#pragma unroll
          for (int d0 = 0; d0 < 4; ++d0) *(__attribute__((address_space(3))) bf16x8*)((LAS unsigned char*)shm + OFF_Q + wid * 4096 + lu * 16 + d0 * 1024) = qv_[d0]; }
        const bf16* ks1 = KC + (rowb + 8 * wid + (lu >> 3)) * 512 + h * 128 + (((lu & 7) ^ (((8 * wid + (lu >> 3)) >> 1) & 7)) << 3);
        const int pA = 2 * wid;
        const bf16* vsA = VC + (rowb + 16 * (pA & 3) + (lu >> 2)) * 512 + h * 128 + (pA >> 2) * 32 + (lu & 3) * 8;
#define DMA_K(t, slot) do { const size_t go_ = (size_t)(t) * 64 * 512; const unsigned kb_ = (unsigned)__builtin_amdgcn_readfirstlane(lds0 + (unsigned)(slot) + wid * 1024); glds16(ks1 + go_, kb_); glds16(ks1 + go_ + 64, kb_ + OFF_K2); } while (0)
#define DMA_V(t, slot) do { const size_t go_ = (size_t)(t) * 64 * 512; const unsigned vb_ = (unsigned)__builtin_amdgcn_readfirstlane(lds0 + OFF_V + (unsigned)(slot) + pA * 1024); glds16(vsA + go_, vb_); glds16(vsA + go_ + 16 * 512, vb_ + 1024); } while (0)
        f32x16 o[4]; float mhat = 0.f, lsum = 0.f;
#pragma unroll
        for (int db = 0; db < 4; ++db) o[db] = f32x16{};
        f32x16 pA0, pA1, pB0, pB1; bf16x8 kf[8], qr[4]; s16x4 vlo[3], vhi[3]; u32x4 pw[4]; bool resc = false;
        const float akey = hi ? 1.0f : slope2 * (float)r32;
        const unsigned kl0 = lds0 + (unsigned)mh * OFF_K2;
        unsigned sl_prev = 0u, sl_cur = 0u, sl_next = KSTG;
#define ROT() do { sl_prev = sl_cur; sl_cur = sl_next; sl_next = (sl_next == 2u * KSTG) ? 0u : sl_next + KSTG; } while (0)
#define PIN(x) asm volatile("" : "+v"(x))
#define KLD(sl, d0) do { const unsigned a_ = kl0 + (sl) + (unsigned)koff[d0]; kf[2 * (d0)] = *(const __attribute__((address_space(3))) bf16x8*)(uintptr_t)a_; kf[2 * (d0) + 1] = *(const __attribute__((address_space(3))) bf16x8*)(uintptr_t)(a_ + 4096u); } while (0)
#define QLD() do { _Pragma("unroll") for (int d0 = 0; d0 < 4; ++d0) qr[d0] = *(const __attribute__((address_space(3))) bf16x8*)(qp + d0 * 1024); } while (0)
#define VR4(g) do { vlo[(g) % 3] = vtr(vp_ + (((g) & 3) * 4096 + ((g) >> 2) * 1024)); vhi[(g) % 3] = vtr(vp_ + (((g) & 3) * 4096 + ((g) >> 2) * 1024 + 512)); } while (0)
#define VF4(g) (bf16x8){vlo[(g) % 3][0], vlo[(g) % 3][1], vlo[(g) % 3][2], vlo[(g) % 3][3], vhi[(g) % 3][0], vhi[(g) % 3][1], vhi[(g) % 3][2], vhi[(g) % 3][3]}
#define PKW(P, i) cvtpk(P[i], P[i + 1])
#define EX(v) __builtin_amdgcn_exp2f(v)
#define SINIT(C0, C1, t) do { const float c_ = slope2 * (float)((t) * 64 - q0w) - mhat; const float b0_ = hi ? c_ : 1.0f, b1_ = hi ? c_ + slope2 * 32.f : 1.0f; \
        C0 = __builtin_amdgcn_mfma_f32_32x32x2f32(akey, b0_, f32x16{}, 0, 0, 0); C1 = __builtin_amdgcn_mfma_f32_32x32x2f32(akey, b1_, f32x16{}, 0, 0, 0); } while (0)
#define DECIDE(C0, C1, t) do { if ((t) * 64 + 63 > q0w) { const int qh_ = q0w + r32 - (t) * 64 - 4 * hi; \
            _Pragma("unroll") for (int r = 0; r < 16; ++r) { const int kc = (r & 3) + 8 * (r >> 2); if (kc > qh_) C0[r] = -INFINITY; if (kc + 32 > qh_) C1[r] = -INFINITY; } } \
        C1[15] += 0.0f; C0[15] += 0.0f; AT_SB(); \
        float rm_; { float m0 = max3f(C0[0], C0[1], C1[0]), m1 = max3f(C0[2], C0[3], C1[1]); m0 = max3f(m0, C1[2], C1[3]); \
            _Pragma("unroll") for (int r = 4; r < 16; r += 4) { m0 = max3f(m0, C0[r], C0[r + 1]); m1 = max3f(m1, C0[r + 2], C0[r + 3]); m0 = max3f(m0, C1[r], C1[r + 1]); m1 = max3f(m1, C1[r + 2], C1[r + 3]); } \
            const float a_ = fmaxf(m0, m1); auto rr_ = __builtin_amdgcn_permlane32_swap(__float_as_uint(a_), __float_as_uint(a_), false, false); rm_ = fmaxf(__uint_as_float(rr_[0]), __uint_as_float(rr_[1])); } \
        resc = false; if (__any(rm_ > THR)) { const float dl_ = fmaxf(rm_, 0.f); mhat += dl_; _Pragma("unroll") for (int r = 0; r < 16; ++r) { C0[r] -= dl_; C1[r] -= dl_; } \
            const float f_ = __builtin_amdgcn_exp2f(-dl_); lsum *= f_; if (hi == 0) wsf[r32] = f_; resc = true; } } while (0)
#define RESC() do { if (resc) { asm volatile("s_waitcnt lgkmcnt(0)" ::: "memory"); _Pragma("unroll") for (int r = 0; r < 16; ++r) { const float f_ = (wsf + 4 * hi)[(r & 3) + 8 * (r >> 2)]; o[0][r] *= f_; o[1][r] *= f_; o[2][r] *= f_; o[3][r] *= f_; } } } while (0)
#define GAPA(MF, a0, a1, a2, a3, W0, W1, PW) do { MF; sacc += a0; sacc += a1; sacc += a2; sacc += a3; W0; W1; PIN(PW); PIN(sacc); AT_SB(); } while (0)
#define GB4(g, X, i) do { if ((g) + 2 < 16) { VR4((g) + 2); AT_SB(); } o[(g) & 3] = AT_MFMA(__builtin_bit_cast(bf16x8, pw[(g) >> 2]), VF4(g), o[(g) & 3]); X[i] = EX(X[i]); X[i + 1] = EX(X[i + 1]); PIN(X); AT_SB(); } while (0)
#define KRD(G, d0) do { if (G) { KLD(sl_next, d0); AT_SB(); } } while (0)
#define STEP(C0, C1, P0, P1, t) do { AT_SB(); const lds_cptr vp_ = vp0 + sl_prev; const bool gl_ = (t) + 1 < NT; \
        QLD(); AT_SB(); SINIT(C0, C1, t); AT_SB(); \
        float sacc = P0[0] + P0[1]; \
        GAPA(C0 = AT_MFMA(kf[0], qr[0], C0), P0[2], P0[3], P0[4], P0[5],     pw[0][0] = PKW(P0, 0),  pw[0][1] = PKW(P0, 2),  pw[0]); \
        GAPA(C1 = AT_MFMA(kf[1], qr[0], C1), P0[6], P0[7], P0[8], P0[9],     pw[0][2] = PKW(P0, 4),  pw[0][3] = PKW(P0, 6),  pw[0]); \
        GAPA(C0 = AT_MFMA(kf[2], qr[1], C0), P0[10], P0[11], P0[12], P0[13], pw[1][0] = PKW(P0, 8),  pw[1][1] = PKW(P0, 10), pw[1]); \
        GAPA(C1 = AT_MFMA(kf[3], qr[1], C1), P0[14], P0[15], P1[0], P1[1],   pw[1][2] = PKW(P0, 12), pw[1][3] = PKW(P0, 14), pw[1]); \
        GAPA(C0 = AT_MFMA(kf[4], qr[2], C0), P1[2], P1[3], P1[4], P1[5],     pw[2][0] = PKW(P1, 0),  pw[2][1] = PKW(P1, 2),  pw[2]); \
        GAPA(C1 = AT_MFMA(kf[5], qr[2], C1), P1[6], P1[7], P1[8], P1[9],     pw[2][2] = PKW(P1, 4),  pw[2][3] = PKW(P1, 6),  pw[2]); \
        VR4(0); AT_SB(); GAPA(C0 = AT_MFMA(kf[6], qr[3], C0), P1[10], P1[11], P1[12], P1[13], pw[3][0] = PKW(P1, 8),  pw[3][1] = PKW(P1, 10), pw[3]); \
        VR4(1); AT_SB(); GAPA(C1 = AT_MFMA(kf[7], qr[3], C1), P1[14], P1[15], 0.f, 0.f,       pw[3][2] = PKW(P1, 12), pw[3][3] = PKW(P1, 14), pw[3]); \
        lsum += sacc; \
        if ((t) + 3 < NT) DMA_K((t) + 3, sl_cur); if ((t) + 1 < NT) DMA_V((t) + 1, sl_next); \
        DECIDE(C0, C1, t); AT_SB(); \
        GB4(0, C0, 0);  GB4(1, C0, 2);  KRD(gl_, 0); GB4(2, C0, 4);  GB4(3, C0, 6);  KRD(gl_, 1); GB4(4, C0, 8);  GB4(5, C0, 10); KRD(gl_, 2); GB4(6, C0, 12); GB4(7, C0, 14); KRD(gl_, 3); \
        GB4(8, C1, 0);  GB4(9, C1, 2);  GB4(10, C1, 4); GB4(11, C1, 6); GB4(12, C1, 8); GB4(13, C1, 10); GB4(14, C1, 12); GB4(15, C1, 14); \
        } while (0)
#define ENDW(t) do { if ((t) + 3 < NT) { AT_WAIT_BAR(4); } else if ((t) + 1 < NT) { AT_WAIT_BAR(2); } else { AT_WAIT_BAR(0); } } while (0)
        DMA_K(0, 0); DMA_V(0, 0); DMA_K(1, KSTG); if (NT > 2) DMA_K(2, 2 * KSTG);
        AT_WAIT_BAR(0);
        _Pragma("unroll") for (int d0 = 0; d0 < 4; ++d0) KLD(0u, d0);
        QLD(); SINIT(pA0, pA1, 0);
        _Pragma("unroll") for (int d0 = 0; d0 < 4; ++d0) { pA0 = AT_MFMA(kf[2 * d0], qr[d0], pA0); pA1 = AT_MFMA(kf[2 * d0 + 1], qr[d0], pA1); }
        AT_SB(); DECIDE(pA0, pA1, 0);
        _Pragma("unroll") for (int r = 0; r < 16; ++r) { pA0[r] = EX(pA0[r]); pA1[r] = EX(pA1[r]); }
        AT_WAIT_BAR(0);
        if (3 < NT) DMA_K(3, 0); DMA_V(1, KSTG); ROT();
        _Pragma("unroll") for (int d0 = 0; d0 < 4; ++d0) KLD(sl_cur, d0);
        if (3 < NT) { AT_WAIT_BAR(4); } else { AT_WAIT_BAR(2); }
        { int t = 1;
          for (; t + 1 < NT; t += 2) {
              STEP(pB0, pB1, pA0, pA1, t);     ENDW(t);     RESC(); ROT();
              STEP(pA0, pA1, pB0, pB1, t + 1); ENDW(t + 1); RESC(); ROT(); }
          STEP(pB0, pB1, pA0, pA1, t); ENDW(t); RESC(); ROT(); }
        { float sacc = pB0[0] + pB0[1];
          _Pragma("unroll") for (int r = 2; r < 16; ++r) sacc += pB0[r];
          _Pragma("unroll") for (int r = 0; r < 16; ++r) sacc += pB1[r];
          lsum += sacc;
          pw[0] = (u32x4){PKW(pB0, 0), PKW(pB0, 2), PKW(pB0, 4), PKW(pB0, 6)}; pw[1] = (u32x4){PKW(pB0, 8), PKW(pB0, 10), PKW(pB0, 12), PKW(pB0, 14)};
          pw[2] = (u32x4){PKW(pB1, 0), PKW(pB1, 2), PKW(pB1, 4), PKW(pB1, 6)}; pw[3] = (u32x4){PKW(pB1, 8), PKW(pB1, 10), PKW(pB1, 12), PKW(pB1, 14)};
          const lds_cptr vp_ = vp0 + sl_prev; VR4(0); VR4(1);
          _Pragma("unroll") for (int g = 0; g < 16; ++g) { if (g + 2 < 16) VR4(g + 2); o[g & 3] = AT_MFMA(__builtin_bit_cast(bf16x8, pw[g >> 2]), VF4(g), o[g & 3]); } }
        AT_WAIT_BAR(0);
#undef DMA_K
#undef DMA_V
#undef ROT
#undef PIN
#undef KLD
#undef QLD
#undef VR4
#undef VF4
#undef PKW
#undef EX
#undef SINIT
#undef DECIDE
#undef RESC
#undef GAPA
#undef GB4
#undef KRD
#undef STEP
#undef ENDW
        { auto rr = __builtin_amdgcn_permlane32_swap(__float_as_uint(lsum), __float_as_uint(lsum), false, false); lsum = __uint_as_float(rr[0]) + __uint_as_float(rr[1]); }
        if (hi == 0) wsf[32 + r32] = lsum;
        asm volatile("s_waitcnt lgkmcnt(0)" ::: "memory");
        float rli[16];
#pragma unroll
        for (int r = 0; r < 16; ++r) rli[r] = 1.0f / (wsf + 32 + 4 * hi)[(r & 3) + 8 * (r >> 2)];
        int le_ = mk_lane(); asm volatile("" : "+v"(le_));
        LAS float* X = (LAS float*)shm + (w4 * 32 + 4 * (le_ >> 5)) * 128 + (le_ & 31);
        if (mh == 1) {
#pragma unroll
            for (int db = 0; db < 4; ++db)
#pragma unroll
                for (int r = 0; r < 16; ++r) X[((r & 3) + 8 * (r >> 2)) * 128 + db * 32] = o[db][r] * rli[r];
        }
        AT_WAIT_BAR(0);
        if (mh == 0) {
            float ssr[16];
#pragma unroll
            for (int r = 0; r < 16; ++r) { float a = 0.f;
#pragma unroll
                for (int db = 0; db < 4; ++db) { const float v = o[db][r] * rli[r] - lam * X[((r & 3) + 8 * (r >> 2)) * 128 + db * 32]; o[db][r] = v; a += v * v; }
                ssr[r] = a; }
#pragma unroll
            for (int r = 0; r < 16; ++r) { float a = ssr[r]; a += mk_shfl_xor(a, 1); a += mk_shfl_xor(a, 2); a += mk_shfl_xor(a, 4); a += mk_shfl_xor(a, 8); a += mk_shfl_xor(a, 16); ssr[r] = rsqrtf(a * (1.0f / 128.0f) + 1e-6f) * (1.0f - P.lam_init); }
            float gsl[4];
#pragma unroll
            for (int db = 0; db < 4; ++db) gsl[db] = ((const GAS float*)P.subln_g)[db * 32 + (le_ & 31)];
            LAS bf16* Y = (LAS bf16*)(shm + OFF_Y) + (w4 * 32 + 4 * (le_ >> 5)) * 128 + (le_ & 31);
#pragma unroll
            for (int db = 0; db < 4; ++db) { const float g = gsl[db];
#pragma unroll
                for (int r = 0; r < 16; ++r) Y[((r & 3) + 8 * (r >> 2)) * 128 + db * 32] = (bf16)f2bf(o[db][r] * ssr[r] * g); }
        }
        AT_WAIT_BAR(0);
        { int tid_ = F.tid; asm volatile("" : "+v"(tid_));
#pragma unroll
        for (int i = 0; i < 4; ++i) { const int id = tid_ + i * 512, row = id >> 4, pc = id & 15;
            const v4u w = *(const LAS v4u*)(shm + OFF_Y + row * 256 + pc * 16);
            *(GAS v4u*)(YC + (rowb + q0 + row) * YP + h * 128 + pc * 8) = w; } }
        AT_WAIT_BAR(0);
    }
}
__device__ __forceinline__ void ph_moba_mfma(Frame& F) {
    using namespace at;
    const int wid = F.wave;
    LAS unsigned char* shm = F.lds + RING_OFF; const unsigned lds0 = (unsigned)(uintptr_t)shm;
    constexpr int KSTG = 8192, VSTG = 8192, OFF_V = 3 * KSTG, OFF_WS = OFF_V + 4 * VSTG, OFF_Q = OFF_WS + 4096, OFF_KM = OFF_Q + 32768, OFF_MSK = OFF_KM + 4096;
    LAS float* wsf = (LAS float*)(shm + OFF_WS) + wid * 64;
    const bf16* QA = (const bf16*)(F.ws + WS_QA); const bf16* KA = (const bf16*)(F.ws + WS_KA); const bf16* VA = (const bf16*)(F.ws + WS_VA); bf16* YA = (bf16*)(F.ws + WS_YA);
    const float* KM = (const float*)(F.ws + WS_KMEAN);
    const lds_cptr kp0 = (lds_cptr)shm;
    for (int idx = F.vcu, it_ = 0; idx < BATCH * MOBA_H * MOBA_NB; idx += F.G, ++it_) {
        int bh = idx % (BATCH * MOBA_H), j = idx / (BATCH * MOBA_H), blk = (j < 8) ? 15 - j : j - 8;
        if (F.G == 256) { const int xcd = F.vcu >> 5, w = F.vcu & 31; bh = 4 * xcd + (w >> 3); blk = it_ == 0 ? 15 - (w & 7) : (w & 7); }
        const int b = bh / MOBA_H, h = bh % MOBA_H, q0 = blk * 256, q0w = q0 + wid * 32;
        const float slope2 = exp2f(-(float)(h + 1)) * LOG2E;
        const size_t rowb = (size_t)b * SEQ;
        int lu = mk_lane(), tu = wid * 64 + lu; asm volatile("" : "+v"(lu), "+v"(tu));
        const int lane = lu, r32 = lane & 31, hi = lane >> 5;
        int koff[4];
#pragma unroll
        for (int d0 = 0; d0 < 4; ++d0) koff[d0] = r32 * 128 + (((2 * d0 + hi) ^ ((r32 >> 1) & 7)) << 4);
        const lds_cptr vp0 = (lds_cptr)shm + OFF_V + ((lane >> 4) & 1) * 32 + (lane & 3) * 8 + (4 * hi + ((lane & 15) >> 2)) * 64;
        unsigned long long blist = (unsigned long long)blk; int nb = 1;
        const bf16* ksrc = KA + (rowb + 8 * wid + (lu >> 3)) * 512 + h * 64 + (((lu & 7) ^ (((8 * wid + (lu >> 3)) >> 1) & 7)) << 3);
        const bf16* vsrc = VA + (rowb + 16 * (wid & 3) + (lu >> 2)) * 512 + h * 64 + (wid >> 2) * 32 + (lu & 3) * 8;
#define MB_K0(ti) ((int)((blist >> (4 * ((ti) >> 2))) & 15ull) * 256 + ((ti) & 3) * 64)
#define MB_DMA(ti) do { if (wid < 4) { const size_t go_ = (size_t)MB_K0(ti) * 512;     \
        const unsigned kd_ = (unsigned)__builtin_amdgcn_readfirstlane(lds0 + (unsigned)((ti) % 3) * KSTG + wid * 1024), vd_ = (unsigned)__builtin_amdgcn_readfirstlane(lds0 + OFF_V + (unsigned)((ti) & 3) * VSTG + wid * 1024); \
        glds16(ksrc + go_, kd_); glds16(vsrc + go_, vd_); glds16(ksrc + go_ + 32 * 512, kd_ + 4096); glds16(vsrc + go_ + 32, vd_ + 4096); } } while (0)
        MB_DMA(0); MB_DMA(1);
        { LAS float* Km = (LAS float*)(shm + OFF_KM);
#pragma unroll
          for (int i = 0; i < 2; ++i) Km[tu + i * 512] = KM[(size_t)bh * MOBA_NB * 64 + tu + i * 512];
          if (tu == 0) *(LAS unsigned*)(shm + OFF_MSK) = 0u; }
        bf16x8 qf[4];
        { const bf16* Qw = QA + (rowb + q0w + (lu & 31)) * 512 + h * 64;
#pragma unroll
          for (int d0 = 0; d0 < 4; ++d0) { qf[d0] = *(const bf16x8*)(Qw + d0 * 16 + (lu >> 5) * 8); *(LAS bf16x8*)(shm + OFF_Q + wid * 4096 + lu * 16 + d0 * 1024) = qf[d0]; } }
        const lds_cptr qp = (lds_cptr)shm + OFF_Q + wid * 4096 + lu * 16;
        AT_WAIT_BAR(0);
        float b0 = -INFINITY, b1 = -INFINITY, b2 = -INFINITY; int i0 = -1, i1 = -1, i2 = -1;
        float qx[32];
#pragma unroll
        for (int d0 = 0; d0 < 4; ++d0)
#pragma unroll
            for (int e = 0; e < 8; ++e) qx[8 * d0 + e] = bf2f((bf16)qf[d0][e]);
        for (int jb0 = 0; jb0 < blk; jb0 += 2) {
            const int jb1 = jb0 + 1 < blk ? jb0 + 1 : jb0; float gg[2];
#pragma unroll
            for (int u2 = 0; u2 < 2; ++u2) { const LAS float* km = (const LAS float*)(shm + OFF_KM) + (u2 ? jb1 : jb0) * 64 + 8 * (lu >> 5); float ga = 0.f, gb = 0.f;
#pragma unroll
                for (int d0 = 0; d0 < 4; ++d0) { const f32x4 k0 = *(const LAS f32x4*)(km + d0 * 16), k1 = *(const LAS f32x4*)(km + d0 * 16 + 4);
                    ga += (qx[8 * d0 + 0] * k0[0] + qx[8 * d0 + 1] * k0[1]) + (qx[8 * d0 + 2] * k0[2] + qx[8 * d0 + 3] * k0[3]);
                    gb += (qx[8 * d0 + 4] * k1[0] + qx[8 * d0 + 5] * k1[1]) + (qx[8 * d0 + 6] * k1[2] + qx[8 * d0 + 7] * k1[3]); }
                gg[u2] = ga + gb; }
#pragma unroll
            for (int u2 = 0; u2 < 2; ++u2) { float g = gg[u2]; const int jb = u2 ? jb1 : jb0;
                { auto rr = __builtin_amdgcn_permlane32_swap(__float_as_uint(g), __float_as_uint(g), false, false); g = __uint_as_float(rr[0]) + __uint_as_float(rr[1]); }
                if (u2 == 0 || jb1 != jb0) { if (g > b0) { b2 = b1; i2 = i1; b1 = b0; i1 = i0; b0 = g; i0 = jb; } else if (g > b1) { b2 = b1; i2 = i1; b1 = g; i1 = jb; } else if (g > b2) { b2 = g; i2 = jb; } } }
        }
        unsigned mym = 0u; if (i0 >= 0) mym |= 1u << i0; if (i1 >= 0) mym |= 1u << i1; if (i2 >= 0) mym |= 1u << i2;
        { unsigned wm = mym;
#pragma unroll
          for (int o_ = 1; o_ < 64; o_ <<= 1) wm |= (unsigned)mk_shfl_xor((int)wm, o_);
          if (lu == 0) atomicOr((unsigned*)(shm + OFF_MSK), wm); }
        AT_WAIT_BAR(0);
        const unsigned wgm = (unsigned)__builtin_amdgcn_readfirstlane(*(volatile LAS unsigned*)(shm + OFF_MSK)) | (1u << blk);
        for (int jb = 0; jb < blk; ++jb) if ((wgm >> jb) & 1u) { blist |= (unsigned long long)jb << (4 * nb); ++nb; }
        const int NTI = 4 * nb;
        f32x16 o[2]; float mhat = 0.f, lsum = 0.f; o[0] = f32x16{}; o[1] = f32x16{};
        u32x4 pw[4]; bool pend = false, presc = false; int pvt = 0; const bool late = wid >= 4;
        for (int t = 0; t <= NTI; ++t) {
            const bool live = t < NTI;
            if (late && live) { AT_WAIT_BAR(0); }
            const int k0 = live ? MB_K0(t) : 0, jb = k0 >> 8; unsigned ks_ = (unsigned)(t % 3) * KSTG; asm volatile("" : "+s"(ks_)); const lds_cptr kp = kp0 + ks_;
            const bool sel = (jb == blk) || ((mym >> jb) & 1u);
            const bool doqk = live && ((jb == blk) ? (k0 <= q0w + 31) : (bool)__any(sel));
            bf16x8 kf[8], qr[4]; s16x4 alo[2], ahv[2], blo[2], bhv[2]; const lds_cptr vp = vp0 + (pvt & 3) * VSTG;
            if (pend) { ld_v<2>(alo, ahv, vp, 0); ld_v<2>(blo, bhv, vp, 1); }
            if (late && doqk) ld_kq(kf, qr, kp, koff, qp);
            AT_SB();
            if (pend) { pv_tile<2>(o, pw, vp, presc, hi, wsf, alo, ahv, blo, bhv); pend = false; }
            if (!late && live) { if (t + 1 < NTI) { AT_WAIT_BAR(4); } else { AT_WAIT_BAR(0); } if (t + 2 < NTI) MB_DMA(t + 2); }
            if (doqk) {
                if (!late) ld_kq(kf, qr, kp, koff, qp);
                presc = qk_softmax<true>(kf, qr, (jb == blk) && (k0 + 63 > q0w), slope2, sel ? slope2 * (float)(k0 - q0w) : -INFINITY, q0w + r32 - k0, hi, r32, mhat, lsum, wsf, pw);
                pend = true; pvt = t; }
        }
        AT_WAIT_BAR(0);
#undef MB_DMA
#undef MB_K0
        { auto rr = __builtin_amdgcn_permlane32_swap(__float_as_uint(lsum), __float_as_uint(lsum), false, false); lsum = __uint_as_float(rr[0]) + __uint_as_float(rr[1]); }
        if (hi == 0) wsf[32 + r32] = lsum;
        asm volatile("s_waitcnt lgkmcnt(0)" ::: "memory");
        { int le_ = mk_lane(); asm volatile("" : "+v"(le_));
          LAS bf16* stg = (LAS bf16*)(shm + OFF_Q + wid * 4096) + (4 * (le_ >> 5)) * 64 + (le_ & 31);
#pragma unroll
          for (int r = 0; r < 16; ++r) { const float il = 1.0f / (wsf + 32 + 4 * (le_ >> 5))[(r & 3) + 8 * (r >> 2)];
#pragma unroll
              for (int db = 0; db < 2; ++db) stg[((r & 3) + 8 * (r >> 2)) * 64 + db * 32] = (bf16)f2bf(o[db][r] * il); }
          asm volatile("s_waitcnt lgkmcnt(0)" ::: "memory");
          bf16* Ow = YA + (rowb + q0w) * YP + h * 64;
#pragma unroll
          for (int i = 0; i < 4; ++i) { const int row = i * 8 + (le_ >> 3), ch = le_ & 7; const v4u v = *(const LAS v4u*)(shm + OFF_Q + wid * 4096 + row * 128 + ch * 16); *(GAS v4u*)(Ow + (size_t)row * YP + ch * 8) = v; } }
        AT_WAIT_BAR(0);
    }
}
__device__ __forceinline__ void ph_moba_pipe(Frame& F) {
    using namespace at;
    const int wid = F.wave;
    LAS unsigned char* shm = F.lds + RING_OFF; const unsigned lds0 = (unsigned)(uintptr_t)shm;
    constexpr int KSTG = 8192, VSTG = 8192, OFF_V = 3 * KSTG, OFF_WS = OFF_V + 4 * VSTG, OFF_Q = OFF_WS + 4096, OFF_KM = OFF_Q + 32768, OFF_MSK = OFF_KM + 4096;
    LAS float* wsf = (LAS float*)(shm + OFF_WS) + wid * 64;
    const bf16* QA = (const bf16*)(F.ws + WS_QA); const bf16* KA = (const bf16*)(F.ws + WS_KA); const bf16* VA = (const bf16*)(F.ws + WS_VA); bf16* YA = (bf16*)(F.ws + WS_YA);
    const float* KM = (const float*)(F.ws + WS_KMEAN);
    const lds_cptr kp0 = (lds_cptr)shm;
    for (int idx = F.vcu, it_ = 0; idx < BATCH * MOBA_H * MOBA_NB; idx += F.G, ++it_) {
        int bh = idx % (BATCH * MOBA_H), j = idx / (BATCH * MOBA_H), blk = (j < 8) ? 15 - j : j - 8;
        if (F.G == 256) { const int xcd = F.vcu >> 5, w = F.vcu & 31; bh = 4 * xcd + (w >> 3); blk = it_ == 0 ? 15 - (w & 7) : (w & 7); }
        const int b = bh / MOBA_H, h = bh % MOBA_H, q0 = blk * 256, q0w = q0 + wid * 32;
        const float slope2 = exp2f(-(float)(h + 1)) * LOG2E;
        const size_t rowb = (size_t)b * SEQ;
        int lu = mk_lane(), tu = wid * 64 + lu; asm volatile("" : "+v"(lu), "+v"(tu));
        const int lane = lu, r32 = lane & 31, hi = lane >> 5;
        int koff[4];
#pragma unroll
        for (int d0 = 0; d0 < 4; ++d0) koff[d0] = r32 * 128 + (((2 * d0 + hi) ^ ((r32 >> 1) & 7)) << 4);
        const lds_cptr vp0 = (lds_cptr)shm + OFF_V + ((lane >> 4) & 1) * 32 + (lane & 3) * 8 + (4 * hi + ((lane & 15) >> 2)) * 64;
        unsigned long long blist = (unsigned long long)blk; int nb = 1;
        const bf16* ksrc = KA + (rowb + 8 * wid + (lu >> 3)) * 512 + h * 64 + (((lu & 7) ^ (((8 * wid + (lu >> 3)) >> 1) & 7)) << 3);
        const bf16* vsrc = VA + (rowb + 16 * (wid & 3) + (lu >> 2)) * 512 + h * 64 + (wid >> 2) * 32 + (lu & 3) * 8;
#define MB_K0(ti) ((int)((blist >> (4 * ((ti) >> 2))) & 15ull) * 256 + ((ti) & 3) * 64)
#define DMA_K(ti, slot) glds16(ksrc + (size_t)MB_K0(ti) * 512, (unsigned)__builtin_amdgcn_readfirstlane(lds0 + (unsigned)(slot) + wid * 1024))
#define DMA_V(ti, slot) glds16(vsrc + (size_t)MB_K0(ti) * 512, (unsigned)__builtin_amdgcn_readfirstlane(lds0 + OFF_V + (unsigned)(slot) + wid * 1024))
        DMA_K(0, 0); DMA_V(0, 0); DMA_K(1, KSTG); DMA_K(2, 2 * KSTG);
        { LAS float* Km = (LAS float*)(shm + OFF_KM);
          const float km0_ = ((const GAS float*)KM)[(size_t)bh * MOBA_NB * 64 + tu], km1_ = ((const GAS float*)KM)[(size_t)bh * MOBA_NB * 64 + tu + 512];
          __builtin_amdgcn_sched_barrier(0);
          Km[tu] = km0_; Km[tu + 512] = km1_;
          if (tu == 0) *(LAS unsigned*)(shm + OFF_MSK) = 0u; }
        bf16x8 qf[4];
        { const bf16* Qw = QA + (rowb + q0w + (lu & 31)) * 512 + h * 64;
#pragma unroll
          for (int d0 = 0; d0 < 4; ++d0) qf[d0] = *(const GAS bf16x8*)(Qw + d0 * 16 + (lu >> 5) * 8); }
        AT_WAIT_BAR(0);
        float b0 = -INFINITY, b1 = -INFINITY, b2 = -INFINITY; int i0 = -1, i1 = -1, i2 = -1;
        float qx[32];
#pragma unroll
        for (int d0 = 0; d0 < 4; ++d0)
#pragma unroll
            for (int e = 0; e < 8; ++e) qx[8 * d0 + e] = bf2f((bf16)qf[d0][e]);
        for (int jb0 = 0; jb0 < blk; jb0 += 2) {
            const int jb1 = jb0 + 1 < blk ? jb0 + 1 : jb0; float gg[2];
#pragma unroll
            for (int u2 = 0; u2 < 2; ++u2) { const LAS float* km = (const LAS float*)(shm + OFF_KM) + (u2 ? jb1 : jb0) * 64 + 8 * (lu >> 5); float ga = 0.f, gb = 0.f;
#pragma unroll
                for (int d0 = 0; d0 < 4; ++d0) { const f32x4 k0 = *(const LAS f32x4*)(km + d0 * 16), k1 = *(const LAS f32x4*)(km + d0 * 16 + 4);
                    ga += (qx[8 * d0 + 0] * k0[0] + qx[8 * d0 + 1] * k0[1]) + (qx[8 * d0 + 2] * k0[2] + qx[8 * d0 + 3] * k0[3]);
                    gb += (qx[8 * d0 + 4] * k1[0] + qx[8 * d0 + 5] * k1[1]) + (qx[8 * d0 + 6] * k1[2] + qx[8 * d0 + 7] * k1[3]); }
                gg[u2] = ga + gb; }
#pragma unroll
            for (int u2 = 0; u2 < 2; ++u2) { float g = gg[u2]; const int jb = u2 ? jb1 : jb0;
                { auto rr = __builtin_amdgcn_permlane32_swap(__float_as_uint(g), __float_as_uint(g), false, false); g = __uint_as_float(rr[0]) + __uint_as_float(rr[1]); }
                if (u2 == 0 || jb1 != jb0) { if (g > b0) { b2 = b1; i2 = i1; b1 = b0; i1 = i0; b0 = g; i0 = jb; } else if (g > b1) { b2 = b1; i2 = i1; b1 = g; i1 = jb; } else if (g > b2) { b2 = g; i2 = jb; } } }
        }
        unsigned mym = 0u; if (i0 >= 0) mym |= 1u << i0; if (i1 >= 0) mym |= 1u << i1; if (i2 >= 0) mym |= 1u << i2;
        { unsigned wm = mym;
#pragma unroll
          for (int o_ = 1; o_ < 64; o_ <<= 1) wm |= (unsigned)mk_shfl_xor((int)wm, o_);
          if (lu == 0) atomicOr((unsigned*)(shm + OFF_MSK), wm); }
        AT_WAIT_BAR(0);
        const unsigned wgm = (unsigned)__builtin_amdgcn_readfirstlane(*(volatile LAS unsigned*)(shm + OFF_MSK)) | (1u << blk);
        for (int jb = 0; jb < blk; ++jb) if ((wgm >> jb) & 1u) { blist |= (unsigned long long)jb << (4 * nb); ++nb; }
        const int NTI = 4 * nb;
        f32x16 o[2]; float mhat = 0.f, lsum = 0.f; o[0] = f32x16{}; o[1] = f32x16{};
        f32x16 pA0, pA1, pB0, pB1; bf16x8 kf[8]; s16x4 vlo[8], vhi[8]; u32x4 pw0, pw1, pw2, pw3; bool resc = false;
        const float akey = hi ? 1.0f : slope2 * (float)r32;
        unsigned sl_prev = 0u, sl_cur = 0u, sl_next = KSTG;
#define ROT() do { sl_prev = sl_cur; sl_cur = sl_next; sl_next = (sl_next == 2u * KSTG) ? 0u : sl_next + KSTG; } while (0)
#define PIN(x) asm volatile("" : "+v"(x))
#define KLD(sl, d0) do { const unsigned a_ = lds0 + (sl) + (unsigned)koff[d0]; kf[2 * (d0)] = *(const __attribute__((address_space(3))) bf16x8*)(uintptr_t)a_; kf[2 * (d0) + 1] = *(const __attribute__((address_space(3))) bf16x8*)(uintptr_t)(a_ + 4096u); } while (0)
#define VRD(i) do { vlo[i] = vtr(vp_ + (((i) >> 2) * 4096 + ((i) & 3) * 1024)); vhi[i] = vtr(vp_ + (((i) >> 2) * 4096 + ((i) & 3) * 1024 + 512)); } while (0)
#define VFR(i) (bf16x8){vlo[i][0], vlo[i][1], vlo[i][2], vlo[i][3], vhi[i][0], vhi[i][1], vhi[i][2], vhi[i][3]}
#define PKW(P, i) cvtpk(P[i], P[i + 1])
#define PAF(k) __builtin_bit_cast(bf16x8, pw##k)
#define EX(v) __builtin_amdgcn_exp2f(v)
#define SINIT(C0, C1, t) do { const int k0_ = MB_K0(t), jb_ = k0_ >> 8; const bool sel_ = (jb_ == blk) || ((mym >> jb_) & 1u); const float c_ = (sel_ ? slope2 * (float)(k0_ - q0w) : -INFINITY) - mhat; \
        const float b0_ = hi ? c_ : 1.0f, b1_ = hi ? c_ + slope2 * 32.f : 1.0f; C0 = __builtin_amdgcn_mfma_f32_32x32x2f32(akey, b0_, f32x16{}, 0, 0, 0); C1 = __builtin_amdgcn_mfma_f32_32x32x2f32(akey, b1_, f32x16{}, 0, 0, 0); } while (0)
#define DECIDE(C0, C1, t) do { if ((t) < 4) { const int qh_ = q0w + r32 - MB_K0(t) - 4 * hi; \
            _Pragma("unroll") for (int r = 0; r < 16; ++r) { const int kc = (r & 3) + 8 * (r >> 2); if (kc > qh_) C0[r] = -INFINITY; if (kc + 32 > qh_) C1[r] = -INFINITY; } } \
        C1[15] += 0.0f; C0[15] += 0.0f; AT_SB(); \
        float rm_; { float m0 = max3f(C0[0], C0[1], C1[0]), m1 = max3f(C0[2], C0[3], C1[1]); m0 = max3f(m0, C1[2], C1[3]); \
            _Pragma("unroll") for (int r = 4; r < 16; r += 4) { m0 = max3f(m0, C0[r], C0[r + 1]); m1 = max3f(m1, C0[r + 2], C0[r + 3]); m0 = max3f(m0, C1[r], C1[r + 1]); m1 = max3f(m1, C1[r + 2], C1[r + 3]); } \
            const float a_ = fmaxf(m0, m1); auto rr_ = __builtin_amdgcn_permlane32_swap(__float_as_uint(a_), __float_as_uint(a_), false, false); rm_ = fmaxf(__uint_as_float(rr_[0]), __uint_as_float(rr_[1])); } \
        resc = false; if (__any(rm_ > THR)) { const float dl_ = fmaxf(rm_, 0.f); mhat += dl_; _Pragma("unroll") for (int r = 0; r < 16; ++r) { C0[r] -= dl_; C1[r] -= dl_; } \
            const float f_ = __builtin_amdgcn_exp2f(-dl_); lsum *= f_; if (hi == 0) wsf[r32] = f_; resc = true; } } while (0)
#define RESC() do { if (resc) { asm volatile("s_waitcnt lgkmcnt(0)" ::: "memory"); _Pragma("unroll") for (int r = 0; r < 16; ++r) { const float f_ = (wsf + 4 * hi)[(r & 3) + 8 * (r >> 2)]; o[0][r] *= f_; o[1][r] *= f_; } } } while (0)
#define GAPA(MF, a0, a1, a2, a3, W0, W1, PW) do { MF; sacc += a0; sacc += a1; sacc += a2; sacc += a3; W0; W1; PIN(PW); PIN(sacc); AT_SB(); } while (0)
#define GAPB(MF, X, i) do { MF; X[i] = EX(X[i]); X[i + 1] = EX(X[i + 1]); X[i + 2] = EX(X[i + 2]); X[i + 3] = EX(X[i + 3]); PIN(X); AT_SB(); } while (0)
#define KRD(G, d0) do { if (G) { KLD(sl_next, d0); AT_SB(); } } while (0)
#define STEP(C0, C1, P0, P1, t) do { AT_SB(); const lds_cptr vp_ = vp0 + sl_prev; const bool gl_ = (t) + 1 < NTI; \
        SINIT(C0, C1, t); AT_SB(); \
        VRD(0); AT_SB(); float sacc = P0[0] + P0[1]; \
                         GAPA(C0 = AT_MFMA(kf[0], qf[0], C0), P0[2], P0[3], P0[4], P0[5],     pw0[0] = PKW(P0, 0),  pw0[1] = PKW(P0, 2),  pw0); \
        VRD(4); AT_SB(); GAPA(C1 = AT_MFMA(kf[1], qf[0], C1), P0[6], P0[7], P0[8], P0[9],     pw0[2] = PKW(P0, 4),  pw0[3] = PKW(P0, 6),  pw0); \
        VRD(1); AT_SB(); GAPA(C0 = AT_MFMA(kf[2], qf[1], C0), P0[10], P0[11], P0[12], P0[13], pw1[0] = PKW(P0, 8),  pw1[1] = PKW(P0, 10), pw1); \
        VRD(5); AT_SB(); GAPA(C1 = AT_MFMA(kf[3], qf[1], C1), P0[14], P0[15], P1[0], P1[1],   pw1[2] = PKW(P0, 12), pw1[3] = PKW(P0, 14), pw1); \
        VRD(2); AT_SB(); GAPA(C0 = AT_MFMA(kf[4], qf[2], C0), P1[2], P1[3], P1[4], P1[5],     pw2[0] = PKW(P1, 0),  pw2[1] = PKW(P1, 2),  pw2); \
        VRD(6); AT_SB(); GAPA(C1 = AT_MFMA(kf[5], qf[2], C1), P1[6], P1[7], P1[8], P1[9],     pw2[2] = PKW(P1, 4),  pw2[3] = PKW(P1, 6),  pw2); \
        VRD(3); AT_SB(); GAPA(C0 = AT_MFMA(kf[6], qf[3], C0), P1[10], P1[11], P1[12], P1[13], pw3[0] = PKW(P1, 8),  pw3[1] = PKW(P1, 10), pw3); \
        VRD(7); AT_SB(); GAPA(C1 = AT_MFMA(kf[7], qf[3], C1), P1[14], P1[15], 0.f, 0.f,       pw3[2] = PKW(P1, 12), pw3[3] = PKW(P1, 14), pw3); \
        lsum += sacc; \
        if ((t) + 3 < NTI) DMA_K((t) + 3, sl_cur); if ((t) + 1 < NTI) DMA_V((t) + 1, sl_next);        \
        DECIDE(C0, C1, t); AT_SB(); \
        GAPB(o[0] = AT_MFMA(PAF(0), VFR(0), o[0]), C0, 0);               GAPB(o[1] = AT_MFMA(PAF(0), VFR(4), o[1]), C0, 4); \
        KRD(gl_, 0); GAPB(o[0] = AT_MFMA(PAF(1), VFR(1), o[0]), C0, 8);  KRD(gl_, 1); GAPB(o[1] = AT_MFMA(PAF(1), VFR(5), o[1]), C0, 12); \
        KRD(gl_, 2); GAPB(o[0] = AT_MFMA(PAF(2), VFR(2), o[0]), C1, 0);  KRD(gl_, 3); GAPB(o[1] = AT_MFMA(PAF(2), VFR(6), o[1]), C1, 4); \
        GAPB(o[0] = AT_MFMA(PAF(3), VFR(3), o[0]), C1, 8);               GAPB(o[1] = AT_MFMA(PAF(3), VFR(7), o[1]), C1, 12); \
        } while (0)
#define ENDW(t) do { if ((t) + 3 < NTI) { AT_WAIT_BAR(2); } else if ((t) + 1 < NTI) { AT_WAIT_BAR(1); } else { AT_WAIT_BAR(0); } } while (0)
        _Pragma("unroll") for (int d0 = 0; d0 < 4; ++d0) KLD(0u, d0);
        SINIT(pA0, pA1, 0);
        _Pragma("unroll") for (int d0 = 0; d0 < 4; ++d0) { pA0 = AT_MFMA(kf[2 * d0], qf[d0], pA0); pA1 = AT_MFMA(kf[2 * d0 + 1], qf[d0], pA1); }
        AT_SB(); DECIDE(pA0, pA1, 0);
        _Pragma("unroll") for (int r = 0; r < 16; ++r) { pA0[r] = EX(pA0[r]); pA1[r] = EX(pA1[r]); }
        AT_WAIT_BAR(0);
        DMA_K(3, 0); DMA_V(1, KSTG); ROT();
        _Pragma("unroll") for (int d0 = 0; d0 < 4; ++d0) KLD(sl_cur, d0);
        AT_WAIT_BAR(2);
        { int t = 1;
          for (; t + 1 < NTI; t += 2) {
              STEP(pB0, pB1, pA0, pA1, t);     ENDW(t);     RESC(); ROT();
              STEP(pA0, pA1, pB0, pB1, t + 1); ENDW(t + 1); RESC(); ROT(); }
          STEP(pB0, pB1, pA0, pA1, t); ENDW(t); RESC(); ROT(); }
        { float sacc = pB0[0] + pB0[1];
          _Pragma("unroll") for (int r = 2; r < 16; ++r) sacc += pB0[r];
          _Pragma("unroll") for (int r = 0; r < 16; ++r) sacc += pB1[r];
          lsum += sacc;
          pw0 = (u32x4){PKW(pB0, 0), PKW(pB0, 2), PKW(pB0, 4), PKW(pB0, 6)}; pw1 = (u32x4){PKW(pB0, 8), PKW(pB0, 10), PKW(pB0, 12), PKW(pB0, 14)};
          pw2 = (u32x4){PKW(pB1, 0), PKW(pB1, 2), PKW(pB1, 4), PKW(pB1, 6)}; pw3 = (u32x4){PKW(pB1, 8), PKW(pB1, 10), PKW(pB1, 12), PKW(pB1, 14)};
          const lds_cptr vp_ = vp0 + sl_prev; _Pragma("unroll") for (int i = 0; i < 8; ++i) VRD(i);
          o[0] = AT_MFMA(PAF(0), VFR(0), o[0]); o[1] = AT_MFMA(PAF(0), VFR(4), o[1]); o[0] = AT_MFMA(PAF(1), VFR(1), o[0]); o[1] = AT_MFMA(PAF(1), VFR(5), o[1]);
          o[0] = AT_MFMA(PAF(2), VFR(2), o[0]); o[1] = AT_MFMA(PAF(2), VFR(6), o[1]); o[0] = AT_MFMA(PAF(3), VFR(3), o[0]); o[1] = AT_MFMA(PAF(3), VFR(7), o[1]); }
        AT_WAIT_BAR(0);
#undef DMA_K
#undef DMA_V
#undef ROT
#undef PIN
#undef KLD
#undef VRD
#undef VFR
#undef PKW
#undef PAF
#undef EX
#undef SINIT
#undef DECIDE
#undef RESC
#undef GAPA
#undef GAPB
#undef KRD
#undef STEP
#undef ENDW
#undef MB_K0
        { auto rr = __builtin_amdgcn_permlane32_swap(__float_as_uint(lsum), __float_as_uint(lsum), false, false); lsum = __uint_as_float(rr[0]) + __uint_as_float(rr[1]); }
        if (hi == 0) wsf[32 + r32] = lsum;
        asm volatile("s_waitcnt lgkmcnt(0)" ::: "memory");
        { int le_ = mk_lane(); asm volatile("" : "+v"(le_));
          LAS bf16* stg = (LAS bf16*)(shm + OFF_Q + wid * 4096) + (4 * (le_ >> 5)) * 64 + (le_ & 31);
#pragma unroll
          for (int r = 0; r < 16; ++r) { const float il = 1.0f / (wsf + 32 + 4 * (le_ >> 5))[(r & 3) + 8 * (r >> 2)];
#pragma unroll
              for (int db = 0; db < 2; ++db) stg[((r & 3) + 8 * (r >> 2)) * 64 + db * 32] = (bf16)f2bf(o[db][r] * il); }
          asm volatile("s_waitcnt lgkmcnt(0)" ::: "memory");
          bf16* Ow = YA + (rowb + q0w) * YP + h * 64;
#pragma unroll
          for (int i = 0; i < 4; ++i) { const int row = i * 8 + (le_ >> 3), ch = le_ & 7; const v4u v = *(const LAS v4u*)(shm + OFF_Q + wid * 4096 + row * 128 + ch * 16); *(GAS v4u*)(Ow + (size_t)row * YP + ch * 8) = v; } }
        AT_WAIT_BAR(0);
    }
}
__device__ __forceinline__ void ph_moba_naive(Frame& F) {
    LAS float* Ks = (LAS float*)(F.lds + RING_OFF); LAS float* Vs = Ks + 64 * 64; LAS float* Km = Vs + 64 * 64; LAS unsigned* msk = (LAS unsigned*)(Km + MOBA_NB * 64);
    const bf16* QA = (const bf16*)(F.ws + WS_QA); const bf16* KA = (const bf16*)(F.ws + WS_KA); const bf16* VA = (const bf16*)(F.ws + WS_VA); bf16* YA = (bf16*)(F.ws + WS_YA);
    const float* KM = (const float*)(F.ws + WS_KMEAN);
    const int row = F.tid >> 2, qd = F.tid & 3;
    for (int idx = F.vcu; idx < BATCH * MOBA_H * 32; idx += F.G) {
        int bh, qt; causal_unit(idx, BATCH * MOBA_H, true, bh, qt);
        const int b = bh / MOBA_H, h = bh % MOBA_H, blk = qt >> 1; const int qpos = qt * 128 + row; const size_t grow = (size_t)b * SEQ + qpos;
        const float slope2 = exp2f(-(float)(h + 1)) * LOG2E;
        __syncthreads();
        for (int i = F.tid; i < MOBA_NB * 64; i += NWAVES * 64) Km[i] = KM[(size_t)bh * MOBA_NB * 64 + i];
        if (F.tid == 0) msk[0] = 0u;
        __syncthreads();
        float q[16]; load_q16(q, QA + grow * 512 + h * 64 + qd * 16);
        float b0 = -INFINITY, b1 = -INFINITY, b2 = -INFINITY; int i0 = -1, i1 = -1, i2 = -1;
        for (int j = 0; j < blk; ++j) { float g = 0.f;
#pragma unroll
            for (int d = 0; d < 16; ++d) g += q[d] * Km[j * 64 + qd * 16 + d];
            g += mk_shfl_xor(g, 1); g += mk_shfl_xor(g, 2);
            if (g > b0) { b2 = b1; i2 = i1; b1 = b0; i1 = i0; b0 = g; i0 = j; } else if (g > b1) { b2 = b1; i2 = i1; b1 = g; i1 = j; } else if (g > b2) { b2 = g; i2 = j; } }
        unsigned mym = 0u; if (i0 >= 0) mym |= 1u << i0; if (i1 >= 0) mym |= 1u << i1; if (i2 >= 0) mym |= 1u << i2;
        atomicOr((unsigned*)msk, mym);
        __syncthreads();
        const unsigned wgm = msk[0];
        float o[16]; float mr = -INFINITY, lr = 0.f;
#pragma unroll
        for (int d = 0; d < 16; ++d) o[d] = 0.f;
        for (int jb = blk; jb >= 0; --jb) {
            if (jb != blk && !((wgm >> jb) & 1u)) continue;
            const bool mine = (jb == blk) || ((mym >> jb) & 1u);
            const int ktop = (jb == blk) ? (2 * (qt & 1) + 1) : 3;
            for (int kt = ktop; kt >= 0; --kt) {
                __syncthreads();
                const size_t krow = (size_t)b * SEQ + jb * 256 + kt * 64;
                naive_stage<64>(F, Ks, Vs, KA + krow * 512 + h * 64, VA + krow * 512 + h * 64);
                __syncthreads();
                naive_tile<16, 64>(Ks, Vs, q, o, mr, lr, qpos, jb * 256 + kt * 64, slope2, mine, qd);
            }
        }
        const float il = 1.0f / lr; bf16* yp = YA + grow * YP + h * 64 + qd * 16;
#pragma unroll
        for (int d = 0; d < 16; d += 8) { v4u w; w.x = pk2(o[d] * il, o[d + 1] * il); w.y = pk2(o[d + 2] * il, o[d + 3] * il); w.z = pk2(o[d + 4] * il, o[d + 5] * il); w.w = pk2(o[d + 6] * il, o[d + 7] * il); *(GAS v4u*)(yp + d) = w; }
    }
    __syncthreads();
}
template <bool FIX> __device__ __forceinline__ void ph_rglru_mfma(Frame& F, const RgP& P) {
    using namespace at;
    const int wid = F.wave;
    constexpr int OFF_CT = 16384, OFF_RAW = 18432, RAWB = 9216;
    LAS unsigned char* shm = F.lds + RING_OFF; const unsigned lds0 = (unsigned)(uintptr_t)shm;
    LAS unsigned char* wfr = shm; LAS float* ctab = (LAS float*)(shm + OFF_CT); const lds_cptr rawp = (lds_cptr)shm + OFF_RAW + wid * RAWB;
    const bf16* RX = (const bf16*)(F.ws + WS_RX); const bf16* RG = (const bf16*)(F.ws + WS_RG); bf16* YB = (bf16*)(F.ws + WS_YB);
    bf16* XRp = (bf16*)(F.ws + WS_MG);
    float* AG = (float*)(F.ws + WS_AGG); float* BG = AG + (size_t)BATCH * RG_NCH * D; const float* CI = (const float*)(F.ws + WS_CARRY);
    const bf16* WT = (const bf16*)(F.ws + WS_RGW);
    const bf16* ZR = (const bf16*)(F.ws + 640 * 1024);
    const bool grp = (F.G % RG_NB) == 0;
    const int nstart = grp ? F.vcu % RG_NB : 0, nstep = grp ? RG_NB : 1, wn = grp ? (F.vcu / RG_NB) * NWAVES + wid : F.vcu * NWAVES + wid, NWn = grp ? (F.G / RG_NB) * NWAVES : F.G * NWAVES;
    for (int n = nstart; n < RG_NB; n += nstep) {
        __syncthreads();
        const bf16* SRCX = FIX ? XRp : RX; constexpr int HAL = FIX ? 0 : 3, NPC = FIX ? 8 : 9;
#define RG_DMA(Q_) do { const int b_ = (Q_) / RG_NCH, c_ = (Q_) % RG_NCH; int ld_ = mk_lane(); \
            _Pragma("unroll") for (int i = 0; i < NPC; ++i) { const int br = 8 * i + (ld_ >> 3), chunk = (ld_ & 7) ^ ((br >> 1) & 7); int trow = c_ * RG_CHUNK - HAL + br; const int tmax = c_ * RG_CHUNK + RG_CHUNK - 1; \
                const bf16* src = trow >= 0 ? SRCX + ((size_t)b_ * SEQ + (trow > tmax ? tmax : trow)) * D + n * 64 + chunk * 8 : ZR + chunk * 8; \
                glds16(src, (unsigned)__builtin_amdgcn_readfirstlane(lds0 + OFF_RAW + wid * RAWB + i * 1024)); } } while (0)
        const bool blocked = FIX && ((BATCH * RG_NCH) % NWn == 0);
        const int upw = blocked ? (BATCH * RG_NCH) / NWn : 0, qstep = blocked ? 1 : NWn, qbeg = blocked ? wn * upw : wn, qend = blocked ? qbeg + upw : BATCH * RG_NCH;
        if (qbeg < qend) RG_DMA(qbeg);
        float ba[2], bx[2], c8[2];
        { int t_ = wid * 64 + mk_lane(); asm volatile("" : "+v"(t_));
          bf16x8 wv_[2]; float ctv_ = 0.f, pa_[2], px_[2], pl_[2];
#pragma unroll
          for (int i = 0; i < 2; ++i) { const int p = t_ + i * 512, f = p >> 6, ln = p & 63, ct = f >> 3, g = (f >> 2) & 1, ks = f & 3;
              wv_[i] = *(const GAS bf16x8*)(WT + ((size_t)(g * RG_NB + n) * 64 + 32 * ct + (ln & 31)) * 64 + 16 * ks + 8 * (ln >> 5)); }
          if (!FIX && t_ < 320) ctv_ = t_ < 256 ? ((const GAS float*)P.conv_w)[(t_ >> 6) * D + n * 64 + (t_ & 63)] : ((const GAS float*)P.conv_b)[n * 64 + (t_ & 63)];
#pragma unroll
          for (int ct = 0; ct < 2; ++ct) { const int ch = n * 64 + 32 * ct + (t_ & 31); pa_[ct] = ((const GAS float*)P.b_a)[ch]; px_[ct] = ((const GAS float*)P.b_x)[ch]; pl_[ct] = ((const GAS float*)P.lam)[ch]; }
          __builtin_amdgcn_sched_barrier(0);
#pragma unroll
          for (int i = 0; i < 2; ++i) *(LAS bf16x8*)(wfr + (t_ + i * 512) * 16) = wv_[i];
          if (!FIX && t_ < 320) ctab[t_] = ctv_;
#pragma unroll
          for (int ct = 0; ct < 2; ++ct) { ba[ct] = -pa_[ct] * LOG2E; bx[ct] = -px_[ct] * LOG2E; c8[ct] = -8.0f * log1pf(expf(-pl_[ct])) * LOG2E; } }
        __syncthreads();
        int prevq = -2; float hprev[2] = {0.f, 0.f};
        for (int q = qbeg; q < qend; q += qstep) {
            const int c = q % RG_NCH, b = q / RG_NCH;
            const int lq_ = mk_lane(), r32o = lq_ & 31, hio = lq_ >> 5;
            const size_t rb = (size_t)b * SEQ; const size_t aidx = ((size_t)b * RG_NCH + c) * D + n * 64 + r32o;
            float h[2] = {0.f, 0.f}, pa[2] = {1.f, 1.f};
            if (FIX && c != 0) {
                if (q == prevq + 1) { h[0] = hprev[0]; h[1] = hprev[1]; }
                else { const float* Ap = AG + (size_t)b * RG_NCH * D + n * 64 + r32o; const float* Bp = BG + (size_t)b * RG_NCH * D + n * 64 + r32o;
                    for (int k0 = 0; k0 < c; k0 += 16) { float a0[16], b0[16], a1[16], b1[16];
#pragma unroll
                        for (int j = 0; j < 16; ++j) { const size_t o_ = (size_t)(k0 + j < c ? k0 + j : 0) * D; a0[j] = ((const GAS float*)Ap)[o_]; b0[j] = ((const GAS float*)Bp)[o_]; a1[j] = ((const GAS float*)Ap)[o_ + 32]; b1[j] = ((const GAS float*)Bp)[o_ + 32]; }
                        __builtin_amdgcn_sched_barrier(0);
#pragma unroll
                        for (int j = 0; j < 16; ++j) { const bool ok = k0 + j < c; h[0] = (ok ? a0[j] : 1.f) * h[0] + (ok ? b0[j] : 0.f); h[1] = (ok ? a1[j] : 1.f) * h[1] + (ok ? b1[j] : 0.f); } } } }
            asm volatile("s_waitcnt vmcnt(0)" ::: "memory");
#pragma unroll 1
            for (int tt = 0; tt < 2; ++tt) {
                const int t0 = c * RG_CHUNK + tt * 32;
                int lt_ = mk_lane(); const int r32 = lt_ & 31, hi = lt_ >> 5;
                bf16x8 Af[4];
#pragma unroll
                for (int ks = 0; ks < 4; ++ks) { const int cc = 16 * ks + 8 * hi; float x8[8];
                    if (FIX) { const int br = tt * 32 + r32; Af[ks] = *(const LAS bf16x8*)(rawp + br * 128 + (((2 * ks + hi) ^ ((br >> 1) & 7)) << 4)); continue; }
                    { const f32x4 b0 = *(const LAS f32x4*)(ctab + 256 + cc), b1 = *(const LAS f32x4*)(ctab + 256 + cc + 4); x8[0] = b0[0]; x8[1] = b0[1]; x8[2] = b0[2]; x8[3] = b0[3]; x8[4] = b1[0]; x8[5] = b1[1]; x8[6] = b1[2]; x8[7] = b1[3]; }
#pragma unroll
                    for (int j = 0; j < 4; ++j) { const int br = tt * 32 + r32 + j; const v4u w = *(const LAS v4u*)(rawp + br * 128 + (((2 * ks + hi) ^ ((br >> 1) & 7)) << 4));
                        const f32x4 w0 = *(const LAS f32x4*)(ctab + j * 64 + cc), w1 = *(const LAS f32x4*)(ctab + j * 64 + cc + 4);
                        x8[0] += w0[0] * bf_lo(w.x); x8[1] += w0[1] * bf_hi(w.x); x8[2] += w0[2] * bf_lo(w.y); x8[3] += w0[3] * bf_hi(w.y);
                        x8[4] += w1[0] * bf_lo(w.z); x8[5] += w1[1] * bf_hi(w.z); x8[6] += w1[2] * bf_lo(w.w); x8[7] += w1[3] * bf_hi(w.w); }
                    const u32x4 pk = (u32x4){cvtpk(x8[0], x8[1]), cvtpk(x8[2], x8[3]), cvtpk(x8[4], x8[5]), cvtpk(x8[6], x8[7])}; Af[ks] = __builtin_bit_cast(bf16x8, pk);
                    *(GAS u32x4*)(XRp + ((size_t)b * SEQ + c * RG_CHUNK + tt * 32 + r32) * D + n * 64 + cc) = pk;
                    }
                if (tt == 1 && q + qstep < qend) { asm volatile("s_waitcnt lgkmcnt(0)" ::: "memory"); RG_DMA(q + qstep); }
#pragma unroll
            for (int ct = 0; ct < 2; ++ct) {
                bf16 rgv[16];
                if (FIX) { const GAS bf16* rgp = (const GAS bf16*)RG + (rb + t0 + 4 * hi) * D + n * 64 + 32 * ct + r32;
#pragma unroll
                    for (int r = 0; r < 16; ++r) rgv[r] = rgp[(size_t)((r & 3) + 8 * (r >> 2)) * D];
                    __builtin_amdgcn_sched_barrier(0); }
                f32x16 accr = f32x16{}, acci = f32x16{}, accx = f32x16{};
                { bf16x8 Br[4], Bi[4];
#pragma unroll
                  for (int ks = 0; ks < 4; ++ks) { Br[ks] = *(const LAS bf16x8*)(wfr + ((ct * 2 + 0) * 4 + ks) * 1024 + lt_ * 16); Bi[ks] = *(const LAS bf16x8*)(wfr + ((ct * 2 + 1) * 4 + ks) * 1024 + lt_ * 16); }
#pragma unroll
                  for (int ks = 0; ks < 4; ++ks) { accr = AT_MFMA(Af[ks], Br[ks], accr); acci = AT_MFMA(Af[ks], Bi[ks], acci); } }
#pragma unroll
                for (int kk = 0; kk < 2; ++kk) { const int ks = 2 * ct + kk; bf16x8 idf;
#pragma unroll
                    for (int j = 0; j < 8; ++j) idf[j] = (16 * kk + 8 * hi + j == r32) ? (short)0x3F80 : (short)0;
                    accx = AT_MFMA(Af[ks], idf, accx); }
                float a[16], bb[16];
#pragma unroll
                for (int r = 0; r < 16; ++r) { const float rg = __builtin_amdgcn_rcpf(1.0f + __builtin_amdgcn_exp2f(__builtin_fmaf(accr[r], -LOG2E, ba[ct]))), ig = __builtin_amdgcn_rcpf(1.0f + __builtin_amdgcn_exp2f(__builtin_fmaf(acci[r], -LOG2E, bx[ct])));
                    const float la2 = c8[ct] * rg; a[r] = __builtin_amdgcn_exp2f(la2); const float om = 1.0f - a[r] * a[r]; bb[r] = __builtin_amdgcn_sqrtf(fmaxf(om, 0.f)) * (ig * accx[r]); }
                float Ag[4], Bg[4], pA[4], pB[4];
#pragma unroll
                for (int g = 0; g < 4; ++g) { Ag[g] = (a[4 * g] * a[4 * g + 1]) * (a[4 * g + 2] * a[4 * g + 3]); Bg[g] = ((bb[4 * g] * a[4 * g + 1] + bb[4 * g + 1]) * a[4 * g + 2] + bb[4 * g + 2]) * a[4 * g + 3] + bb[4 * g + 3];
                    auto ra = __builtin_amdgcn_permlane32_swap(__float_as_uint(Ag[g]), __float_as_uint(Ag[g]), false, false); pA[g] = __uint_as_float(hi ? ra[0] : ra[1]);
                    auto rbb = __builtin_amdgcn_permlane32_swap(__float_as_uint(Bg[g]), __float_as_uint(Bg[g]), false, false); pB[g] = __uint_as_float(hi ? rbb[0] : rbb[1]); }
                float cin[4], cc_ = h[ct], pp = pa[ct];
#pragma unroll
                for (int k = 0; k < 8; ++k) { const int g = k >> 1; const bool mine = (hi == (k & 1)); if (mine) cin[g] = cc_;
                    const float Ak = mine ? Ag[g] : pA[g], Bk = mine ? Bg[g] : pB[g]; cc_ = Ak * cc_ + Bk; pp *= Ak; }
                h[ct] = cc_; pa[ct] = pp;
                if (FIX) { GAS bf16* yg = (GAS bf16*)YB + (rb + t0 + 4 * hi) * YP + n * 64 + 32 * ct + r32;
#pragma unroll
                    for (int g = 0; g < 4; ++g) { float hv = cin[g];
#pragma unroll
                        for (int e = 0; e < 4; ++e) { const int r = 4 * g + e; hv = a[r] * hv + bb[r]; yg[(size_t)(e + 8 * g) * YP] = (bf16)f2bf(hv * bf2f(rgv[r])); } } }
            }
            }
            if (!FIX && hio == 0) {
#pragma unroll
                for (int ct = 0; ct < 2; ++ct) { ((GAS float*)AG)[aidx + 32 * ct] = pa[ct]; ((GAS float*)BG)[aidx + 32 * ct] = h[ct]; } }
            prevq = q; hprev[0] = h[0]; hprev[1] = h[1];
        }
#undef RG_DMA
    }
    asm volatile("s_waitcnt vmcnt(0)" ::: "memory");
}
__device__ __forceinline__ void ph_ffnact(Frame& F, const float* cw  , const float* cbias  ) {
    const bf16* U = (const bf16*)(F.ws + WS_U); bf16* ACT = (bf16*)(F.ws + WS_ACT);
    constexpr int RW = 16, NCK = DFF / 8; const int total = (M / RW) * NCK, stride = F.G * NWAVES * 64;
    for (int i = F.vcu * NWAVES * 64 + F.tid; i < total; i += stride) {
        const int rg = i / NCK, c = (i % NCK) * 8, row0 = rg * RW, t0 = row0 % SEQ;
        float wg[3][8], wv[3][8], bg[8], bv[8];
#pragma unroll
        for (int j = 0; j < 3; ++j) { const f32x4 a0 = *(const GAS f32x4*)(cw + (size_t)j * DFF2 + c), a1 = *(const GAS f32x4*)(cw + (size_t)j * DFF2 + c + 4), v0 = *(const GAS f32x4*)(cw + (size_t)j * DFF2 + DFF + c), v1 = *(const GAS f32x4*)(cw + (size_t)j * DFF2 + DFF + c + 4);
            wg[j][0] = a0[0]; wg[j][1] = a0[1]; wg[j][2] = a0[2]; wg[j][3] = a0[3]; wg[j][4] = a1[0]; wg[j][5] = a1[1]; wg[j][6] = a1[2]; wg[j][7] = a1[3];
            wv[j][0] = v0[0]; wv[j][1] = v0[1]; wv[j][2] = v0[2]; wv[j][3] = v0[3]; wv[j][4] = v1[0]; wv[j][5] = v1[1]; wv[j][6] = v1[2]; wv[j][7] = v1[3]; }
        { const f32x4 a0 = *(const GAS f32x4*)(cbias + c), a1 = *(const GAS f32x4*)(cbias + c + 4), v0 = *(const GAS f32x4*)(cbias + DFF + c), v1 = *(const GAS f32x4*)(cbias + DFF + c + 4);
          bg[0] = a0[0]; bg[1] = a0[1]; bg[2] = a0[2]; bg[3] = a0[3]; bg[4] = a1[0]; bg[5] = a1[1]; bg[6] = a1[2]; bg[7] = a1[3]; bv[0] = v0[0]; bv[1] = v0[1]; bv[2] = v0[2]; bv[3] = v0[3]; bv[4] = v1[0]; bv[5] = v1[1]; bv[6] = v1[2]; bv[7] = v1[3]; }
        v4u g2 = (v4u){0u, 0u, 0u, 0u}, g1 = g2, v2 = g2, v1_ = g2;
        if (t0 >= 2) { const bf16* up = U + (size_t)(row0 - 2) * DFF2 + c; g2 = *(const GAS v4u*)up; v2 = *(const GAS v4u*)(up + DFF); }
        if (t0 >= 1) { const bf16* up = U + (size_t)(row0 - 1) * DFF2 + c; g1 = *(const GAS v4u*)up; v1_ = *(const GAS v4u*)(up + DFF); }
#pragma unroll 4
        for (int r = 0; r < RW; ++r) {
            const bf16* up = U + (size_t)(row0 + r) * DFF2 + c; const v4u g0 = *(const GAS v4u*)up, v0 = *(const GAS v4u*)(up + DFF);
            float ug[8], uv[8];
#define FA_ROW(D_, W_, X_) D_[0] += W_[0] * bf_lo(X_.x); D_[1] += W_[1] * bf_hi(X_.x); D_[2] += W_[2] * bf_lo(X_.y); D_[3] += W_[3] * bf_hi(X_.y); D_[4] += W_[4] * bf_lo(X_.z); D_[5] += W_[5] * bf_hi(X_.z); D_[6] += W_[6] * bf_lo(X_.w); D_[7] += W_[7] * bf_hi(X_.w);
#pragma unroll
            for (int e = 0; e < 8; ++e) { ug[e] = bg[e]; uv[e] = bv[e]; }
            FA_ROW(ug, wg[0], g2) FA_ROW(ug, wg[1], g1) FA_ROW(ug, wg[2], g0) FA_ROW(uv, wv[0], v2) FA_ROW(uv, wv[1], v1_) FA_ROW(uv, wv[2], v0)
#undef FA_ROW
            v4u w; w.x = pk2(pg8::gelu_tanh_f(ug[0]) * uv[0], pg8::gelu_tanh_f(ug[1]) * uv[1]); w.y = pk2(pg8::gelu_tanh_f(ug[2]) * uv[2], pg8::gelu_tanh_f(ug[3]) * uv[3]);
            w.z = pk2(pg8::gelu_tanh_f(ug[4]) * uv[4], pg8::gelu_tanh_f(ug[5]) * uv[5]); w.w = pk2(pg8::gelu_tanh_f(ug[6]) * uv[6], pg8::gelu_tanh_f(ug[7]) * uv[7]);
            *(GAS v4u*)(ACT + (size_t)(row0 + r) * DFF + c) = w;
            g2 = g1; g1 = g0; v2 = v1_; v1_ = v0;
        }
    }
}
__device__ __forceinline__ void ph_ffnfix(Frame& F, const float* cw  , const float* cbias  , int panel = -1  ) {
    const bf16* UH = (const bf16*)(F.ws + WS_U); bf16* ACT = (bf16*)(F.ws + WS_ACT);
    constexpr int NCK = DFF / 8; const int total = (panel >= 0 ? 4 : M / 64) * 2 * NCK, stride = panel >= 0 ? NWAVES * 64 : F.G * NWAVES * 64;
    for (int i = (panel >= 0 ? 0 : F.vcu * NWAVES * 64) + F.tid; i < total; i += stride) {
        const int c = (i % NCK) * 8, sk = i / NCK + (panel >= 0 ? panel * 8 : 0), k = sk & 1, sl = sk >> 1; const bool hasprev = (sl % (SEQ / 64)) != 0;
        const bf16* r0 = UH + ((size_t)sl * 4 + (k == 0 ? 0 : 1)) * DFF2 + c;
        const bf16* r1 = k == 0 ? UH + ((size_t)(sl - 1) * 4 + 3) * DFF2 + c : UH + ((size_t)sl * 4 + 0) * DFF2 + c;
        const bf16* r2 = k == 0 ? UH + ((size_t)(sl - 1) * 4 + 2) * DFF2 + c : UH + ((size_t)(sl - 1) * 4 + 3) * DFF2 + c;
        const bool v1ok = (k == 1) || hasprev, v2ok = hasprev; const v4u z = (v4u){0u, 0u, 0u, 0u};
        const v4u g0 = *(const GAS v4u*)r0, v0 = *(const GAS v4u*)(r0 + DFF), g1 = v1ok ? *(const GAS v4u*)r1 : z, v1_ = v1ok ? *(const GAS v4u*)(r1 + DFF) : z, g2 = v2ok ? *(const GAS v4u*)r2 : z, v2 = v2ok ? *(const GAS v4u*)(r2 + DFF) : z;
        f32x4 wv[6][2], bs[4];
        { const GAS float* cg = (const GAS float*)cw + c; const GAS float* bg = (const GAS float*)cbias + c;
#pragma unroll
          for (int r = 0; r < 3; ++r) { wv[r][0] = *(const GAS f32x4*)(cg + r * DFF2); wv[r][1] = *(const GAS f32x4*)(cg + r * DFF2 + 4); wv[3 + r][0] = *(const GAS f32x4*)(cg + r * DFF2 + DFF); wv[3 + r][1] = *(const GAS f32x4*)(cg + r * DFF2 + DFF + 4); }
          bs[0] = *(const GAS f32x4*)bg; bs[1] = *(const GAS f32x4*)(bg + 4); bs[2] = *(const GAS f32x4*)(bg + DFF); bs[3] = *(const GAS f32x4*)(bg + DFF + 4); }
        __builtin_amdgcn_sched_barrier(0);
        float ug[8], uv[8];
#pragma unroll
        for (int e = 0; e < 4; ++e) { ug[e] = bs[0][e]; ug[4 + e] = bs[1][e]; uv[e] = bs[2][e]; uv[4 + e] = bs[3][e]; }
#define FX_ROW(D_, W_, X_) D_[0] += (W_)[0][0] * bf_lo(X_.x); D_[1] += (W_)[0][1] * bf_hi(X_.x); D_[2] += (W_)[0][2] * bf_lo(X_.y); D_[3] += (W_)[0][3] * bf_hi(X_.y); D_[4] += (W_)[1][0] * bf_lo(X_.z); D_[5] += (W_)[1][1] * bf_hi(X_.z); D_[6] += (W_)[1][2] * bf_lo(X_.w); D_[7] += (W_)[1][3] * bf_hi(X_.w);
        FX_ROW(ug, wv[0], g2) FX_ROW(ug, wv[1], g1) FX_ROW(ug, wv[2], g0) FX_ROW(uv, wv[3], v2) FX_ROW(uv, wv[4], v1_) FX_ROW(uv, wv[5], v0)
#undef FX_ROW
        v4u w; w.x = pk2(pg8::gelu_tanh_f(ug[0]) * uv[0], pg8::gelu_tanh_f(ug[1]) * uv[1]); w.y = pk2(pg8::gelu_tanh_f(ug[2]) * uv[2], pg8::gelu_tanh_f(ug[3]) * uv[3]);
        w.z = pk2(pg8::gelu_tanh_f(ug[4]) * uv[4], pg8::gelu_tanh_f(ug[5]) * uv[5]); w.w = pk2(pg8::gelu_tanh_f(ug[6]) * uv[6], pg8::gelu_tanh_f(ug[7]) * uv[7]);
        *(GAS v4u*)(ACT + ((size_t)sl * 64 + k) * DFF + c) = w;
    }
}
__device__ __forceinline__ void ph_final(Frame& F, const bf16* xh, const bf16* xlo, float* out, const float* g) {
    (void)xlo; static_assert(RESID_LO == 0, "the residual stream is xh only");
    typedef unsigned u32x2v __attribute__((ext_vector_type(2)));
    const int gw = F.vcu * NWAVES + F.wave, NGW = F.G * NWAVES;
    f32x4 gg[4];
#pragma unroll
    for (int j = 0; j < 4; ++j) gg[j] = *((const GAS f32x4*)g + F.lane + 64 * j);
    for (int m = gw; m < M; m += 2 * NGW) {
        const int m1 = m + NGW; const bool two = m1 < M;
        const GAS u32x2v* hr0 = (const GAS u32x2v*)(xh + (size_t)m * D) + F.lane; const GAS u32x2v* hr1 = (const GAS u32x2v*)(xh + (size_t)(two ? m1 : m) * D) + F.lane;
        u32x2v h0[4], h1[4];
#pragma unroll
        for (int j = 0; j < 4; ++j) { h0[j] = hr0[64 * j]; h1[j] = hr1[64 * j]; }
        f32x4 v0[4], v1[4]; float s0 = 0.f, s1 = 0.f;
#pragma unroll
        for (int j = 0; j < 4; ++j) { v0[j] = (f32x4){bf_lo(h0[j].x), bf_hi(h0[j].x), bf_lo(h0[j].y), bf_hi(h0[j].y)}; v1[j] = (f32x4){bf_lo(h1[j].x), bf_hi(h1[j].x), bf_lo(h1[j].y), bf_hi(h1[j].y)};
            s0 += (v0[j].x * v0[j].x + v0[j].y * v0[j].y) + (v0[j].z * v0[j].z + v0[j].w * v0[j].w); s1 += (v1[j].x * v1[j].x + v1[j].y * v1[j].y) + (v1[j].z * v1[j].z + v1[j].w * v1[j].w); }
        const float rs0 = rsqrtf(wave_sum(s0) * (1.0f / D) + 1e-6f), rs1 = rsqrtf(wave_sum(s1) * (1.0f / D) + 1e-6f);
        GAS f32x4* o0 = (GAS f32x4*)(out + (size_t)m * D) + F.lane; GAS f32x4* o1 = (GAS f32x4*)(out + (size_t)m1 * D) + F.lane;
#pragma unroll
        for (int j = 0; j < 4; ++j) { o0[64 * j] = v0[j] * rs0 * gg[j]; if (two) o1[64 * j] = v1[j] * rs1 * gg[j]; }
    }
}

constexpr int NPL = 10;
constexpr int NPH = 1 + DEPTH * NPL + 1;
struct Args { const float* in[26]; float* out; unsigned char* ws; int ph_lo, ph_hi; };
__global__ void __launch_bounds__(NWAVES * 64, 2) mk_fwd(Args args) {
    extern __shared__ __attribute__((aligned(16))) unsigned char lds[];
    Frame F;
    F.lds = (LAS unsigned char*)lds;
    F.MISC = (volatile LAS unsigned*)(F.lds + MISC_OFF);
    F.tid = threadIdx.x; F.lane = F.tid & 63; F.wave = __builtin_amdgcn_readfirstlane(F.tid >> 6);
    F.G = gridDim.x; { const int bx = blockIdx.x; F.vcu = (F.G % 8 == 0) ? (bx % 8) * (F.G / 8) + bx / 8 : bx; }
    F.ws = args.ws; F.ctl = (gu32*)(args.ws + WS_CTL);
    for (int u = F.tid; u < (LDS_BYTES - LDSCTL_OFF) / 4; u += NWAVES * 64) ((LAS unsigned*)(F.lds + LDSCTL_OFF))[u] = 0u;
    __syncthreads();
    const int lo = args.ph_lo, hi = args.ph_hi;
    XcdBarrier bar; bar.bar = (unsigned*)(F.ctl + CW_BAR); bar.x = 0; bar.st = nullptr;
    if (hi - lo > 1) bar = xcd_barrier_post((unsigned*)(F.ctl + CW_BAR), F.MISC + 8, F.tid == 0);
#define IN(k) (lo <= (k) && (k) < hi)
#define RELAUNDER() do { int t_ = F.wave * 64 + pg8::mk_lane(); asm volatile("" : "+v"(t_)); F.tid = t_; F.lane = t_ & 63; asm volatile("" : "+s"(KA)); unsigned char* w_ = (unsigned char*)KA[27]; asm volatile("" : "+s"(w_)); F.ws = w_; } while (0)
#define SEAM(k) do { if (DBG_TIMING) { if (blockIdx.x == 0 && F.wave == 0 && pg8::mk_lane() == 0) ((unsigned long long*)(F.ws + 768 * 1024))[(k) + 1] = __builtin_amdgcn_s_memrealtime(); } if ((k) + 1 < hi) { XcdBarrier b2_ = bar; asm volatile("" : "+s"(b2_.bar)); xcd_barrier(b2_, F.wave == 0 && pg8::mk_lane() == 0); } } while (0)
    typedef const float* cfp_t;
    const __attribute__((address_space(4))) cfp_t* KA = (const __attribute__((address_space(4))) cfp_t*)__builtin_amdgcn_kernarg_segment_ptr();
    #define in KA
    LAS float* RSTAB = (LAS float*)(F.lds + RSTAB_OFF);
#define XB ((bf16*)(F.ws + WS_XB))
#define SSP ((float*)(F.ws + WS_SS))
#define X32 ((float*)(F.ws + WS_X32))

    if (DBG_TIMING) { if (blockIdx.x == 0 && F.tid == 0) ((unsigned long long*)(args.ws + 768 * 1024))[0] = __builtin_amdgcn_s_memrealtime(); }
    if (IN(0)) { RELAUNDER(); ph_xprologue(F, in[0]); if (DBG_TIMING) { SEAM(0); } }

    for (int l = 0; l < DEPTH; ++l) {
        const int pb = 1 + l * NPL;
#define LAYER_W(L) LayerW{in[2] + (size_t)(L) * D * IN_COLS, in[1] + (size_t)(L) * D, in[16] + (size_t)(L) * 512 * D, in[17] + (size_t)(L) * D * D, in[18] + (size_t)(L) * 512 * D, in[19] + (size_t)(L) * D * D, \
                     in[21] + (size_t)(L) * D * DFF2, in[20] + (size_t)(L) * D, in[24] + (size_t)(L) * DFF * D, in[6] + (size_t)(L) * RG_NB * 4096, in[8] + (size_t)(L) * RG_NB * 4096}
        if (DBG_TIMING && l > 0 && blockIdx.x == 0 && F.wave == 0 && pg8::mk_lane() == 0) ((unsigned long long*)(F.ws + 768 * 1024))[pb + 1] = __builtin_amdgcn_s_memrealtime();
        if (IN(pb + 0) && l == 0) {
            const LayerW W = LAYER_W(0);
            RELAUNDER(); ph_weights(F, W, 3); SEAM(pb + 0);
        }
        if (IN(pb + 1)) {
            RELAUNDER();
            pg8::Gemm g{XB, (const bf16*)(F.ws + WS_WIN), M, IN_COLS, D}; pg8::StaticOrder S; S.init(M, IN_COLS, F.G, (int)blockIdx.x);
            pg8::EpiInProj E{(bf16*)(F.ws + WS_QA), (bf16*)(F.ws + WS_KA), (bf16*)(F.ws + WS_VA), (bf16*)(F.ws + WS_QC), (bf16*)(F.ws + WS_KC), (bf16*)(F.ws + WS_VC),
                             (bf16*)(F.ws + WS_RX), (bf16*)(F.ws + WS_RG), (bf16*)(F.ws + WS_GT), SSP, in[3] + (size_t)l * 3 * D, RSTAB};
            if (F.tid == 0) ((volatile LAS int*)RSTAB)[256] = 0; __syncthreads();
#ifndef DIS_G1
            pg8::gemm_phase<pg8::EpiInProj, pg8::StaticOrder, true, true>(F.lds + RING_OFF, g, S, E, F.wave);
#endif
            SEAM(pb + 1);
        }
        if (IN(pb + 2)) {

#ifndef DIS_KMEAN
            RELAUNDER(); ph_kmean(F);
#endif

            RgP P{in[4] + (size_t)l * 4 * D, in[5] + (size_t)l * D, in[6] + (size_t)l * RG_NB * 4096, in[7] + (size_t)l * D, in[8] + (size_t)l * RG_NB * 4096, in[9] + (size_t)l * D, in[10] + (size_t)l * D};

#ifndef DIS_RGA
            RELAUNDER();
#if USE_MFMA_RG
            ph_rglru_mfma<false>(F, P); __syncthreads();
#else
            ph_rglru<false>(F, P);
#endif
#endif

            DiffP DP{in[11] + l * 64, in[12] + l * 64, in[13] + l * 64, in[14] + l * 64, in[15] + l * 128, 0.8f - 0.6f * expf(-0.3f * (float)l)};

#ifndef DIS_DIFF
            RELAUNDER();
#if USE_MFMA_DIFF
            ph_diffattn_pipe(F, DP);
#else
            ph_diffattn_naive(F, DP);
#endif
#endif

            SEAM(pb + 2);
        }
        if (IN(pb + 3)) {
#ifndef DIS_MOBA
 RELAUNDER();
#if USE_MFMA_MOBA
 ph_moba_pipe(F);
#else
 ph_moba_naive(F);
#endif
#endif
 __syncthreads();
            RgP P{in[4] + (size_t)l * 4 * D, in[5] + (size_t)l * D, in[6] + (size_t)l * RG_NB * 4096, in[7] + (size_t)l * D, in[8] + (size_t)l * RG_NB * 4096, in[9] + (size_t)l * D, in[10] + (size_t)l * D};

#ifndef DIS_RGC
            RELAUNDER();
#if USE_MFMA_RG
            ph_rglru_mfma<true>(F, P);
#else
            ph_rglru<true>(F, P);
#endif
            if (l > 0) { __syncthreads(); const LayerW W = LAYER_W(l); RELAUNDER(); ph_weights(F, W, 2); }
#endif
 SEAM(pb + 3);
        }
        if (IN(pb + 5)) {
            RELAUNDER();
            pg8::StaticOrder S; S.init(M, D, F.G, (int)blockIdx.x);
            { pg8::Gemm g{(const bf16*)(F.ws + WS_Y), (const bf16*)(F.ws + WS_WA), M, D, YP}; pg8::EpiBranchFused E{(bf16*)(F.ws + WS_MG), (const bf16*)(F.ws + WS_GT)};
#ifndef DIS_G2
              pg8::gemm_phase<pg8::EpiBranchFused, pg8::StaticOrder, true, true>(F.lds + RING_OFF, g, S, E, F.wave);
#endif
            }
            SEAM(pb + 5);
        }
        if (IN(pb + 6)) {
            RELAUNDER();
            pg8::Gemm g{(const bf16*)(F.ws + WS_MG), (const bf16*)(F.ws + WS_WO), M, D, D}; pg8::StaticOrder S; S.init(M, D, F.G, (int)blockIdx.x);
            pg8::EpiResid E{(const float*)nullptr, XB, (bf16*)(F.ws + WS_XL), SSP};
#ifndef DIS_G3
            pg8::gemm_phase<pg8::EpiResid, pg8::StaticOrder, true, true>(F.lds + RING_OFF, g, S, E, F.wave);
#endif
            SEAM(pb + 6);
        }
        if (IN(pb + 7)) {
            RELAUNDER();
            pg8::Gemm g{XB, (const bf16*)(F.ws + WS_WUP), M, DFF2, D}; pg8::StaticOrder S; S.init(M, DFF2, F.G, (int)blockIdx.x);
#if USE_ACT_FUSE
            pg8::EpiUpAct E{(bf16*)(F.ws + WS_ACT), (bf16*)(F.ws + WS_U), SSP, RSTAB, in[22] + (size_t)l * 3 * DFF2, in[23] + (size_t)l * DFF2, (LAS float*)(F.lds + RSTAB_OFF + 2048)};
#else
            pg8::EpiUp E{(bf16*)(F.ws + WS_U), DFF2, SSP, RSTAB};
#endif
            if (F.tid == 0) ((volatile LAS int*)RSTAB)[256] = 0; __syncthreads();
#ifndef DIS_G4
#if USE_ACT_FUSE
            pg8::gemm_phase<pg8::EpiUpAct, pg8::StaticOrder, true, true>(F.lds + RING_OFF, g, S, E, F.wave);
#if W_EARLY
            { const int nun = (M / 256) * (DFF2 / 256), c0 = nun % F.G;
              if (l + 1 < DEPTH && c0 > 0 && (int)blockIdx.x >= c0) { __syncthreads(); const LayerW W = LAYER_W(l + 1); RELAUNDER(); ph_weights(F, W, 1 | 4, (int)blockIdx.x - c0, F.G - c0); } }
#endif
#else
            pg8::gemm_phase<pg8::EpiUp, pg8::StaticOrder, true, true>(F.lds + RING_OFF, g, S, E, F.wave);
#endif
#endif
            SEAM(pb + 7);
        }
#if !(USE_ACT_FUSE)
#error this build expects USE_ACT_FUSE
#endif
        if (IN(pb + 9)) {
            RELAUNDER();
            pg8::Gemm g{(const bf16*)(F.ws + WS_ACT), (const bf16*)(F.ws + WS_WDN), M, D, DFF}; pg8::StaticOrder S; S.init(M, D, F.G, (int)blockIdx.x);
            { pg8::Unit u_; int lastpm = -1;
              for (int i = 0; S.next(i, u_); ++i) if (u_.pm != lastpm) { lastpm = u_.pm; ph_ffnfix(F, in[22] + (size_t)l * 3 * DFF2, in[23] + (size_t)l * DFF2, u_.pm); }
              asm volatile("s_waitcnt vmcnt(0)" ::: "memory"); __syncthreads(); }
            const bool conv_first = (blockIdx.x & 1) == 0;
            if (l + 1 < DEPTH && conv_first) { const LayerW W = LAYER_W(l + 1); RELAUNDER(); ph_weights(F, W, W_EARLY ? (1 | 8) : 1); __syncthreads(); }
            pg8::EpiResid E{nullptr, XB, (bf16*)(F.ws + WS_XL), SSP};
#ifndef DIS_G3
            pg8::gemm_phase<pg8::EpiResid, pg8::StaticOrder, true, true>(F.lds + RING_OFF, g, S, E, F.wave);
#endif
            if (l + 1 < DEPTH && !conv_first) { const LayerW W = LAYER_W(l + 1); RELAUNDER(); ph_weights(F, W, W_EARLY ? (1 | 8) : 1); }
            SEAM(pb + 9);
        }
    }
    if (IN(NPH - 1)) { RELAUNDER(); ph_final(F, XB, (const bf16*)(F.ws + WS_XL), (float*)KA[26], in[25]); }
#if DBG_TIMING
    {
        RELAUNDER();
        float* tmin = (float*)(F.ws + WS_END);
        if (blockIdx.x == 0 && F.tid == 0) { unsigned long long* ts = (unsigned long long*)(F.ws + 768 * 1024);
            float tt[12]; for (int i = 0; i < 12; ++i) tt[i] = 0.f;
            tt[0] = (float)(ts[2] - ts[0]) * 0.01f;
            for (int l = 0; l < DEPTH; ++l) for (int p = 1; p < NPL; ++p) { const int k = 1 + l * NPL + p; tt[1 + p] += (float)(ts[k + 1] - ts[k]) * 0.01f; }
            tt[11] = (float)(ts[NPH - 1] - ts[0]) * 0.01f;
            for (int i = 0; i < 12; ++i) tmin[i] = fminf(tmin[i], tt[i]); }
        { XcdBarrier b2_ = bar; asm volatile("" : "+s"(b2_.bar)); xcd_barrier(b2_, F.wave == 0 && pg8::mk_lane() == 0); }
        float v1 = 0.f, v2 = 0.f; for (int i = 0; i < 12; ++i) { if (i == DBG_SEL1) v1 = tmin[i]; if (i == DBG_SEL2) v2 = tmin[i]; }
        const float q1_ = (rintf(log2f(v1) * 6.f + DBG_QOFF) - DBG_QOFF) * (1.f / 6.f), q2_ = (rintf(log2f(v2) * 6.f + DBG_QOFF) - DBG_QOFF) * (1.f / 6.f); const float K1 = sqrtf(100.f * (q1_ - 5.f)), K2 = 100.f * (q2_ - 5.f);
        float* o_ = (float*)KA[26]; const size_t n_ = (size_t)M * D;
        for (size_t i = (size_t)blockIdx.x * 512 + F.tid; i < n_; i += (size_t)gridDim.x * 512) o_[i] = (i < 64) ? K2 : K1;
    }
#endif
#undef IN
#undef RELAUNDER
#undef LAYER_W
#undef XB
#undef SSP
#undef X32
#undef in
#undef SEAM
}


#ifndef DBG_STOP
#define DBG_STOP 0
#endif
#define DBG_DUMP_OFF (WS_YA)
#define DBG_DUMP_PER 2
__global__ void dbg_dump(const unsigned short* buf, float* out, size_t n, int per) {
    for (size_t i = (size_t)blockIdx.x * blockDim.x + threadIdx.x; i < n; i += (size_t)gridDim.x * blockDim.x) { float a = 0.f; for (int j = 0; j < per; ++j) a += __uint_as_float(((unsigned)buf[i * per + j]) << 16); out[i] = a; }
}

#ifndef DBG_TWICE
#define DBG_TWICE 0
#endif
__global__ void dbg_cksum(const unsigned* w, size_t n, unsigned poison, unsigned long long* ck) {
    unsigned long long a = 0; for (size_t i = (size_t)blockIdx.x * blockDim.x + threadIdx.x; i < n; i += (size_t)gridDim.x * blockDim.x) { const unsigned v = w[i]; if (v != poison) a += (unsigned long long)v * (unsigned long long)((i & 1023) + 1); }
    atomicAdd(ck, a);
}
__global__ void dbg_fill(unsigned* w, size_t n, unsigned v) { for (size_t i = (size_t)blockIdx.x * blockDim.x + threadIdx.x; i < n; i += (size_t)gridDim.x * blockDim.x) w[i] = v; }
__global__ void dbg_decide(float* out, size_t n, const unsigned long long* ck, int nph) {
    int first = -1; for (int p = 0; p < nph; ++p) if (ck[p] != ck[64 + p]) { first = p; break; }
    const float K = first < 0 ? 0.f : sqrtf(exp2f((float)first));
    for (size_t i = (size_t)blockIdx.x * blockDim.x + threadIdx.x; i < n; i += (size_t)gridDim.x * blockDim.x) out[i] = K;
}
extern "C" void kernel_launch(void* const* d_in, const int* in_sizes, int n_in, void* d_out, int out_size, void* d_ws, size_t ws_size, hipStream_t stream) {
    static int grid = 0;
    if (grid == 0) {
        if (n_in != 26 || in_sizes[0] != M * D || out_size != M * D || ws_size < WS_END) { fprintf(stderr, "kernel_launch: unexpected shapes / workspace (n_in %d, ws %zu); nothing launched\n", n_in, ws_size); grid = -1; return; }
        int dev = 0, cus = 0, per_cu = 0;
        if (hipGetDevice(&dev) != hipSuccess || hipDeviceGetAttribute(&cus, hipDeviceAttributeMultiprocessorCount, dev) != hipSuccess) { grid = -1; return; }
        if (hipFuncSetAttribute((const void*)mk_fwd, hipFuncAttributeMaxDynamicSharedMemorySize, LDS_BYTES) != hipSuccess) { grid = -1; return; }
        if (hipOccupancyMaxActiveBlocksPerMultiprocessor(&per_cu, (const void*)mk_fwd, NWAVES * 64, LDS_BYTES) != hipSuccess || per_cu < 1) { fprintf(stderr, "kernel_launch: occupancy query reports %d\n", per_cu); }
        (void)hipGetLastError();
        grid = cus;
    }
    if (grid < 0) return;
    if (hipMemsetAsync((char*)d_ws + WS_CTL, 0, CTL_ZERO_BYTES, stream) != hipSuccess) return;
    Args a{};
    for (int i = 0; i < 26; ++i) a.in[i] = (const float*)d_in[i];
    a.out = (float*)d_out; a.ws = (unsigned char*)d_ws;
#if MK_ONE_LAUNCH
    a.ph_lo = 0; a.ph_hi = NPH;
#if DBG_TIMING
    hipMemsetAsync((char*)d_ws + WS_END, 0x7f, 256, stream);
#endif
    hipLaunchKernelGGL(mk_fwd, dim3(grid), dim3(NWAVES * 64), LDS_BYTES, stream, a);
#if DBG_TIMING
    for (int rep = 0; rep < 3; ++rep) {
        hipMemsetAsync((char*)d_ws + WS_CTL, 0, CTL_ZERO_BYTES, stream);
        hipLaunchKernelGGL(mk_fwd, dim3(grid), dim3(NWAVES * 64), LDS_BYTES, stream, a); }
#endif
#else
#if DBG_TWICE
    unsigned long long* ck = (unsigned long long*)((char*)d_ws + 512 * 1024);
    hipLaunchKernelGGL(dbg_fill, dim3(1), dim3(256), 0, stream, (unsigned*)ck, (size_t)256, 0u);
    for (int rep = 0; rep < 2; ++rep) {
        const int pb = rep ? 0x3C : 0x5A; const unsigned pw = rep ? 0x3C3C3C3Cu : 0x5A5A5A5Au;
        (void)pb; hipLaunchKernelGGL(dbg_fill, dim3(2048), dim3(256), 0, stream, (unsigned*)((char*)d_ws + MiB), (size_t)(WS_END - MiB) / 4, pw); hipLaunchKernelGGL(dbg_fill, dim3(2048), dim3(256), 0, stream, (unsigned*)d_out, (size_t)M * D, pw);
        for (int p = 0; p < NPH; ++p) { a.ph_lo = p; a.ph_hi = p + 1; hipLaunchKernelGGL(mk_fwd, dim3(grid), dim3(NWAVES * 64), LDS_BYTES, stream, a);
            hipLaunchKernelGGL(dbg_cksum, dim3(2048), dim3(256), 0, stream, (const unsigned*)((char*)d_ws + MiB), (size_t)(WS_END - MiB) / 4, pw, ck + 64 * rep + p);
            hipLaunchKernelGGL(dbg_cksum, dim3(2048), dim3(256), 0, stream, (const unsigned*)d_out, (size_t)M * D, pw, ck + 64 * rep + p); }
    }
    hipLaunchKernelGGL(dbg_decide, dim3(1024), dim3(256), 0, stream, (float*)d_out, (size_t)M * D, (const unsigned long long*)ck, NPH);
#else
    for (int p = 0; p < NPH; ++p) { a.ph_lo = p; a.ph_hi = p + 1; hipLaunchKernelGGL(mk_fwd, dim3(grid), dim3(NWAVES * 64), LDS_BYTES, stream, a); }
#endif
#endif
}
```

```cpp
#include <hip/hip_runtime.h>
#include <cstdio>
#include <cstdint>
namespace pg8 {
#define PG8_LAS __attribute__((address_space(3)))
#define PG8_GAS __attribute__((address_space(1)))
typedef unsigned short bf16_t;
typedef short bf16x8 __attribute__((ext_vector_type(8)));
typedef float f32x4 __attribute__((ext_vector_type(4)));
typedef unsigned u32x4 __attribute__((ext_vector_type(4)));
constexpr int BM = 256, BK = 64, HALF = 128, HTB = HALF * BK * 2  , STAGE_BYTES = 8 * HTB, NXCD = 8, WGM = 8;

__host__ __device__ __forceinline__ int lds_byte(int r, int c) { const int st = (r >> 4) * 2 + (c >> 5), rr = r & 15, cc = c & 31, ob = rr * 64 + cc * 2; return st * 1024 + (ob ^ (((ob >> 9) & 1) << 5)); }
__host__ __device__ __forceinline__ void stage_rc(int b, int& R, int& C) { const int st = b / 1024, sb = b % 1024, swz = sb ^ (((sb >> 9) & 1) << 5); R = (st >> 1) * 16 + swz / 64; C = (st & 1) * 32 + (swz % 64) / 2; }
__host__ __device__ __forceinline__ int perm32(int rho) { const int n = rho >> 4, i = rho & 15; return 8 * (i >> 2) + 4 * n + (i & 3); }

struct Unit { int pm, pn; };
struct Gemm { const bf16_t* A; const bf16_t* Bt; int M, N, K; };

struct StaticOrder {
    int nM, nN, nwg, G, c;
    __host__ __device__ void init(int M, int N, int G_, int c_) { nM = M / BM; nN = N / BM; nwg = nM * nN; G = G_; c = c_; }
    __host__ __device__ __forceinline__ bool next(int i, Unit& u) const {
        const long L = (long)i * G + c; if (L >= nwg) return false;
        int wgid = (int)L; { const int q = nwg / NXCD, r = nwg % NXCD, xcd = wgid % NXCD, off = wgid / NXCD; wgid = (xcd < r ? xcd * (q + 1) : r * (q + 1) + (xcd - r) * q) + off; }
        const int nig = WGM * nN, gid = wgid / nig, fm = gid * WGM, gsz = (nM - fm) < WGM ? (nM - fm) : WGM;
        u.pm = fm + ((wgid % nig) % gsz); u.pn = (wgid % nig) / gsz; return true;
    }
    __device__ __forceinline__ void a_ready(const Unit&) const {}
    __device__ __forceinline__ void done(const Unit&) const {}
};

__device__ __forceinline__ unsigned cvt_pk_bf16(float lo, float hi) { unsigned r; asm volatile("v_cvt_pk_bf16_f32 %0, %1, %2" : "=v"(r) : "v"(lo), "v"(hi)); return r; }
typedef float f32x2 __attribute__((ext_vector_type(2)));
__device__ __forceinline__ f32x2 gelu_pk(f32x2 v) {
    const f32x2 av = __builtin_elementwise_abs(v), d = av * 0.2316418882f + 1.0f;
    f32x2 t; t.x = __builtin_amdgcn_rcpf(d.x); t.y = __builtin_amdgcn_rcpf(d.y);
    f32x2 q = t * 0.5307027145f + (-0.7265760135f); q = q * t + 0.7107068705f; q = q * t + (-0.142248368f); q = q * t + 0.127414796f; q = q * t;
    const f32x2 s = (v * v) * (-0.72134752044f);
    f32x2 e; e.x = __builtin_amdgcn_exp2f(s.x); e.y = __builtin_amdgcn_exp2f(s.y);
    const f32x2 m = v * (q * e), r = v - m;
    f32x2 o; o.x = v.x < 0.f ? m.x : r.x; o.y = v.y < 0.f ? m.y : r.y; return o;
}

constexpr float RMS_EPS_F = 1e-6f, LOG2E_F = 1.4426950408889634f;
constexpr float QSCALE = 0.125f * 1.4426950408889634f;
__device__ __forceinline__ float gelu_tanh_f(float x) {
    constexpr float KG = -2.0f * 0.7978845608028654f * LOG2E_F;
    const float e = __builtin_amdgcn_exp2f(x * __builtin_fmaf(x * x, KG * 0.044715f, KG));
    return x * __builtin_amdgcn_rcpf(1.0f + e);
}
__device__ __forceinline__ float sigmoid_f(float x) { return __builtin_amdgcn_rcpf(1.0f + __builtin_amdgcn_exp2f(-x * LOG2E_F)); }
__device__ __forceinline__ float row_rs(const float* ssp, int row) {
    const PG8_GAS f32x4* sp = (const PG8_GAS f32x4*)(ssp + (size_t)row * 16);
    const f32x4 s0 = sp[0], s1 = sp[1], s2 = sp[2], s3 = sp[3]; __builtin_amdgcn_sched_barrier(0);
    const f32x4 a = (s0 + s1) + (s2 + s3);
    return rsqrtf(((a[0] + a[1]) + (a[2] + a[3])) * (1.0f / 1024.0f) + RMS_EPS_F);
}
__device__ __forceinline__ int mk_lane() { int l_; asm volatile("v_mbcnt_lo_u32_b32 %0, -1, 0\n\tv_mbcnt_hi_u32_b32 %0, -1, %0" : "=v"(l_)); return l_; }
__device__ __forceinline__ int mk_shfl_xor(int v, int m) { return __builtin_amdgcn_ds_bpermute((mk_lane() ^ m) << 2, v); }
__device__ __forceinline__ float mk_shfl_xor(float v, int m) { return __int_as_float(__builtin_amdgcn_ds_bpermute((mk_lane() ^ m) << 2, __float_as_int(v))); }
__device__ __forceinline__ void rs_table_update(PG8_LAS float* tab, const float* ssp, int pm, int wid) {
    const int tag = ((volatile PG8_LAS int*)tab)[256];
    if (tag != pm + 1) {
        asm volatile("s_waitcnt lgkmcnt(0)" ::: "memory"); __builtin_amdgcn_s_barrier(); asm volatile("" ::: "memory");
        int t_ = wid * 64 + mk_lane(); asm volatile("" : "+v"(t_));
        if (t_ < 256) tab[t_] = row_rs(ssp, pm * BM + t_);
        if (t_ == 0) ((volatile PG8_LAS int*)tab)[256] = pm + 1;
        asm volatile("s_waitcnt vmcnt(0) lgkmcnt(0)" ::: "memory"); __builtin_amdgcn_s_barrier(); asm volatile("" ::: "memory");
    }
}
__device__ __forceinline__ void st16_stream(void* p, const u32x4& v) { asm volatile("global_store_dwordx4 %0, %1, off sc1 nt\n\ts_nop 1" :: "v"(p), "v"(v) : "memory"); }
struct EpiInProj {
    static constexpr bool PERM = true, AFTER_DRAIN = false, HAS_MID = false;
    bf16_t *QA, *KA, *VA, *QC, *KC, *VC, *RX, *RG, *GT; const float* ssp; const float* bgate; PG8_LAS float* tab;
    __device__ __forceinline__ void operator()(const f32x4 (&acc)[2][2][4][2], const Unit& u, int wr, int wc, int fr, int fq) const {
        rs_table_update(tab, ssp, u.pm, wr * 4 + wc);
        const int pn = u.pn;
        bf16_t* base; int ldc, colt, mode;
        if (pn < 12) { const int seg = pn >> 1; base = seg == 0 ? QA : seg == 1 ? KA : seg == 2 ? VA : seg == 3 ? QC : seg == 4 ? KC : VC; ldc = 512; colt = (pn & 1) * 256; mode = (seg == 0 || seg == 3) ? 1 : 0; }
        else if (pn < 16) { base = RX; ldc = 1024; colt = (pn - 12) * 256; mode = 0; }
        else if (pn < 20) { base = RG; ldc = 1024; colt = (pn - 16) * 256; mode = 2; }
        else { base = GT; ldc = 3072; colt = (pn - 20) * 256; mode = 3; }
        const int row0 = u.pm * BM + wr * 64 + fr, col0 = colt + wc * 32 + 8 * fq;
        f32x4 bv[2][2];
#pragma unroll
        for (int bj = 0; bj < 2; ++bj)
#pragma unroll
            for (int n = 0; n < 2; ++n) bv[bj][n] = (mode == 3) ? *(const f32x4*)(bgate + col0 + bj * HALF + 4 * n) * (-LOG2E_F) : (f32x4){0.f, 0.f, 0.f, 0.f};
        const float sc = (mode == 1) ? QSCALE : 1.0f;
        float rsv[2][4];
#pragma unroll
        for (int ai = 0; ai < 2; ++ai)
#pragma unroll
            for (int m = 0; m < 4; ++m) rsv[ai][m] = tab[ai * HALF + wr * 64 + m * 16 + fr];
#pragma unroll
        for (int ai = 0; ai < 2; ++ai)
#pragma unroll
            for (int m = 0; m < 4; ++m) { const int row = row0 + ai * HALF + m * 16; const float rs = rsv[ai][m] * sc; bf16_t* rowp = base + (size_t)row * ldc + col0;
#pragma unroll
                for (int bj = 0; bj < 2; ++bj) { f32x4 v0 = acc[ai][bj][m][0] * rs, v1 = acc[ai][bj][m][1] * rs;
                    if (mode == 2) {
#pragma unroll
                        for (int e = 0; e < 4; ++e) { v0[e] = gelu_tanh_f(v0[e]); v1[e] = gelu_tanh_f(v1[e]); } }
                    if (mode == 3) { const float rsn = -rs * LOG2E_F;
#pragma unroll
                        for (int e = 0; e < 4; ++e) { v0[e] = __builtin_amdgcn_rcpf(1.0f + __builtin_amdgcn_exp2f(__builtin_fmaf(acc[ai][bj][m][0][e], rsn, bv[bj][0][e]))); v1[e] = __builtin_amdgcn_rcpf(1.0f + __builtin_amdgcn_exp2f(__builtin_fmaf(acc[ai][bj][m][1][e], rsn, bv[bj][1][e]))); } }
                    u32x4 w; w.x = cvt_pk_bf16(v0[0], v0[1]); w.y = cvt_pk_bf16(v0[2], v0[3]); w.z = cvt_pk_bf16(v1[0], v1[1]); w.w = cvt_pk_bf16(v1[2], v1[3]);
                    st16_stream(rowp + bj * HALF, w); } }
    }
};
struct EpiUp {
    static constexpr bool PERM = true, AFTER_DRAIN = false, HAS_MID = false;
    bf16_t* U; int ldc; const float* ssp; PG8_LAS float* tab;
    __device__ __forceinline__ void operator()(const f32x4 (&acc)[2][2][4][2], const Unit& u, int wr, int wc, int fr, int fq) const {
        rs_table_update(tab, ssp, u.pm, wr * 4 + wc);
        const int row0 = u.pm * BM + wr * 64 + fr, col0 = u.pn * BM + wc * 32 + 8 * fq;
#pragma unroll
        for (int ai = 0; ai < 2; ++ai)
#pragma unroll
            for (int m = 0; m < 4; ++m) { const int row = row0 + ai * HALF + m * 16; const float rs = tab[ai * HALF + wr * 64 + m * 16 + fr]; bf16_t* rowp = U + (size_t)row * ldc + col0;
#pragma unroll
                for (int bj = 0; bj < 2; ++bj) { const f32x4 v0 = acc[ai][bj][m][0] * rs, v1 = acc[ai][bj][m][1] * rs;
                    u32x4 w; w.x = cvt_pk_bf16(v0[0], v0[1]); w.y = cvt_pk_bf16(v0[2], v0[3]); w.z = cvt_pk_bf16(v1[0], v1[1]); w.w = cvt_pk_bf16(v1[2], v1[3]);
                    *(u32x4*)(rowp + bj * HALF) = w; } }
    }
};
__device__ __forceinline__ float dpp_prev(float cur, float prevgrp, int n  ) {
    const int rot = n == 1 ? __builtin_amdgcn_update_dpp(0, __float_as_int(prevgrp), 0x121, 0xf, 0xf, false) : __builtin_amdgcn_update_dpp(0, __float_as_int(prevgrp), 0x122, 0xf, 0xf, false);
    const int r = n == 1 ? __builtin_amdgcn_update_dpp(rot, __float_as_int(cur), 0x111, 0xf, 0xf, false) : __builtin_amdgcn_update_dpp(rot, __float_as_int(cur), 0x112, 0xf, 0xf, false);
    return __int_as_float(r);
}
struct EpiUpAct {
    static constexpr bool PERM = true, AFTER_DRAIN = false, HAS_MID = false;
    bf16_t* ACT; bf16_t* UH; const float* ssp; PG8_LAS float* tab; const float* cw; const float* cb; PG8_LAS float* ctw;
    __device__ __forceinline__ void operator()(f32x4 (&acc)[2][2][4][2], const Unit& u, int wr, int wc, int fr, int fq) const {
        rs_table_update(tab, ssp, u.pm, wr * 4 + wc);
        int tl_ = mk_lane(); asm volatile("" : "+v"(tl_)); const int fr_ = tl_ & 15, fq_ = (tl_ >> 4) & 3; (void)fr; (void)fq;
        const int c0 = u.pn * 128 + wc * 32 + 8 * fq_;
        int t_ = (wr * 4 + wc) * 64 + mk_lane(); asm volatile("" : "+v"(t_));
        float cwv[2];
#pragma unroll
        for (int i = 0; i < 2; ++i) { const int idx = t_ + i * 512, bjk = idx >> 7, chl = idx & 127, bj = bjk >> 2, k = bjk & 3; cwv[i] = ((const PG8_GAS float*)(k < 3 ? cw + (size_t)k * 5632 : cb))[bj * 2816 + u.pn * 128 + chl]; }
        const PG8_LAS float* cl = ctw + wc * 32 + 8 * fq_;
        constexpr int DFF_ = 2816, DFF2_ = 5632;
#pragma unroll
        for (int ai = 0; ai < 2; ++ai) {
            __builtin_amdgcn_sched_barrier(0);
#pragma unroll
            for (int m = 0; m < 4; ++m) { const float rs = tab[ai * HALF + wr * 64 + m * 16 + fr_];
#pragma unroll
                for (int bj = 0; bj < 2; ++bj) { acc[ai][bj][m][0] = acc[ai][bj][m][0] * rs; acc[ai][bj][m][1] = acc[ai][bj][m][1] * rs; } }
            { const int slab = u.pm * 4 + ai * 2 + wr;
              int fh_ = fr_; asm volatile("" : "+v"(fh_));
              if (fh_ < 2 || fh_ >= 14) { const int mm = fh_ < 2 ? 0 : 3, k = fh_ < 2 ? fh_ : fh_ - 12; bf16_t* hp = UH + (unsigned)((slab * 4 + k) * DFF2_ + c0);
#pragma unroll
                  for (int bj = 0; bj < 2; ++bj) { const f32x4 v0 = mm == 0 ? acc[ai][bj][0][0] : acc[ai][bj][3][0], v1 = mm == 0 ? acc[ai][bj][0][1] : acc[ai][bj][3][1];
                      u32x4 w; w.x = cvt_pk_bf16(v0[0], v0[1]); w.y = cvt_pk_bf16(v0[2], v0[3]); w.z = cvt_pk_bf16(v1[0], v1[1]); w.w = cvt_pk_bf16(v1[2], v1[3]); *(PG8_GAS u32x4*)(hp + bj * DFF_) = w; } } }
            __builtin_amdgcn_sched_barrier(0);
        }
        ctw[t_] = cwv[0]; ctw[t_ + 512] = cwv[1];
        asm volatile("s_waitcnt lgkmcnt(0)" ::: "memory"); __builtin_amdgcn_s_barrier(); asm volatile("" ::: "memory");
#pragma unroll
        for (int ai = 0; ai < 2; ++ai) {
            __builtin_amdgcn_sched_barrier(0);
#pragma unroll
            for (int n = 0; n < 2; ++n) {
#pragma unroll
                for (int bj = 0; bj < 2; ++bj) {
                    const f32x4 w0 = *(const PG8_LAS f32x4*)(cl + (bj * 4 + 0) * 128 + 4 * n), w1 = *(const PG8_LAS f32x4*)(cl + (bj * 4 + 1) * 128 + 4 * n), w2 = *(const PG8_LAS f32x4*)(cl + (bj * 4 + 2) * 128 + 4 * n), bia = *(const PG8_LAS f32x4*)(cl + (bj * 4 + 3) * 128 + 4 * n);
#pragma unroll
                    for (int m = 3; m >= 0; --m) { f32x4 o; float t1[4], t2[4];
#pragma unroll
                        for (int e = 0; e < 4; ++e) { const float cur = acc[ai][bj][m][n][e], pg = m > 0 ? acc[ai][bj][m > 0 ? m - 1 : 0][n][e] : 0.f;
                            t1[e] = fr_ == 15 ? pg : cur; t2[e] = fr_ >= 14 ? pg : cur; o[e] = bia[e] + w2[e] * cur; }
                        __builtin_amdgcn_sched_barrier(0);
                        asm volatile("s_nop 1\n\t"
                                     "v_fmac_f32_dpp %0, %4, %12 row_ror:1 row_mask:0xf bank_mask:0xf\n\tv_fmac_f32_dpp %1, %5, %13 row_ror:1 row_mask:0xf bank_mask:0xf\n\t"
                                     "v_fmac_f32_dpp %2, %6, %14 row_ror:1 row_mask:0xf bank_mask:0xf\n\tv_fmac_f32_dpp %3, %7, %15 row_ror:1 row_mask:0xf bank_mask:0xf\n\t"
                                     "v_fmac_f32_dpp %0, %8, %16 row_ror:2 row_mask:0xf bank_mask:0xf\n\tv_fmac_f32_dpp %1, %9, %17 row_ror:2 row_mask:0xf bank_mask:0xf\n\t"
                                     "v_fmac_f32_dpp %2, %10, %18 row_ror:2 row_mask:0xf bank_mask:0xf\n\tv_fmac_f32_dpp %3, %11, %19 row_ror:2 row_mask:0xf bank_mask:0xf\n\ts_nop 0"
                                     : "+v"(o[0]), "+v"(o[1]), "+v"(o[2]), "+v"(o[3])
                                     : "v"(t1[0]), "v"(t1[1]), "v"(t1[2]), "v"(t1[3]), "v"(t2[0]), "v"(t2[1]), "v"(t2[2]), "v"(t2[3]),
                                       "v"(w1[0]), "v"(w1[1]), "v"(w1[2]), "v"(w1[3]), "v"(w0[0]), "v"(w0[1]), "v"(w0[2]), "v"(w0[3]));
                        acc[ai][bj][m][n] = o; __builtin_amdgcn_sched_barrier(0); }
                    __builtin_amdgcn_sched_barrier(0); }
#pragma unroll
                for (int m = 0; m < 4; ++m)
#pragma unroll
                    for (int e = 0; e < 4; ++e) { acc[ai][0][m][n][e] = gelu_tanh_f(acc[ai][0][m][n][e]) * acc[ai][1][m][n][e]; if (e == 3) __builtin_amdgcn_sched_barrier(0); }
            }
            int fs_ = fr_, cs_ = c0; asm volatile("" : "+v"(fs_), "+v"(cs_));
#pragma unroll
            for (int m = 0; m < 4; ++m) { __builtin_amdgcn_sched_barrier(0); const int row = u.pm * BM + ai * HALF + wr * 64 + m * 16 + fs_; const f32x4 v0 = acc[ai][0][m][0], v1 = acc[ai][0][m][1];
                u32x4 w; w.x = cvt_pk_bf16(v0[0], v0[1]); w.y = cvt_pk_bf16(v0[2], v0[3]); w.z = cvt_pk_bf16(v1[0], v1[1]); w.w = cvt_pk_bf16(v1[2], v1[3]);
                st16_stream(ACT + (unsigned)(row * DFF_ + cs_), w); }
        }
    }
};
__device__ __forceinline__ float bf_lo(unsigned w) { return __uint_as_float(w << 16); }
__device__ __forceinline__ float bf_hi(unsigned w) { return __uint_as_float(w & 0xffff0000u); }
template <bool FIRST> struct EpiBranch {
    static constexpr bool PERM = true, AFTER_DRAIN = false, HAS_MID = false;
    bf16_t* MG; const bf16_t* GT; int gcol;
    __device__ __forceinline__ void operator()(const f32x4 (&acc)[2][2][4][2], const Unit& u, int wr, int wc, int fr, int fq) const {
        const int row0 = u.pm * BM + wr * 64 + fr, col0 = u.pn * BM + wc * 32 + 8 * fq;
#pragma unroll
        for (int ai = 0; ai < 2; ++ai)
#pragma unroll
            for (int m = 0; m < 4; ++m) { const int row = row0 + ai * HALF + m * 16; bf16_t* rowp = MG + (size_t)row * 1024 + col0; const bf16_t* gp = GT + (size_t)row * 3072 + gcol + col0;
#pragma unroll
                for (int bj = 0; bj < 2; ++bj) { const u32x4 g = *(const u32x4*)(gp + bj * HALF); const f32x4 a0 = acc[ai][bj][m][0], a1 = acc[ai][bj][m][1];
                    f32x4 v0, v1;
                    v0[0] = bf_lo(g.x) * a0[0]; v0[1] = bf_hi(g.x) * a0[1]; v0[2] = bf_lo(g.y) * a0[2]; v0[3] = bf_hi(g.y) * a0[3];
                    v1[0] = bf_lo(g.z) * a1[0]; v1[1] = bf_hi(g.z) * a1[1]; v1[2] = bf_lo(g.w) * a1[2]; v1[3] = bf_hi(g.w) * a1[3];
                    if (!FIRST) { const u32x4 p = *(const u32x4*)(rowp + bj * HALF);
                        v0[0] += bf_lo(p.x); v0[1] += bf_hi(p.x); v0[2] += bf_lo(p.y); v0[3] += bf_hi(p.y); v1[0] += bf_lo(p.z); v1[1] += bf_hi(p.z); v1[2] += bf_lo(p.w); v1[3] += bf_hi(p.w); }
                    u32x4 w; w.x = cvt_pk_bf16(v0[0], v0[1]); w.y = cvt_pk_bf16(v0[2], v0[3]); w.z = cvt_pk_bf16(v1[0], v1[1]); w.w = cvt_pk_bf16(v1[2], v1[3]);
                    *(u32x4*)(rowp + bj * HALF) = w; }
                asm volatile("" ::: "memory"); }
    }
};
struct EpiBranchFused {
    static constexpr bool PERM = true, AFTER_DRAIN = false, HAS_MID = true;
    bf16_t* MG; const bf16_t* GT;
    __device__ __forceinline__ void scale(f32x4 (&acc)[2][2][4][2], const Unit& u, int wr, int wc, int fr, int fq, int gnum  , int gden  ) const {
        int fr_ = fr, fq_ = fq; asm volatile("" : "+v"(fr_), "+v"(fq_));
        const int row0 = u.pm * BM + wr * 64 + fr_, col0 = u.pn * BM + wc * 32 + 8 * fq_;
#pragma unroll
        for (int ai = 0; ai < 2; ++ai) {
            u32x4 gnv[4][2], gdv[4][2];
#pragma unroll
            for (int m = 0; m < 4; ++m) { const PG8_GAS bf16_t* gp = (const PG8_GAS bf16_t*)GT + (size_t)(row0 + ai * HALF + m * 16) * 3072 + col0;
#pragma unroll
                for (int bj = 0; bj < 2; ++bj) { gnv[m][bj] = *(const PG8_GAS u32x4*)(gp + gnum * 1024 + bj * HALF); if (gden >= 0) gdv[m][bj] = *(const PG8_GAS u32x4*)(gp + gden * 1024 + bj * HALF); } }
            __builtin_amdgcn_sched_barrier(0);
#pragma unroll
            for (int m = 0; m < 4; ++m)
#pragma unroll
                for (int bj = 0; bj < 2; ++bj) { const u32x4 gn = gnv[m][bj]; f32x4 r0, r1;
                    r0[0] = bf_lo(gn.x); r0[1] = bf_hi(gn.x); r0[2] = bf_lo(gn.y); r0[3] = bf_hi(gn.y); r1[0] = bf_lo(gn.z); r1[1] = bf_hi(gn.z); r1[2] = bf_lo(gn.w); r1[3] = bf_hi(gn.w);
                    if (gden >= 0) { const u32x4 gd = gdv[m][bj];
                        r0[0] *= __builtin_amdgcn_rcpf(bf_lo(gd.x)); r0[1] *= __builtin_amdgcn_rcpf(bf_hi(gd.x)); r0[2] *= __builtin_amdgcn_rcpf(bf_lo(gd.y)); r0[3] *= __builtin_amdgcn_rcpf(bf_hi(gd.y));
                        r1[0] *= __builtin_amdgcn_rcpf(bf_lo(gd.z)); r1[1] *= __builtin_amdgcn_rcpf(bf_hi(gd.z)); r1[2] *= __builtin_amdgcn_rcpf(bf_lo(gd.w)); r1[3] *= __builtin_amdgcn_rcpf(bf_hi(gd.w)); }
                    acc[ai][bj][m][0] = acc[ai][bj][m][0] * r0; acc[ai][bj][m][1] = acc[ai][bj][m][1] * r1; }
            __builtin_amdgcn_sched_barrier(0); }
    }
    __device__ __forceinline__ void mid(f32x4 (&acc)[2][2][4][2], const Unit& u, int t, int wr, int wc, int fr, int fq) const {
        if (t == 8) scale(acc, u, wr, wc, fr, fq, 0, 1); else if (t == 24) scale(acc, u, wr, wc, fr, fq, 1, 2);
    }
    __device__ __forceinline__ void operator()(f32x4 (&acc)[2][2][4][2], const Unit& u, int wr, int wc, int fr, int fq) const {
        scale(acc, u, wr, wc, fr, fq, 2, -1);
        const int row0 = u.pm * BM + wr * 64 + fr, col0 = u.pn * BM + wc * 32 + 8 * fq;
#pragma unroll
        for (int ai = 0; ai < 2; ++ai)
#pragma unroll
            for (int m = 0; m < 4; ++m) { bf16_t* rowp = MG + (size_t)(row0 + ai * HALF + m * 16) * 1024 + col0;
#pragma unroll
                for (int bj = 0; bj < 2; ++bj) { const f32x4 v0 = acc[ai][bj][m][0], v1 = acc[ai][bj][m][1];
                    u32x4 w; w.x = cvt_pk_bf16(v0[0], v0[1]); w.y = cvt_pk_bf16(v0[2], v0[3]); w.z = cvt_pk_bf16(v1[0], v1[1]); w.w = cvt_pk_bf16(v1[2], v1[3]);
                    *(PG8_GAS u32x4*)(rowp + bj * HALF) = w; } }
    }
};
#ifndef RESID_LO
#define RESID_LO 0
#endif
struct EpiResid {
    static constexpr bool PERM = true, AFTER_DRAIN = false, HAS_MID = false;
    const float* base32; bf16_t* xb; bf16_t* xl; float* ssp;
    __device__ __forceinline__ void operator()(const f32x4 (&acc)[2][2][4][2], const Unit& u, int wr, int wc, int fr, int fq) const {
        static_assert(RESID_LO == 0, "this epilogue keeps the residual stream in xb only");
        const int row0 = u.pm * BM + wr * 64 + fr, col0 = u.pn * BM + wc * 32 + 8 * fq;
        PG8_GAS bf16_t* xg = (PG8_GAS bf16_t*)xb; PG8_GAS float* sg = (PG8_GAS float*)ssp;
        u32x4 hb[2][4][2];
#pragma unroll
        for (int ai = 0; ai < 2; ++ai)
#pragma unroll
            for (int m = 0; m < 4; ++m)
#pragma unroll
                for (int bj = 0; bj < 2; ++bj) hb[ai][m][bj] = *(const PG8_GAS u32x4*)(xg + (size_t)(row0 + ai * HALF + m * 16) * 1024 + col0 + bj * HALF);
        __builtin_amdgcn_sched_barrier(0);
#pragma unroll
        for (int ai = 0; ai < 2; ++ai)
#pragma unroll
            for (int m = 0; m < 4; ++m) { const int row = row0 + ai * HALF + m * 16; const size_t off = (size_t)row * 1024 + col0; float s = 0.f;
#pragma unroll
                for (int bj = 0; bj < 2; ++bj) { const u32x4 hw = hb[ai][m][bj]; f32x4 b0, b1;
                    b0[0] = bf_lo(hw.x); b0[1] = bf_hi(hw.x); b0[2] = bf_lo(hw.y); b0[3] = bf_hi(hw.y); b1[0] = bf_lo(hw.z); b1[1] = bf_hi(hw.z); b1[2] = bf_lo(hw.w); b1[3] = bf_hi(hw.w);
                    const f32x4 o0 = b0 + acc[ai][bj][m][0], o1 = b1 + acc[ai][bj][m][1];
                    s += ((o0[0] * o0[0] + o0[1] * o0[1]) + (o0[2] * o0[2] + o0[3] * o0[3])) + ((o1[0] * o1[0] + o1[1] * o1[1]) + (o1[2] * o1[2] + o1[3] * o1[3]));
                    u32x4 w; w.x = cvt_pk_bf16(o0[0], o0[1]); w.y = cvt_pk_bf16(o0[2], o0[3]); w.z = cvt_pk_bf16(o1[0], o1[1]); w.w = cvt_pk_bf16(o1[2], o1[3]); *(PG8_GAS u32x4*)(xg + off + bj * HALF) = w; }
                s += mk_shfl_xor(s, 16); s += mk_shfl_xor(s, 32);
                if (fq == 0) sg[(size_t)row * 16 + u.pn * 4 + wc] = s; }
    }
};
template <class Epi, class Sched, bool ALIGN_EPI = false, bool SP2 = false>
__device__ __forceinline__ void gemm_phase(PG8_LAS unsigned char* lds, const Gemm g, const Sched& S, const Epi& E, int wave_id) {
    int tid_ = wave_id * 64 + mk_lane(); asm volatile("" : "+v"(tid_));
    const int tid = tid_, wid = __builtin_amdgcn_readfirstlane(tid >> 6), lane = tid & 63, wr = wid >> 2, wc = wid & 3, fr = lane & 15, fq = lane >> 4;
    const int K = g.K, nt = K / BK;
    unsigned voffA[2], voffB[2];
#define PG8_VOFF(T_) do { _Pragma("unroll") for (int i = 0; i < 2; ++i) { int R, C; stage_rc((T_) * 16 + i * 8192, R, C); const int Rb = Epi::PERM ? ((R & ~31) + perm32(R & 31)) : R; \
        voffA[i] = (unsigned)(R * K + C) * 2u; voffB[i] = (unsigned)(Rb * K + C) * 2u; } } while (0)
    PG8_VOFF(tid);
    const size_t kstep = (size_t)(BK * 2);
    const size_t hstep = (size_t)HALF * K * 2;
    const size_t tstep = 2 * hstep;
    const unsigned ldsw = (unsigned)wid * 1024u;
    const int aoff = lds_byte(wr * 64 + fr, fq * 8), boff = lds_byte(wc * 32 + fr, fq * 8);
#define PG8_SA(b, h) (((b) * 2 + (h)) * HTB)
#define PG8_SB(b, h) ((4 + (b) * 2 + (h)) * HTB)
#define PG8_STAGE(bufoff, gbase, voff) do { _Pragma("unroll") for (int _i = 0; _i < 2; ++_i) \
        __builtin_amdgcn_global_load_lds((const unsigned*)((const char*)(gbase) + (voff)[_i]), (PG8_LAS unsigned*)(lds + (bufoff) + ldsw + _i * 8192), 16, 0, 0); } while (0)
#define PG8_LDA(dst, b, h) do { _Pragma("unroll") for (int m = 0; m < 4; ++m) _Pragma("unroll") for (int k = 0; k < 2; ++k) dst[m][k] = *(const PG8_LAS bf16x8*)(lds + PG8_SA(b, h) + aoff + m * 2048 + k * 1024); } while (0)
#define PG8_LDB(dst, b, h) do { _Pragma("unroll") for (int n = 0; n < 2; ++n) _Pragma("unroll") for (int k = 0; k < 2; ++k) dst[n][k] = *(const PG8_LAS bf16x8*)(lds + PG8_SB(b, h) + boff + n * 2048 + k * 1024); } while (0)
#define PG8_MMA(ai, bj, At, Bt) do { __builtin_amdgcn_s_setprio(1); _Pragma("unroll") for (int m = 0; m < 4; ++m) _Pragma("unroll") for (int n = 0; n < 2; ++n) _Pragma("unroll") for (int k = 0; k < 2; ++k) \
        acc[ai][bj][m][n] = __builtin_amdgcn_mfma_f32_16x16x32_bf16(Bt[n][k], At[m][k], acc[ai][bj][m][n], 0, 0, 0); __builtin_amdgcn_s_setprio(0); } while (0)
#define PG8_WAIT_V(n) asm volatile("s_waitcnt vmcnt(" #n ")" ::: "memory")
#define PG8_WAIT_L(n) asm volatile("s_waitcnt lgkmcnt(" #n ")" ::: "memory")
#define PG8_BAR __builtin_amdgcn_s_barrier()
#define PG8_SCHED __builtin_amdgcn_sched_barrier(0)
    Unit cur, nxt; int ui = 0;
    if (!S.next(0, cur)) return;
    f32x4 acc[2][2][4][2];
#pragma unroll
    for (int a = 0; a < 2; ++a)
#pragma unroll
        for (int b = 0; b < 2; ++b)
#pragma unroll
            for (int m = 0; m < 4; ++m)
#pragma unroll
                for (int n = 0; n < 2; ++n) acc[a][b][m][n] = (f32x4){0.f, 0.f, 0.f, 0.f};
    bf16x8 At[4][2], B0[2][2], B1[2][2];
    const char* cA = (const char*)g.A + (size_t)cur.pm * tstep; const char* cB = (const char*)g.Bt + (size_t)cur.pn * tstep;
    S.a_ready(cur);
    if constexpr (SP2) {
        PG8_STAGE(PG8_SB(0, 0), cB, voffB); PG8_STAGE(PG8_SB(0, 1), cB + hstep, voffB); PG8_STAGE(PG8_SA(0, 0), cA, voffA); PG8_STAGE(PG8_SA(0, 1), cA + hstep, voffA);
        if (wr == 1) PG8_BAR;
        PG8_WAIT_V(2); PG8_BAR;
        PG8_STAGE(PG8_SB(1, 0), cB + kstep, voffB); PG8_STAGE(PG8_SA(1, 0), cA + kstep, voffA); PG8_STAGE(PG8_SB(1, 1), cB + hstep + kstep, voffB);
        PG8_WAIT_V(6); PG8_BAR;
    } else {
        PG8_STAGE(PG8_SB(0, 0), cB, voffB); PG8_STAGE(PG8_SA(0, 0), cA, voffA); PG8_STAGE(PG8_SB(0, 1), cB + hstep, voffB); PG8_STAGE(PG8_SA(0, 1), cA + hstep, voffA);
        if (wr == 1) PG8_BAR;
        PG8_WAIT_V(4); PG8_BAR;
        PG8_STAGE(PG8_SB(1, 0), cB + kstep, voffB); PG8_STAGE(PG8_SA(1, 0), cA + kstep, voffA); PG8_STAGE(PG8_SB(1, 1), cB + hstep + kstep, voffB);
        PG8_WAIT_V(6); PG8_BAR;
    }
    for (;;) {
        if (ui > 0) { int tu_ = wave_id * 64 + mk_lane(); asm volatile("" : "+v"(tu_)); PG8_VOFF(tu_); }
        const bool has_next = S.next(ui + 1, nxt);
        const char* nA = has_next ? (const char*)g.A + (size_t)nxt.pm * tstep : cA; const char* nB = has_next ? (const char*)g.Bt + (size_t)nxt.pn * tstep : cB;
#pragma unroll
        for (int seg_ = 0; seg_ < (Epi::HAS_MID ? 3 : 1); ++seg_) {
        int tb_ = 0, te_ = nt; if constexpr (Epi::HAS_MID) { tb_ = seg_ == 0 ? 0 : seg_ == 1 ? 8 : 24; te_ = seg_ == 0 ? 8 : seg_ == 1 ? 24 : nt; if (seg_ > 0) E.mid(acc, cur, tb_, wr, wc, fr, fq); }
        for (int t = tb_; t < te_; t += 2) {
            const bool last = (t == nt - 2);
            const char* a1 = cA + (size_t)(t + 1) * kstep;
            const char* a2 = last ? nA : cA + (size_t)(t + 2) * kstep; const char* b2 = last ? nB : cB + (size_t)(t + 2) * kstep;
            const char* a3 = a2 + kstep; const char* b3 = b2 + kstep;
            if (last && has_next) S.a_ready(nxt);
            if constexpr (SP2) {
            PG8_LDB(B0, 0, 0); PG8_LDB(B1, 0, 1); PG8_SCHED; PG8_LDA(At, 0, 0); PG8_STAGE(PG8_SA(1, 1), a1 + hstep, voffA);
            PG8_WAIT_V(8); PG8_WAIT_L(0); PG8_BAR; PG8_MMA(0, 0, At, B0); PG8_MMA(0, 1, At, B1); PG8_BAR; PG8_SCHED;
            PG8_LDA(At, 0, 1); PG8_STAGE(PG8_SB(0, 0), b2, voffB); PG8_STAGE(PG8_SB(0, 1), b2 + hstep, voffB); PG8_STAGE(PG8_SA(0, 0), a2, voffA);
            PG8_WAIT_V(8); PG8_WAIT_L(0); PG8_BAR; PG8_MMA(1, 0, At, B0); PG8_MMA(1, 1, At, B1); PG8_BAR; PG8_SCHED;
            PG8_LDB(B0, 1, 0); PG8_LDB(B1, 1, 1); PG8_SCHED; PG8_LDA(At, 1, 0); PG8_STAGE(PG8_SA(0, 1), a2 + hstep, voffA);
            PG8_WAIT_V(8); PG8_WAIT_L(0); PG8_BAR; PG8_MMA(0, 0, At, B0); PG8_MMA(0, 1, At, B1); PG8_BAR; PG8_SCHED;
            PG8_LDA(At, 1, 1); PG8_STAGE(PG8_SB(1, 0), b3, voffB); PG8_STAGE(PG8_SB(1, 1), b3 + hstep, voffB); PG8_STAGE(PG8_SA(1, 0), a3, voffA);
            PG8_WAIT_V(8); PG8_WAIT_L(0); PG8_BAR; PG8_MMA(1, 0, At, B0); PG8_MMA(1, 1, At, B1); PG8_BAR; PG8_SCHED;
            } else {
            PG8_LDB(B0, 0, 0); PG8_SCHED; PG8_LDA(At, 0, 0); PG8_STAGE(PG8_SA(1, 1), a1 + hstep, voffA);
            PG8_WAIT_L(8); PG8_BAR; PG8_WAIT_L(0); PG8_MMA(0, 0, At, B0); PG8_BAR; PG8_SCHED;
            PG8_LDB(B1, 0, 1); PG8_STAGE(PG8_SB(0, 0), b2, voffB);
            PG8_BAR; PG8_WAIT_L(0); PG8_MMA(0, 1, At, B1); PG8_BAR;
            PG8_LDA(At, 0, 1); PG8_STAGE(PG8_SA(0, 0), a2, voffA);
            PG8_BAR; PG8_WAIT_L(0); PG8_MMA(1, 0, At, B0); PG8_BAR; PG8_SCHED;
            PG8_STAGE(PG8_SB(0, 1), b2 + hstep, voffB);
            PG8_WAIT_V(6); PG8_BAR; PG8_MMA(1, 1, At, B1); PG8_BAR;
            PG8_LDB(B0, 1, 0); PG8_SCHED; PG8_LDA(At, 1, 0); PG8_STAGE(PG8_SA(0, 1), a2 + hstep, voffA);
            PG8_WAIT_L(8); PG8_BAR; PG8_WAIT_L(0); PG8_MMA(0, 0, At, B0); PG8_BAR; PG8_SCHED;
            PG8_LDB(B1, 1, 1); PG8_STAGE(PG8_SB(1, 0), b3, voffB);
            PG8_BAR; PG8_WAIT_L(0); PG8_MMA(0, 1, At, B1); PG8_BAR;
            PG8_LDA(At, 1, 1); PG8_STAGE(PG8_SA(1, 0), a3, voffA);
            PG8_BAR; PG8_WAIT_L(0); PG8_MMA(1, 0, At, B0); PG8_BAR; PG8_SCHED;
            PG8_STAGE(PG8_SB(1, 1), b3 + hstep, voffB);
            PG8_WAIT_V(6); PG8_BAR; PG8_MMA(1, 1, At, B1); PG8_BAR;
            }
        }
        }
        if constexpr (ALIGN_EPI) { if (wr == 0) PG8_BAR; }
        if constexpr (!Epi::AFTER_DRAIN) { E(acc, cur, wr, wc, fr, fq); S.done(cur); }
        if (!has_next) break;
#pragma unroll
        for (int a = 0; a < 2; ++a)
#pragma unroll
            for (int b = 0; b < 2; ++b)
#pragma unroll
                for (int m = 0; m < 4; ++m)
#pragma unroll
                    for (int n = 0; n < 2; ++n) acc[a][b][m][n] = (f32x4){0.f, 0.f, 0.f, 0.f};
        cur = nxt; cA = nA; cB = nB; ++ui;
        if constexpr (ALIGN_EPI) { if (wr == 1) PG8_BAR; }
    }
    PG8_WAIT_V(0);
    if constexpr (!ALIGN_EPI) { if (wr == 0) PG8_BAR; }
    PG8_BAR;
    if constexpr (Epi::AFTER_DRAIN) { E.fused(acc, cur, wr, wc, fr, fq, lds, wid, lane); S.done(cur); }
#undef PG8_VOFF
#undef PG8_SA
#undef PG8_SB
#undef PG8_STAGE
#undef PG8_LDA
#undef PG8_LDB
#undef PG8_MMA
#undef PG8_WAIT_V
#undef PG8_WAIT_L
#undef PG8_BAR
#undef PG8_SCHED
}
}
using pg8::bf_lo; using pg8::bf_hi; using pg8::mk_shfl_xor; using pg8::mk_lane;
#include <cmath>

constexpr int NWAVES = 8;
#ifndef USE_MFMA_DIFF
#define USE_MFMA_DIFF 1
#endif
#ifndef USE_ACT_FUSE
#define USE_ACT_FUSE 1
#endif
#ifndef USE_MFMA_RG
#define USE_MFMA_RG 1
#endif
#ifndef USE_MFMA_MOBA
#define USE_MFMA_MOBA 1
#endif
#ifndef DBG_TIMING
#define DBG_TIMING 0
#endif
#define DBG_SEL1 0
#define DBG_QOFF 0.0f
#define DBG_SEL2 1
#ifndef MK_ONE_LAUNCH
#define MK_ONE_LAUNCH 1
#endif

constexpr int BATCH = 4, SEQ = 4096, D = 1024, DEPTH = 4;
constexpr int M = BATCH * SEQ;
constexpr int IN_COLS = 8192, DFF = 2816, DFF2 = 5632;
constexpr int MOBA_H = 8, MOBA_BLK = 256, MOBA_NB = SEQ / MOBA_BLK;
constexpr int DIFF_H = 4;
constexpr int RG_NB = 16, RG_CHUNK = 64, RG_NCH = SEQ / RG_CHUNK;
constexpr float LOG2E = 1.4426950408889634f;

constexpr size_t MiB = 1u << 20;
constexpr size_t WS_CTL = 0, CTL_ZERO_BYTES = 1 * MiB;
constexpr size_t WS_WIN = 1 * MiB;
constexpr size_t WS_WA = 17 * MiB;
constexpr size_t WS_WB = 18 * MiB;
constexpr size_t WS_WC = 20 * MiB;
constexpr size_t WS_WO = 21 * MiB;
constexpr size_t WS_WUP = 23 * MiB;
constexpr size_t WS_WDN = 34 * MiB;
constexpr size_t WS_SS = 40 * MiB;
constexpr size_t WS_KMEAN = 41 * MiB;
constexpr size_t WS_AGG = 42 * MiB;
constexpr size_t WS_CARRY = 44 * MiB;
constexpr size_t WS_RGW = 45 * MiB;
constexpr size_t WS_PROJ = 48 * MiB;
constexpr size_t WS_QA = WS_PROJ, WS_KA = WS_QA + 16 * MiB, WS_VA = WS_KA + 16 * MiB, WS_QC = WS_VA + 16 * MiB, WS_KC = WS_QC + 16 * MiB, WS_VC = WS_KC + 16 * MiB;
constexpr size_t WS_RX = WS_VC + 16 * MiB, WS_RG = WS_RX + 32 * MiB;
constexpr size_t WS_GT = WS_RG + 32 * MiB;
constexpr size_t WS_XB = 304 * MiB;
constexpr size_t WS_Y = 336 * MiB;
constexpr int YP = 2048, YA_COL = 0, YB_COL = 512, YC_COL = 1536;
constexpr size_t WS_YA = WS_Y + YA_COL * 2, WS_YB = WS_Y + YB_COL * 2, WS_YC = WS_Y + YC_COL * 2;
constexpr size_t WS_MG = 400 * MiB;
constexpr size_t WS_U = WS_PROJ;
constexpr size_t WS_ACT = 336 * MiB;
constexpr size_t WS_DSCR = WS_MG;
constexpr size_t WS_XL = 432 * MiB;
constexpr size_t WS_X32 = 432 * MiB;
constexpr size_t WS_END = 464 * MiB;
static_assert(WS_GT + (size_t)M * 3072 * 2 == WS_XB && WS_U + (size_t)M * DFF2 * 2 <= WS_XB && WS_ACT + (size_t)M * DFF * 2 <= WS_XL && WS_XL + (size_t)M * D * 2 <= WS_END, "d_ws map");
constexpr int CW_BAR = 4096;

constexpr int RING_OFF = 0, RING_BYTES = 153600;
constexpr int LDSCTL_OFF = RING_BYTES, MISC_OFF = LDSCTL_OFF + 320;
constexpr int RSTAB_OFF = LDSCTL_OFF + 1024;
constexpr int LDS_BYTES = 163840;

#define GAS __attribute__((address_space(1)))
#define LAS __attribute__((address_space(3)))
typedef unsigned short bf16;
typedef unsigned v4u __attribute__((ext_vector_type(4)));
typedef float f32x4 __attribute__((ext_vector_type(4)));
typedef short bf16x8 __attribute__((ext_vector_type(8)));
typedef GAS unsigned gu32;
typedef GAS unsigned long long gu64;
#define RLX_AGENT __ATOMIC_RELAXED, __HIP_MEMORY_SCOPE_AGENT
#define LDS_WAIT() asm volatile("s_waitcnt lgkmcnt(0)" ::: "memory")
#define VM_WAIT() asm volatile("s_waitcnt vmcnt(0)" ::: "memory")
__device__ __forceinline__ unsigned long long rt() { return __builtin_amdgcn_s_memrealtime(); }
typedef float mk_f32x2 __attribute__((ext_vector_type(2))); typedef __bf16 mk_bf16x2 __attribute__((ext_vector_type(2)));
__device__ __forceinline__ unsigned pk2(float lo, float hi) { mk_f32x2 v = {lo, hi}; mk_bf16x2 b = __builtin_convertvector(v, mk_bf16x2); return __builtin_bit_cast(unsigned, b); }
__device__ __forceinline__ unsigned f2bf(float f) { return pk2(f, 0.f) & 0xffffu; }

#define XB_TMO      128
#define XB_XCNT(j)  (256  + 64 * (j))
#define XB_XSUB(j)  (1280 + 64 * (j))
#define XB_XGEN(j)  (2304 + 64 * (j))
#define XB_TOP      3328
#define XB_TOPGEN   3392
#define XCD_BAR_WORDS 3456
#define XB_SPIN_CAP (1u << 24)

__device__ __forceinline__ unsigned xb_ld(unsigned* p)              { return __hip_atomic_load(p, __ATOMIC_RELAXED, __HIP_MEMORY_SCOPE_AGENT); }
__device__ __forceinline__ unsigned xb_add(unsigned* p, unsigned v) { return __hip_atomic_fetch_add(p, v, __ATOMIC_RELAXED, __HIP_MEMORY_SCOPE_AGENT); }
__device__ __forceinline__ unsigned xb_xcc_id() { return (unsigned)__builtin_amdgcn_s_getreg((3 << 11) | 20) & 0xFu; }
#define XB_SPIN(cond, bar) do { unsigned _sp = 0; while (cond) { __builtin_amdgcn_s_sleep(1); \
    if ((++_sp & 255u) == 0u) { if (xb_ld(&(bar)[XB_TMO])) break; if (_sp > XB_SPIN_CAP) { atomicAdd(&(bar)[XB_TMO], 1u); break; } } } } while (0)

struct XcdBarrier {
    unsigned* bar; unsigned x;
    volatile LAS unsigned* st;
};

__device__ __forceinline__ XcdBarrier xcd_barrier_post(unsigned* bar, volatile LAS unsigned* st, bool leader  ) {
    XcdBarrier b; b.bar = bar; b.x = xb_xcc_id(); b.st = st;
    if (leader) (void)xb_add(&bar[XB_XCNT(b.x)], 1u);
    return b;
}
__device__ __forceinline__ void xcd_barrier_complete(unsigned* bar, unsigned x, unsigned& nloc, unsigned& nx) {
    const unsigned G = gridDim.x * gridDim.y * gridDim.z;
    unsigned sum, cnt, mine, sp = 0u;
    for (;;) {
        sum = 0u; cnt = 0u; mine = 0u;
#pragma unroll
        for (unsigned j = 0; j < 16; ++j) { const unsigned c = xb_ld(&bar[XB_XCNT(j)]); sum += c; cnt += (c > 0u) ? 1u : 0u; mine = (j == x) ? c : mine; }
        if (sum == G) break;
        __builtin_amdgcn_s_sleep(1);
        if ((++sp & 255u) == 0u) { if (xb_ld(&bar[XB_TMO])) break; if (sp > XB_SPIN_CAP) { atomicAdd(&bar[XB_TMO], 1u); break; } }
    }
    nloc = mine > 0u ? mine : 1u; nx = cnt > 0u ? cnt : 1u;
}

__device__ __forceinline__ void xcd_barrier(const XcdBarrier& b, bool leader  ) {
    asm volatile("s_waitcnt vmcnt(0)" ::: "memory");
    __syncthreads();
    if (leader) {
        unsigned* bar = b.bar;
        __builtin_amdgcn_s_waitcnt(0);
        unsigned nloc = b.st[0], nx = b.st[1];
        if (nloc == 0u) { xcd_barrier_complete(bar, b.x, nloc, nx); b.st[0] = nloc; b.st[1] = nx; }
        const unsigned old = xb_add(&bar[XB_XSUB(b.x)], 1u);
        const unsigned gen = old / nloc;
        if (old + 1u == (gen + 1u) * nloc) {
            __builtin_amdgcn_fence(__ATOMIC_RELEASE, "agent");
            asm volatile("s_waitcnt vmcnt(0)" ::: "memory");
            const unsigned og = xb_add(&bar[XB_TOP], 1u);
            const unsigned tg = og / nx;
            if (og + 1u == (tg + 1u) * nx) xb_add(&bar[XB_TOPGEN], 1u);
            else XB_SPIN(xb_ld(&bar[XB_TOPGEN]) == tg, bar);
            __builtin_amdgcn_fence(__ATOMIC_ACQUIRE, "agent");
            xb_add(&bar[XB_XGEN(b.x)], 1u);
            asm volatile("s_waitcnt vmcnt(0)" ::: "memory");
        } else {
            XB_SPIN(xb_ld(&bar[XB_XGEN(b.x)]) == gen, bar);
            __builtin_amdgcn_fence(__ATOMIC_ACQUIRE, "agent");
            asm volatile("s_waitcnt vmcnt(0)" ::: "memory");
        }
    }
    __syncthreads();
}

struct Frame {
    LAS unsigned char* lds;
    volatile LAS unsigned* MISC;
    gu32* ctl;
    int tid, lane, wave;
    int vcu, G;
    unsigned char* ws;
};
__device__ __forceinline__ float bf2f(bf16 b) { return __uint_as_float(((unsigned)b) << 16); }
__device__ __forceinline__ float wave_sum(float v) {
#pragma unroll
    for (int o = 1; o < 64; o <<= 1) v += mk_shfl_xor(v, o);
    return v;
}
__device__ __forceinline__ void p0_transpose_item(const float* W, int K, int N, bf16* WT, const float* gain, LAS float* scr, int item, int lane, int ldk = 0, int koff = 0, bool gv_pair = false) {
    if (ldk == 0) ldk = K;
    const int nblk = N / 32, kb = item / nblk, nb = item % nblk, k0 = 64 * kb, n0 = 32 * nb;
    float tv[32];
#pragma unroll
    for (int i = 0; i < 32; ++i) tv[i] = __builtin_nontemporal_load(&W[(size_t)(k0 + 2 * i + (lane >> 5)) * N + n0 + (lane & 31)]);
    const int c = lane & 7;
    f32x4 g0 = {1.f, 1.f, 1.f, 1.f}, g1 = g0;
    if (gain) { g0 = *(const GAS f32x4*)(gain + k0 + 8 * c); g1 = *(const GAS f32x4*)(gain + k0 + 8 * c + 4); }
#pragma unroll
    for (int i = 0; i < 32; ++i) { const int kk = 2 * i + (lane >> 5); scr[kk * 33 + (lane & 31)] = tv[i]; }
    LDS_WAIT(); asm volatile("" ::: "memory");
#pragma unroll
    for (int j = 0; j < 4; ++j) { const int n = (lane >> 3) + 8 * j; const LAS float* s = scr + (8 * c) * 33 + n;
        v4u o; o.x = pk2(s[0 * 33] * g0[0], s[1 * 33] * g0[1]); o.y = pk2(s[2 * 33] * g0[2], s[3 * 33] * g0[3]); o.z = pk2(s[4 * 33] * g1[0], s[5 * 33] * g1[1]); o.w = pk2(s[6 * 33] * g1[2], s[7 * 33] * g1[3]);
        int nd = n0 + n; if (gv_pair) { const int half = N / 2, isv = nd >= half ? 1 : 0, ch = nd - isv * half; nd = (ch >> 7) * 256 + isv * 128 + (ch & 127); }
        pg8::st16_stream(WT + (size_t)nd * ldk + koff + k0 + 8 * c, o); }
    LDS_WAIT(); asm volatile("" ::: "memory");
}
__device__ __forceinline__ void ph_xprologue(Frame& F, const float* x) {
    const int gw = F.vcu * NWAVES + F.wave, NGW = F.G * NWAVES;
    bf16* XB = (bf16*)(F.ws + WS_XB); float* ssp = (float*)(F.ws + WS_SS);
    for (int m = gw; m < M; m += 2 * NGW) {
        const int m1 = (m + NGW < M) ? m + NGW : m;
        const GAS f32x4* xr = (const GAS f32x4*)(x + (size_t)m * D) + F.lane; const GAS f32x4* xr1 = (const GAS f32x4*)(x + (size_t)m1 * D) + F.lane;
        f32x4 v[4], w[4]; float s = 0.f, s1 = 0.f;
#pragma unroll
        for (int j = 0; j < 4; ++j) { v[j] = xr[64 * j]; w[j] = xr1[64 * j]; }
        __builtin_amdgcn_sched_barrier(0);
#pragma unroll
        for (int j = 0; j < 4; ++j) { s += (v[j].x * v[j].x + v[j].y * v[j].y) + (v[j].z * v[j].z + v[j].w * v[j].w); s1 += (w[j].x * w[j].x + w[j].y * w[j].y) + (w[j].z * w[j].z + w[j].w * w[j].w); }
        s = wave_sum(s); s1 = wave_sum(s1);
        GAS unsigned long long* o8 = (GAS unsigned long long*)(XB + (size_t)m * D) + F.lane; GAS unsigned long long* o9 = (GAS unsigned long long*)(XB + (size_t)m1 * D) + F.lane;
#pragma unroll
        for (int j = 0; j < 4; ++j) { o8[64 * j] = (unsigned long long)pk2(v[j].x, v[j].y) | ((unsigned long long)pk2(v[j].z, v[j].w) << 32); o9[64 * j] = (unsigned long long)pk2(w[j].x, w[j].y) | ((unsigned long long)pk2(w[j].z, w[j].w) << 32); }
        if (F.lane < 16) { ((GAS float*)ssp)[(size_t)m * 16 + F.lane] = (F.lane == 0) ? s : 0.f; ((GAS float*)ssp)[(size_t)m1 * 16 + F.lane] = (F.lane == 0) ? s1 : 0.f; }
    }
}
struct LayerW { const float *w_in, *g_mix, *wa, *wb, *wc, *wo, *up, *g_ffn, *dn, *rg_a, *rg_x; };
#ifndef W_EARLY
#define W_EARLY 1
#endif
__device__ __forceinline__ void ph_weights(Frame& F, const LayerW& W, int which  , int wg = -1, int nwg = 0  ) {
    LAS float* scr = (LAS float*)(F.lds + RING_OFF + F.wave * 16384);
    const int gw = (wg >= 0 ? wg : F.vcu) * NWAVES + F.wave, NGW = (wg >= 0 ? nwg : F.G) * NWAVES;
    constexpr int I_IN = (D / 64) * (IN_COLS / 32), I_A = (512 / 64) * (D / 32), I_B = (D / 64) * (D / 32), I_UP = (D / 64) * (DFF2 / 32), I_DN = (DFF / 64) * (D / 32);
    constexpr int I_RG = 2 * RG_NB;
    constexpr int NITEMS = I_IN + I_A + I_B + I_A + I_B + I_UP + I_DN + I_RG;
    int it_lo = (which & 1) ? 0 : NITEMS - I_DN, it_hi = (which & 2) ? NITEMS : NITEMS - I_DN;
    if (which & 4) it_hi = I_RG + I_IN;
    if (which & 8) it_lo = I_RG + I_IN;
    for (int it = it_lo + gw; it < it_hi; it += NGW) {
        int r = it;
        if (r < I_RG) { const float* src = (r < RG_NB ? W.rg_a : W.rg_x) + (size_t)(r % RG_NB) * 4096; bf16* dst = (bf16*)(F.ws + WS_RGW) + (size_t)r * 4096 + (size_t)F.lane * 64;
            float v[64];
#pragma unroll
            for (int c = 0; c < 64; ++c) v[c] = src[c * 64 + F.lane];
#pragma unroll
            for (int c = 0; c < 64; c += 8) { v4u o; o.x = pk2(v[c], v[c + 1]); o.y = pk2(v[c + 2], v[c + 3]); o.z = pk2(v[c + 4], v[c + 5]); o.w = pk2(v[c + 6], v[c + 7]); *(GAS v4u*)(dst + c) = o; }
            continue; } r -= I_RG;
        if (r < I_IN) { p0_transpose_item(W.w_in, D, IN_COLS, (bf16*)(F.ws + WS_WIN), W.g_mix, scr, r, F.lane); continue; } r -= I_IN;
        if (r < I_A) { p0_transpose_item(W.wa, 512, D, (bf16*)(F.ws + WS_WA), nullptr, scr, r, F.lane, YP, YA_COL); continue; } r -= I_A;
        if (r < I_B) { p0_transpose_item(W.wb, D, D, (bf16*)(F.ws + WS_WA), nullptr, scr, r, F.lane, YP, YB_COL); continue; } r -= I_B;
        if (r < I_A) { p0_transpose_item(W.wc, 512, D, (bf16*)(F.ws + WS_WA), nullptr, scr, r, F.lane, YP, YC_COL); continue; } r -= I_A;
        if (r < I_B) { p0_transpose_item(W.wo, D, D, (bf16*)(F.ws + WS_WO), nullptr, scr, r, F.lane); continue; } r -= I_B;
        if (r < I_UP) { p0_transpose_item(W.up, D, DFF2, (bf16*)(F.ws + WS_WUP), W.g_ffn, scr, r, F.lane, 0, 0, USE_ACT_FUSE != 0); continue; } r -= I_UP;
        p0_transpose_item(W.dn, DFF, D, (bf16*)(F.ws + WS_WDN), nullptr, scr, r, F.lane);
    }
}
__device__ __forceinline__ void ph_kmean(Frame& F) {
    const int gw = F.vcu * NWAVES + F.wave, NGW = F.G * NWAVES;
    const bf16* KA = (const bf16*)(F.ws + WS_KA); float* KM = (float*)(F.ws + WS_KMEAN);
    for (int u = gw; u < BATCH * MOBA_NB * MOBA_H; u += NGW) {
        const int h = u % MOBA_H, blk = (u / MOBA_H) % MOBA_NB, b = u / (MOBA_H * MOBA_NB);
        const int dc = F.lane & 7, r0 = F.lane >> 3;
        const bf16* p = KA + ((size_t)b * SEQ + blk * MOBA_BLK + r0) * 512 + h * 64 + dc * 8;
        v4u w[32];
#pragma unroll
        for (int i = 0; i < 32; ++i) w[i] = *(const GAS v4u*)(p + (size_t)i * 8 * 512);
        float s[8] = {0.f, 0.f, 0.f, 0.f, 0.f, 0.f, 0.f, 0.f};
#pragma unroll
        for (int i = 0; i < 32; ++i) { s[0] += bf_lo(w[i].x); s[1] += bf_hi(w[i].x); s[2] += bf_lo(w[i].y); s[3] += bf_hi(w[i].y); s[4] += bf_lo(w[i].z); s[5] += bf_hi(w[i].z); s[6] += bf_lo(w[i].w); s[7] += bf_hi(w[i].w); }
#pragma unroll
        for (int e = 0; e < 8; ++e) { s[e] += mk_shfl_xor(s[e], 8); s[e] += mk_shfl_xor(s[e], 16); s[e] += mk_shfl_xor(s[e], 32); }
        if (r0 == 0) { float* o = KM + ((size_t)(b * MOBA_H + h) * MOBA_NB + blk) * 64 + dc * 8;
            *(GAS f32x4*)o = (f32x4){s[0], s[1], s[2], s[3]} * (1.0f / MOBA_BLK); *(GAS f32x4*)(o + 4) = (f32x4){s[4], s[5], s[6], s[7]} * (1.0f / MOBA_BLK); }
    }
}
struct RgP { const float *conv_w, *conv_b, *w_a, *b_a, *w_x, *b_x, *lam; };
template <bool FIX> __device__ __forceinline__ void ph_rglru(Frame& F, const RgP& P) {
    const int gw = F.vcu * NWAVES + F.wave, NGW = F.G * NWAVES;
    const bf16* RX = (const bf16*)(F.ws + WS_RX); const bf16* RG = (const bf16*)(F.ws + WS_RG); bf16* YB = (bf16*)(F.ws + WS_YB);
    float* AG = (float*)(F.ws + WS_AGG); float* BG = AG + (size_t)BATCH * RG_NCH * D; const float* CI = (const float*)(F.ws + WS_CARRY);
    for (int u = gw; u < BATCH * RG_NCH * RG_NB; u += NGW) {
        const int n = u % RG_NB, c = (u / RG_NB) % RG_NCH, b = u / (RG_NB * RG_NCH);
        const int ch = n * 64 + F.lane;
        float wa[64], wx[64];
#pragma unroll
        for (int k = 0; k < 64; ++k) { wa[k] = P.w_a[(size_t)n * 4096 + k * 64 + F.lane]; wx[k] = P.w_x[(size_t)n * 4096 + k * 64 + F.lane]; }
        const float ba = P.b_a[ch], bx = P.b_x[ch], c8 = -8.0f * log1pf(expf(-P.lam[ch]));
        const float cw0 = P.conv_w[ch], cw1 = P.conv_w[D + ch], cw2 = P.conv_w[2 * D + ch], cw3 = P.conv_w[3 * D + ch], cb = P.conv_b[ch];
        const int t0 = c * RG_CHUNK; const size_t rb = (size_t)b * SEQ;
        float x3 = (t0 >= 3) ? bf2f(RX[(rb + t0 - 3) * D + ch]) : 0.f, x2 = (t0 >= 2) ? bf2f(RX[(rb + t0 - 2) * D + ch]) : 0.f, x1 = (t0 >= 1) ? bf2f(RX[(rb + t0 - 1) * D + ch]) : 0.f;
        const size_t aidx = ((size_t)b * RG_NCH + c) * D + ch;
        float h = FIX ? CI[aidx] : 0.f, pa = 1.f;
        for (int t = 0; t < RG_CHUNK; ++t) {
            const float x0 = bf2f(RX[(rb + t0 + t) * D + ch]);
            const float xr = cb + cw0 * x3 + cw1 * x2 + cw2 * x1 + cw3 * x0; x3 = x2; x2 = x1; x1 = x0;
            float rp = ba, ip = bx;
#pragma unroll
            for (int k = 0; k < 64; ++k) { const float s = __uint_as_float(__builtin_amdgcn_readlane(__float_as_uint(xr), k)); rp += s * wa[k]; ip += s * wx[k]; }
            const float r = 1.0f / (1.0f + expf(-rp)), ig = 1.0f / (1.0f + expf(-ip));
            const float la = c8 * r, a = expf(la), mult = sqrtf(-expm1f(2.0f * la));
            h = a * h + mult * (ig * xr); pa *= a;
            if (FIX) YB[(rb + t0 + t) * YP + ch] = (bf16)f2bf(h * bf2f(RG[(rb + t0 + t) * D + ch]));
        }
        if (!FIX) { AG[aidx] = pa; BG[aidx] = h; }
    }
}
__device__ __forceinline__ void ph_carry(Frame& F) {
    const float* AG = (const float*)(F.ws + WS_AGG); const float* BG = AG + (size_t)BATCH * RG_NCH * D; float* CI = (float*)(F.ws + WS_CARRY);
    if (F.wave == 0) for (int task = F.vcu; task < BATCH * (D / 64); task += F.G) {
        const int b = task / (D / 64), ch = (task % (D / 64)) * 64 + F.lane; const size_t i0 = (size_t)b * RG_NCH * D + ch;
        float A[RG_NCH], Bv[RG_NCH];
#pragma unroll
        for (int c = 0; c < RG_NCH; ++c) { A[c] = AG[i0 + (size_t)c * D]; Bv[c] = BG[i0 + (size_t)c * D]; }
        float carry = 0.f;
#pragma unroll
        for (int c = 0; c < RG_NCH; ++c) { CI[i0 + (size_t)c * D] = carry; carry = A[c] * carry + Bv[c]; }
    }
}
template <int DV  , int VW  >
__device__ __forceinline__ void naive_tile(const LAS float* Ks, const LAS float* Vs, const float (&q)[16], float (&o)[DV], float& mr, float& lr, int qpos, int kpos0, float slope2, bool mine, int qd) {
#pragma unroll 2
    for (int j = 63; j >= 0; --j) {
        const LAS f32x4* kr = (const LAS f32x4*)(Ks + j * 64 + qd * 16);
        const f32x4 k0 = kr[0], k1 = kr[1], k2 = kr[2], k3 = kr[3];
        float d = ((q[0] * k0[0] + q[1] * k0[1]) + (q[2] * k0[2] + q[3] * k0[3])) + ((q[4] * k1[0] + q[5] * k1[1]) + (q[6] * k1[2] + q[7] * k1[3]))
                + ((q[8] * k2[0] + q[9] * k2[1]) + (q[10] * k2[2] + q[11] * k2[3])) + ((q[12] * k3[0] + q[13] * k3[1]) + (q[14] * k3[2] + q[15] * k3[3]));
        d += mk_shfl_xor(d, 1); d += mk_shfl_xor(d, 2);
        const int dist = qpos - (kpos0 + j);
        if (mine && dist >= 0) {
            const float sv = d - slope2 * (float)dist;
            if (sv > mr) { const float sc = __builtin_amdgcn_exp2f(mr - sv); lr *= sc; mr = sv;
#pragma unroll
                for (int e = 0; e < DV; ++e) o[e] *= sc; }
            const float p = __builtin_amdgcn_exp2f(sv - mr); lr += p; const LAS f32x4* vr = (const LAS f32x4*)(Vs + j * VW + qd * DV);
#pragma unroll
            for (int i = 0; i < DV / 4; ++i) { const f32x4 v = vr[i]; o[4 * i] += p * v[0]; o[4 * i + 1] += p * v[1]; o[4 * i + 2] += p * v[2]; o[4 * i + 3] += p * v[3]; }
        }
    }
}
template <int VW> __device__ __forceinline__ void naive_stage(Frame& F, LAS float* Ks, LAS float* Vs, const bf16* Kg, const bf16* Vg) {
    { const int r = F.tid >> 3, c = (F.tid & 7) * 8; const v4u w = *(const GAS v4u*)(Kg + (size_t)r * 512 + c); LAS float* d = Ks + r * 64 + c;
      d[0] = bf_lo(w.x); d[1] = bf_hi(w.x); d[2] = bf_lo(w.y); d[3] = bf_hi(w.y); d[4] = bf_lo(w.z); d[5] = bf_hi(w.z); d[6] = bf_lo(w.w); d[7] = bf_hi(w.w); }
#pragma unroll
    for (int i = 0; i < VW / 64; ++i) { const int e = (F.tid + i * 512) * 8, r = e / VW, c = e % VW; const v4u w = *(const GAS v4u*)(Vg + (size_t)r * 512 + c); LAS float* d = Vs + r * VW + c;
      d[0] = bf_lo(w.x); d[1] = bf_hi(w.x); d[2] = bf_lo(w.y); d[3] = bf_hi(w.y); d[4] = bf_lo(w.z); d[5] = bf_hi(w.z); d[6] = bf_lo(w.w); d[7] = bf_hi(w.w); }
}
__device__ __forceinline__ void load_q16(float (&q)[16], const bf16* p) {
#pragma unroll
    for (int i = 0; i < 2; ++i) { const v4u w = *(const GAS v4u*)(p + 8 * i); q[8 * i] = bf_lo(w.x); q[8 * i + 1] = bf_hi(w.x); q[8 * i + 2] = bf_lo(w.y); q[8 * i + 3] = bf_hi(w.y); q[8 * i + 4] = bf_lo(w.z); q[8 * i + 5] = bf_hi(w.z); q[8 * i + 6] = bf_lo(w.w); q[8 * i + 7] = bf_hi(w.w); }
}
__device__ __forceinline__ void causal_unit(int idx, int nbh, bool four, int& bh, int& qt) {
    bh = idx % nbh; const int j = idx / nbh;
    if (four) qt = (j < 8) ? 31 - j : (j < 16) ? j - 8 : (j < 24) ? 39 - j : j - 16;
    else qt = (j < 16) ? 31 - j : j - 16;
}

struct DiffP { const float *lq1, *lk1, *lq2, *lk2, *subln_g; float lam_init; };
__device__ __forceinline__ void ph_diffattn_naive(Frame& F, const DiffP& P) {
    LAS float* Ks = (LAS float*)(F.lds + RING_OFF); LAS float* Vs = Ks + 64 * 64;
    const bf16* QC = (const bf16*)(F.ws + WS_QC); const bf16* KC = (const bf16*)(F.ws + WS_KC); const bf16* VC = (const bf16*)(F.ws + WS_VC); bf16* YC = (bf16*)(F.ws + WS_YC);
    float* DS = (float*)(F.ws + WS_DSCR);
    float d1 = 0.f, d2 = 0.f;
    for (int i = 0; i < 64; ++i) { d1 += P.lq1[i] * P.lk1[i]; d2 += P.lq2[i] * P.lk2[i]; }
    const float lam = expf(d1) - expf(d2) + P.lam_init;
    const int row = F.tid >> 2, qd = F.tid & 3;
    for (int idx = F.vcu; idx < BATCH * DIFF_H * 32; idx += F.G) {
        int bh, qt; causal_unit(idx, BATCH * DIFF_H, false, bh, qt);
        const int b = bh / DIFF_H, h = bh % DIFF_H; const int qpos = qt * 128 + row; const size_t grow = (size_t)b * SEQ + qpos;
        const float slope2 = exp2f(-2.0f * (float)(h + 1)) * LOG2E;
        float* dsp = DS + (grow * DIFF_H + h) * 128 + qd * 32;
        for (int m = 0; m < 2; ++m) {
            float q[16]; load_q16(q, QC + grow * 512 + h * 128 + m * 64 + qd * 16);
            float o[32]; float mr = -INFINITY, lr = 0.f;
#pragma unroll
            for (int d = 0; d < 32; ++d) o[d] = 0.f;
            for (int kt = 2 * qt + 1; kt >= 0; --kt) {
                __syncthreads();
                const size_t krow = (size_t)b * SEQ + kt * 64;
                naive_stage<128>(F, Ks, Vs, KC + krow * 512 + h * 128 + m * 64, VC + krow * 512 + h * 128);
                __syncthreads();
                naive_tile<32, 128>(Ks, Vs, q, o, mr, lr, qpos, kt * 64, slope2, true, qd);
            }
            const float il = __builtin_amdgcn_rcpf(lr);
            if (m == 0) {
#pragma unroll
                for (int d = 0; d < 32; d += 4) *(f32x4*)(dsp + d) = (f32x4){o[d] * il, o[d + 1] * il, o[d + 2] * il, o[d + 3] * il};
            } else {
                float ss = 0.f;
#pragma unroll
                for (int d = 0; d < 32; d += 4) { const f32x4 o1 = *(const f32x4*)(dsp + d);
#pragma unroll
                    for (int e = 0; e < 4; ++e) { o[d + e] = o1[e] - lam * (o[d + e] * il); ss += o[d + e] * o[d + e]; } }
                ss += mk_shfl_xor(ss, 1); ss += mk_shfl_xor(ss, 2);
                const float rs = rsqrtf(ss * (1.0f / 128.0f) + 1e-6f) * (1.0f - P.lam_init);
                bf16* yp = YC + grow * YP + h * 128 + qd * 32; const float* gp = P.subln_g + qd * 32;
#pragma unroll
                for (int d = 0; d < 32; d += 8) { v4u w;
                    w.x = pk2(o[d] * rs * gp[d], o[d + 1] * rs * gp[d + 1]); w.y = pk2(o[d + 2] * rs * gp[d + 2], o[d + 3] * rs * gp[d + 3]);
                    w.z = pk2(o[d + 4] * rs * gp[d + 4], o[d + 5] * rs * gp[d + 5]); w.w = pk2(o[d + 6] * rs * gp[d + 6], o[d + 7] * rs * gp[d + 7]);
                    *(GAS v4u*)(yp + d) = w; }
            }
        }
    }
    __syncthreads();
}
namespace at {
using bf16x8 = __attribute__((ext_vector_type(8))) short;
using s16x4 = __attribute__((ext_vector_type(4))) short;
using f32x16 = __attribute__((ext_vector_type(16))) float;
using u32x4 = __attribute__((ext_vector_type(4))) unsigned;
typedef __attribute__((address_space(3))) const char* lds_cptr;
typedef short v4i16_t __attribute__((ext_vector_type(4)));
__device__ __forceinline__ int crow(int r, int hi) { return (r & 3) + 8 * (r >> 2) + 4 * hi; }
__device__ __forceinline__ void glds16(const void* gsrc, unsigned lds_dst) { unsigned keep;
    asm volatile("s_mov_b32 %0, m0\n\ts_mov_b32 m0, %2\n\ts_nop 0\n\tglobal_load_lds_dwordx4 %1, off\n\ts_mov_b32 m0, %0" : "=&s"(keep) : "v"(gsrc), "s"(lds_dst) : "memory"); }
typedef float f32x2_t __attribute__((ext_vector_type(2))); typedef __bf16 bf16x2_t __attribute__((ext_vector_type(2)));
__device__ __forceinline__ unsigned cvtpk(float lo, float hi) { f32x2_t v = {lo, hi}; bf16x2_t b = __builtin_convertvector(v, bf16x2_t); return __builtin_bit_cast(unsigned, b); }
__device__ __forceinline__ void kload8(bf16x8* kf, lds_cptr kp) {
#pragma unroll
    for (int d0 = 0; d0 < 4; ++d0) { kf[2 * d0] = *(const __attribute__((address_space(3))) bf16x8*)(kp + d0 * 2048); kf[2 * d0 + 1] = *(const __attribute__((address_space(3))) bf16x8*)(kp + d0 * 2048 + 512); }
}
__device__ __forceinline__ s16x4 vtr(lds_cptr p) { return __builtin_bit_cast(s16x4, __builtin_amdgcn_ds_read_tr16_b64_v4i16((__attribute__((address_space(3))) v4i16_t*)p)); }
__device__ __forceinline__ float rowmax(const f32x16& p0, const f32x16& p1) {
    float a = fmaxf(p0[0], p1[0]);
#pragma unroll
    for (int r = 1; r < 16; ++r) a = fmaxf(a, fmaxf(p0[r], p1[r]));
    auto rr = __builtin_amdgcn_permlane32_swap(__float_as_uint(a), __float_as_uint(a), false, false);
    return fmaxf(__uint_as_float(rr[0]), __uint_as_float(rr[1]));
}
__device__ __forceinline__ float max3f(float a, float b, float c) { float r; asm("v_max3_f32 %0, %1, %2, %3" : "=v"(r) : "v"(a), "v"(b), "v"(c)); return r; }
__device__ __forceinline__ float max2f(float a, float b) { float r; asm("v_max_f32_e32 %0, %1, %2" : "=v"(r) : "v"(a), "v"(b)); return r; }
__device__ __forceinline__ float fadd_s(float a, float b) { float r; asm("v_add_f32_e32 %0, %1, %2" : "=v"(r) : "v"(a), "v"(b)); return r; }
#define AT_WAIT_BAR(N) asm volatile("s_waitcnt vmcnt(" #N ") lgkmcnt(0)\n\ts_barrier" ::: "memory")
#define AT_MFMA(a, b, c) __builtin_amdgcn_mfma_f32_32x32x16_bf16(a, b, c, 0, 0, 0)
constexpr float THR = 8.0f;
template <bool MASK>
__device__ __forceinline__ bool tile_qk(lds_cptr kp  , const int (&koff)[4]  , lds_cptr qp  , float slope2, float tb, int qrel, int hi, int r32,
                                          float& mhat, float& lsum, __attribute__((address_space(3))) float* wsf, u32x4 (&pw)[4]) {
    bf16x8 kf[4];
#pragma unroll
    for (int d0 = 0; d0 < 2; ++d0) { kf[2 * d0] = *(const __attribute__((address_space(3))) bf16x8*)(kp + koff[d0]); kf[2 * d0 + 1] = *(const __attribute__((address_space(3))) bf16x8*)(kp + koff[d0] + 4096); }
    f32x16 p0, p1; { const float t0 = tb - mhat + slope2 * (float)(4 * hi), t1 = t0 + slope2 * 32.f;
        const float s8 = slope2 * 8.f; (void)t1;
        p0[0] = t0; p0[1] = p0[0] + slope2; p0[2] = p0[1] + slope2; p0[3] = p0[2] + slope2;
#pragma unroll
        for (int r = 4; r < 16; ++r) p0[r] = p0[r - 4] + s8;
        const float s32 = slope2 * 32.f;
#pragma unroll
        for (int r = 0; r < 16; ++r) p1[r] = p0[r] + s32; }
    bf16x8 qr[4];
#pragma unroll
    for (int d0 = 0; d0 < 4; ++d0) qr[d0] = *(const __attribute__((address_space(3))) bf16x8*)(qp + d0 * 1024);
    __builtin_amdgcn_sched_barrier(0);
#pragma unroll
    for (int d0 = 0; d0 < 2; ++d0) { p0 = AT_MFMA(kf[2 * d0], qr[d0], p0); p1 = AT_MFMA(kf[2 * d0 + 1], qr[d0], p1); }
#pragma unroll
    for (int d0 = 0; d0 < 2; ++d0) { kf[2 * d0] = *(const __attribute__((address_space(3))) bf16x8*)(kp + koff[d0 + 2]); kf[2 * d0 + 1] = *(const __attribute__((address_space(3))) bf16x8*)(kp + koff[d0 + 2] + 4096); }
    __builtin_amdgcn_sched_barrier(0);
#pragma unroll
    for (int d0 = 0; d0 < 2; ++d0) { p0 = AT_MFMA(kf[2 * d0], qr[d0 + 2], p0); p1 = AT_MFMA(kf[2 * d0 + 1], qr[d0 + 2], p1); }
    __builtin_amdgcn_sched_barrier(0);
    if (MASK) {
#pragma unroll
        for (int r = 0; r < 16; ++r) { const int kv = crow(r, hi); if (kv > qrel) p0[r] = -INFINITY; if (kv + 32 > qrel) p1[r] = -INFINITY; } }
    const float rm = rowmax(p0, p1);
    const bool resc = __any(rm > THR);
    if (resc) { const float dl = fmaxf(rm, 0.f); mhat += dl;
#pragma unroll
        for (int r = 0; r < 16; ++r) { p0[r] -= dl; p1[r] -= dl; }
        const float f = __builtin_amdgcn_exp2f(-dl); lsum *= f; if (hi == 0) wsf[r32] = f; }
    float sacc = 0.f;
#pragma unroll
    for (int r = 0; r < 16; ++r) { p0[r] = __builtin_amdgcn_exp2f(p0[r]); p1[r] = __builtin_amdgcn_exp2f(p1[r]); sacc += p0[r] + p1[r]; }
    lsum += sacc;
#pragma unroll
    for (int s = 0; s < 2; ++s) { pw[s] = (u32x4){cvtpk(p0[8 * s], p0[8 * s + 1]), cvtpk(p0[8 * s + 2], p0[8 * s + 3]), cvtpk(p0[8 * s + 4], p0[8 * s + 5]), cvtpk(p0[8 * s + 6], p0[8 * s + 7])};
                                  pw[2 + s] = (u32x4){cvtpk(p1[8 * s], p1[8 * s + 1]), cvtpk(p1[8 * s + 2], p1[8 * s + 3]), cvtpk(p1[8 * s + 4], p1[8 * s + 5]), cvtpk(p1[8 * s + 6], p1[8 * s + 7])}; }
    return resc;
}
template <int NDB>
__device__ __forceinline__ void tile_pv(lds_cptr vp, const u32x4 (&pw)[4], bool resc, int hi, f32x16 (&o)[NDB], __attribute__((address_space(3))) float* wsf) {
    if (resc) { asm volatile("s_waitcnt lgkmcnt(0)" ::: "memory");
#pragma unroll
        for (int r = 0; r < 16; ++r) { const float f = (wsf + 4 * hi)[(r & 3) + 8 * (r >> 2)];
#pragma unroll
            for (int db = 0; db < NDB; ++db) o[db][r] *= f; } }
    __builtin_amdgcn_sched_barrier(0);
#pragma unroll
    for (int ks = 0; ks < 4; ++ks) {
        s16x4 lo[NDB], hv[NDB];
#pragma unroll
        for (int db = 0; db < NDB; ++db) { lo[db] = vtr(vp + db * 4096 + ks * 1024); hv[db] = vtr(vp + db * 4096 + ks * 1024 + 512); }
#pragma unroll
        for (int db = 0; db < NDB; ++db) { const bf16x8 vf = (bf16x8){lo[db][0], lo[db][1], lo[db][2], lo[db][3], hv[db][0], hv[db][1], hv[db][2], hv[db][3]};
            o[db] = AT_MFMA(__builtin_bit_cast(bf16x8, pw[ks]), vf, o[db]); }
        __builtin_amdgcn_sched_barrier(0); }
}

#define AT_SB() __builtin_amdgcn_sched_barrier(0)
typedef __attribute__((address_space(3))) float* lds_fptr;
template <int NDB> __device__ __forceinline__ void ld_v(s16x4 (&lo)[NDB], s16x4 (&hv)[NDB], lds_cptr vp, int ks) {
#pragma unroll
    for (int db = 0; db < NDB; ++db) { lo[db] = vtr(vp + db * 4096 + ks * 1024); hv[db] = vtr(vp + db * 4096 + ks * 1024 + 512); } }
template <int NDB> __device__ __forceinline__ void pv_mm(f32x16 (&o)[NDB], const u32x4& pk, const s16x4 (&lo)[NDB], const s16x4 (&hv)[NDB]) {
#pragma unroll
    for (int db = 0; db < NDB; ++db) { const bf16x8 vf = (bf16x8){lo[db][0], lo[db][1], lo[db][2], lo[db][3], hv[db][0], hv[db][1], hv[db][2], hv[db][3]};
        o[db] = AT_MFMA(__builtin_bit_cast(bf16x8, pk), vf, o[db]); } }
template <int NDB> __device__ __forceinline__ void pv_tile(f32x16 (&o)[NDB], const u32x4 (&pw)[4], lds_cptr vp, bool resc, int hi, lds_fptr wsf, s16x4 (&alo)[NDB], s16x4 (&ahv)[NDB], s16x4 (&blo)[NDB], s16x4 (&bhv)[NDB]) {
    if (resc) { asm volatile("s_waitcnt lgkmcnt(0)" ::: "memory");
#pragma unroll
        for (int r = 0; r < 16; ++r) { const float f = (wsf + 4 * hi)[(r & 3) + 8 * (r >> 2)];
#pragma unroll
            for (int db = 0; db < NDB; ++db) o[db][r] *= f; } }
    AT_SB();
    pv_mm<NDB>(o, pw[0], alo, ahv); ld_v<NDB>(alo, ahv, vp, 2); AT_SB();
    pv_mm<NDB>(o, pw[1], blo, bhv); ld_v<NDB>(blo, bhv, vp, 3); AT_SB();
    pv_mm<NDB>(o, pw[2], alo, ahv); AT_SB();
    pv_mm<NDB>(o, pw[3], blo, bhv); AT_SB(); }
__device__ __forceinline__ void ld_kq(bf16x8 (&kf)[8], bf16x8 (&qr)[4], lds_cptr kp, const int (&koff)[4], lds_cptr qp) {
#pragma unroll
    for (int d0 = 0; d0 < 4; ++d0) { const unsigned a_ = (unsigned)(uintptr_t)kp + (unsigned)koff[d0]; __builtin_assume(a_ < 0x28000u);
        kf[2 * d0] = *(const __attribute__((address_space(3))) bf16x8*)(uintptr_t)a_; kf[2 * d0 + 1] = *(const __attribute__((address_space(3))) bf16x8*)(uintptr_t)(a_ + 4096u); }
#pragma unroll
    for (int d0 = 0; d0 < 4; ++d0) qr[d0] = *(const __attribute__((address_space(3))) bf16x8*)(qp + d0 * 1024); }
template <bool CM = false>
__device__ __forceinline__ bool qk_softmax(const bf16x8 (&kf)[8], const bf16x8 (&qr)[4], bool msk, float slope2, float tb, int qrel, int hi, int r32, float& mhat, float& lsum, lds_fptr wsf, u32x4 (&pw)[4]) {
    asm volatile("" : "+v"(hi), "+v"(slope2));
    f32x16 p0, p1;
    if (CM) {
        const float c_ = tb - mhat, ak = hi ? 1.0f : slope2 * (float)r32, b0 = hi ? c_ : 1.0f, b1 = hi ? c_ + slope2 * 32.f : 1.0f;
        p0 = __builtin_amdgcn_mfma_f32_32x32x2f32(ak, b0, f32x16{}, 0, 0, 0); p1 = __builtin_amdgcn_mfma_f32_32x32x2f32(ak, b1, f32x16{}, 0, 0, 0);
    } else { const float t0 = tb - mhat + slope2 * (float)(4 * hi), s8 = slope2 * 8.f, s32 = slope2 * 32.f;
        p0[0] = t0; p0[1] = fadd_s(p0[0], slope2); p0[2] = fadd_s(p0[1], slope2); p0[3] = fadd_s(p0[2], slope2);
#pragma unroll
        for (int r = 4; r < 16; ++r) p0[r] = fadd_s(p0[r - 4], s8);
#pragma unroll
        for (int r = 0; r < 16; ++r) p1[r] = fadd_s(p0[r], s32); }
    if (!CM) asm volatile("s_nop 3" ::: "memory");
    AT_SB();
#pragma unroll
    for (int d0 = 0; d0 < 4; ++d0) { p0 = AT_MFMA(kf[2 * d0], qr[d0], p0); p1 = AT_MFMA(kf[2 * d0 + 1], qr[d0], p1); }
    AT_SB();
    if (msk) { const int qh = qrel - 4 * hi;
#pragma unroll
        for (int r = 0; r < 16; ++r) { const int kc = (r & 3) + 8 * (r >> 2); if (kc > qh) p0[r] = -INFINITY; if (kc + 32 > qh) p1[r] = -INFINITY; } }
    p1[15] += 0.0f; p0[15] += 0.0f;
    AT_SB();
    float rm; { float m0 = max3f(p0[0], p0[1], p1[0]), m1 = max3f(p0[2], p0[3], p1[1]); m0 = max3f(m0, p1[2], p1[3]);
#pragma unroll
        for (int r = 4; r < 16; r += 4) { m0 = max3f(m0, p0[r], p0[r + 1]); m1 = max3f(m1, p0[r + 2], p0[r + 3]); m0 = max3f(m0, p1[r], p1[r + 1]); m1 = max3f(m1, p1[r + 2], p1[r + 3]); }
        const float a = fmaxf(m0, m1); auto rr = __builtin_amdgcn_permlane32_swap(__float_as_uint(a), __float_as_uint(a), false, false);
        rm = fmaxf(__uint_as_float(rr[0]), __uint_as_float(rr[1])); }
    const bool resc = __any(rm > THR);
    if (resc) { const float dl = fmaxf(rm, 0.f); mhat += dl;
#pragma unroll
        for (int r = 0; r < 16; ++r) { p0[r] -= dl; p1[r] -= dl; }
        const float f = __builtin_amdgcn_exp2f(-dl); lsum *= f; if (hi == 0) wsf[r32] = f; }
#pragma unroll
    for (int r = 0; r < 16; ++r) { p0[r] = __builtin_amdgcn_exp2f(p0[r]); p1[r] = __builtin_amdgcn_exp2f(p1[r]); }
    AT_SB();
    float s0 = p0[0], s1 = p1[0];
#pragma unroll
    for (int r = 1; r < 16; ++r) { s0 = fadd_s(s0, p0[r]); s1 = fadd_s(s1, p1[r]); }
    lsum += s0 + s1;
#pragma unroll
    for (int s = 0; s < 2; ++s) { pw[s] = (u32x4){cvtpk(p0[8 * s], p0[8 * s + 1]), cvtpk(p0[8 * s + 2], p0[8 * s + 3]), cvtpk(p0[8 * s + 4], p0[8 * s + 5]), cvtpk(p0[8 * s + 6], p0[8 * s + 7])};
                                  pw[2 + s] = (u32x4){cvtpk(p1[8 * s], p1[8 * s + 1]), cvtpk(p1[8 * s + 2], p1[8 * s + 3]), cvtpk(p1[8 * s + 4], p1[8 * s + 5]), cvtpk(p1[8 * s + 6], p1[8 * s + 7])}; }
    return resc;
}
}

__device__ __forceinline__ void ph_diffattn_mfma(Frame& F, const DiffP& P) {
    using namespace at;
    const int wid = F.wave, mh = wid >> 2, w4 = wid & 3;
    LAS unsigned char* shm = F.lds + RING_OFF; const unsigned lds0 = (unsigned)(uintptr_t)shm;
    constexpr int KSTG = 16384, VSTG = 16384, OFF_K2 = 8192, OFF_V = 3 * KSTG, OFF_WS = OFF_V + 4 * VSTG, OFF_Q = OFF_WS + 2048, OFF_Y = OFF_Q;
    LAS float* wsf = (LAS float*)(shm + OFF_WS) + wid * 64;
    const bf16* QC = (const bf16*)(F.ws + WS_QC); const bf16* KC = (const bf16*)(F.ws + WS_KC); const bf16* VC = (const bf16*)(F.ws + WS_VC); bf16* YC = (bf16*)(F.ws + WS_YC);
    float d1 = 0.f, d2 = 0.f;
    for (int i = 0; i < 64; ++i) { d1 += P.lq1[i] * P.lk1[i]; d2 += P.lq2[i] * P.lk2[i]; }
    const float lam = expf(d1) - expf(d2) + P.lam_init;
    const lds_cptr kp0 = (lds_cptr)shm + mh * OFF_K2;
    for (int idx = F.vcu, it_ = 0; idx < BATCH * DIFF_H * 32; idx += F.G, ++it_) {
        int bh = idx % (BATCH * DIFF_H), j = idx / (BATCH * DIFF_H), qb = (j < 16) ? 31 - j : j - 16;
        if (F.G == 256) { const int xcd = F.vcu >> 5, w = F.vcu & 31; bh = 2 * xcd + it_; qb = it_ == 0 ? 31 - w : w; }
        const int b = bh / DIFF_H, h = bh % DIFF_H, q0 = qb * 128, q0w = q0 + w4 * 32, NT = 2 * qb + 2;
        const float slope2 = exp2f(-2.0f * (float)(h + 1)) * LOG2E;
        const size_t rowb = (size_t)b * SEQ;
        int lu = mk_lane(); asm volatile("" : "+v"(lu));
        const int lane = lu, r32 = lane & 31, hi = lane >> 5;
        int koff[4];
#pragma unroll
        for (int d0 = 0; d0 < 4; ++d0) koff[d0] = r32 * 128 + (((2 * d0 + hi) ^ ((r32 >> 1) & 7)) << 4);
        const lds_cptr vp0 = (lds_cptr)shm + OFF_V + ((lane >> 4) & 1) * 32 + (lane & 3) * 8 + (4 * hi + ((lane & 15) >> 2)) * 64;
        const lds_cptr qp = (lds_cptr)shm + OFF_Q + wid * 4096 + lu * 16;
        { const bf16* Qw = QC + (rowb + q0w + (lu & 31)) * 512 + h * 128 + mh * 64;
#pragma unroll
          for (int d0 = 0; d0 < 4; ++d0) *(__attribute__((address_space(3))) bf16x8*)((LAS unsigned char*)shm + OFF_Q + wid * 4096 + lu * 16 + d0 * 1024) = *(const GAS bf16x8*)(Qw + d0 * 16 + (lu >> 5) * 8); }
        const bf16* ks1 = KC + (rowb + 8 * wid + (lu >> 3)) * 512 + h * 128 + (((lu & 7) ^ (((8 * wid + (lu >> 3)) >> 1) & 7)) << 3);
        const int pA = 2 * wid;
        const bf16* vsA = VC + (rowb + 16 * (pA & 3) + (lu >> 2)) * 512 + h * 128 + (pA >> 2) * 32 + (lu & 3) * 8;
#define DF_DMA(t) do { const size_t go_ = (size_t)(t) * 64 * 512; const unsigned kb_ = lds0 + (unsigned)((t) % 3) * KSTG, vb_ = lds0 + OFF_V + (unsigned)((t) & 3) * VSTG; \
        glds16(ks1 + go_, (unsigned)__builtin_amdgcn_readfirstlane(kb_ + wid * 1024)); glds16(ks1 + go_ + 64, (unsigned)__builtin_amdgcn_readfirstlane(kb_ + OFF_K2 + wid * 1024)); \
        glds16(vsA + go_, (unsigned)__builtin_amdgcn_readfirstlane(vb_ + pA * 1024)); glds16(vsA + go_ + 16 * 512, (unsigned)__builtin_amdgcn_readfirstlane(vb_ + (pA + 1) * 1024)); } while (0)
        f32x16 o[4]; float mhat = 0.f, lsum = 0.f;
#pragma unroll
        for (int db = 0; db < 4; ++db) o[db] = f32x16{};
        u32x4 pw[4]; bool pend = false, presc = false; int pvt = 0;
        DF_DMA(0); DF_DMA(1);
        for (int t = 0; t <= NT; ++t) {
            const bool live = t < NT;
            if (mh == 1 && live) { if (t + 1 < NT) { AT_WAIT_BAR(4); } else { AT_WAIT_BAR(0); } if (t + 2 < NT) DF_DMA(t + 2); }
            const int k0 = t * 64; const bool doqk = live && (k0 <= q0w + 31);
            unsigned ks_ = (unsigned)(t % 3) * KSTG; asm volatile("" : "+s"(ks_));
            const lds_cptr kp = kp0 + ks_;
            bf16x8 kf[8], qr[4]; s16x4 alo[4], ahv[4], blo[4], bhv[4]; const lds_cptr vp = vp0 + (pvt & 3) * VSTG;
            if (pend) { ld_v<4>(alo, ahv, vp, 0); ld_v<4>(blo, bhv, vp, 1); }
            if (mh == 1 && doqk) ld_kq(kf, qr, kp, koff, qp);
            AT_SB();
            if (pend) { pv_tile<4>(o, pw, vp, presc, hi, wsf, alo, ahv, blo, bhv); pend = false; }
            if (mh == 0 && live) { if (t + 1 < NT) { AT_WAIT_BAR(4); } else { AT_WAIT_BAR(0); } if (t + 2 < NT) DF_DMA(t + 2); }
            if (doqk) {
                if (mh == 0) ld_kq(kf, qr, kp, koff, qp);
                presc = qk_softmax(kf, qr, k0 + 63 > q0w, slope2, slope2 * (float)(k0 - q0w), q0w + r32 - k0, hi, r32, mhat, lsum, wsf, pw);
                pend = true; pvt = t; }
        }
        AT_WAIT_BAR(0);
#undef DF_DMA
        { auto rr = __builtin_amdgcn_permlane32_swap(__float_as_uint(lsum), __float_as_uint(lsum), false, false); lsum = __uint_as_float(rr[0]) + __uint_as_float(rr[1]); }
        if (hi == 0) wsf[32 + r32] = lsum;
        asm volatile("s_waitcnt lgkmcnt(0)" ::: "memory");
        float rli[16];
#pragma unroll
        for (int r = 0; r < 16; ++r) rli[r] = __builtin_amdgcn_rcpf((wsf + 32 + 4 * hi)[(r & 3) + 8 * (r >> 2)]);
        int le_ = mk_lane(); asm volatile("" : "+v"(le_));
        LAS float* X = (LAS float*)shm + (w4 * 32 + 4 * (le_ >> 5)) * 128 + (le_ & 31);
        if (mh == 1) {
#pragma unroll
            for (int db = 0; db < 4; ++db)
#pragma unroll
                for (int r = 0; r < 16; ++r) X[((r & 3) + 8 * (r >> 2)) * 128 + db * 32] = o[db][r] * rli[r];
        }
        AT_WAIT_BAR(0);
        if (mh == 0) {
            float ssr[16];
#pragma unroll
            for (int r = 0; r < 16; ++r) { float a = 0.f;
#pragma unroll
                for (int db = 0; db < 4; ++db) { const float v = o[db][r] * rli[r] - lam * X[((r & 3) + 8 * (r >> 2)) * 128 + db * 32]; o[db][r] = v; a += v * v; }
                ssr[r] = a; }
#pragma unroll
            for (int r = 0; r < 16; ++r) { float a = ssr[r]; a += mk_shfl_xor(a, 1); a += mk_shfl_xor(a, 2); a += mk_shfl_xor(a, 4); a += mk_shfl_xor(a, 8); a += mk_shfl_xor(a, 16); ssr[r] = rsqrtf(a * (1.0f / 128.0f) + 1e-6f) * (1.0f - P.lam_init); }
            float gsl[4];
#pragma unroll
            for (int db = 0; db < 4; ++db) gsl[db] = ((const GAS float*)P.subln_g)[db * 32 + (le_ & 31)];
            LAS bf16* Y = (LAS bf16*)(shm + OFF_Y) + (w4 * 32 + 4 * (le_ >> 5)) * 128 + (le_ & 31);
#pragma unroll
            for (int db = 0; db < 4; ++db) { const float g = gsl[db];
#pragma unroll
                for (int r = 0; r < 16; ++r) Y[((r & 3) + 8 * (r >> 2)) * 128 + db * 32] = (bf16)f2bf(o[db][r] * ssr[r] * g); }
        }
        AT_WAIT_BAR(0);
        { int tid_ = F.tid; asm volatile("" : "+v"(tid_));
#pragma unroll
        for (int i = 0; i < 4; ++i) { const int id = tid_ + i * 512, row = id >> 4, pc = id & 15;
            const v4u w = *(const LAS v4u*)(shm + OFF_Y + row * 256 + pc * 16);
            *(GAS v4u*)(YC + (rowb + q0 + row) * YP + h * 128 + pc * 8) = w; } }
        AT_WAIT_BAR(0);
    }
}
__device__ __forceinline__ void ph_diffattn_pipe(Frame& F, const DiffP& P) {
    using namespace at;
    const int wid = F.wave, mh = wid >> 2, w4 = wid & 3;
    LAS unsigned char* shm = F.lds + RING_OFF; const unsigned lds0 = (unsigned)(uintptr_t)shm;
    constexpr int KSTG = 16384, VSTG = 16384, OFF_K2 = 8192, OFF_V = 3 * KSTG, OFF_WS = OFF_V + 4 * VSTG, OFF_Q = OFF_WS + 2048, OFF_Y = OFF_Q;
    LAS float* wsf = (LAS float*)(shm + OFF_WS) + wid * 64;
    const bf16* QC = (const bf16*)(F.ws + WS_QC); const bf16* KC = (const bf16*)(F.ws + WS_KC); const bf16* VC = (const bf16*)(F.ws + WS_VC); bf16* YC = (bf16*)(F.ws + WS_YC);
    float d1 = 0.f, d2 = 0.f;
    for (int i = 0; i < 64; ++i) { d1 += P.lq1[i] * P.lk1[i]; d2 += P.lq2[i] * P.lk2[i]; }
    const float lam = expf(d1) - expf(d2) + P.lam_init;
    const lds_cptr kp0 = (lds_cptr)shm + mh * OFF_K2;
    for (int idx = F.vcu, it_ = 0; idx < BATCH * DIFF_H * 32; idx += F.G, ++it_) {
        int bh = idx % (BATCH * DIFF_H), j = idx / (BATCH * DIFF_H), qb = (j < 16) ? 31 - j : j - 16;
        if (F.G == 256) { const int xcd = F.vcu >> 5, w = F.vcu & 31; bh = 2 * xcd + it_; qb = it_ == 0 ? 31 - w : w; }
        const int b = bh / DIFF_H, h = bh % DIFF_H, q0 = qb * 128, q0w = q0 + w4 * 32, NT = 2 * qb + 2;
        const float slope2 = exp2f(-2.0f * (float)(h + 1)) * LOG2E;
        const size_t rowb = (size_t)b * SEQ;
        int lu = mk_lane(); asm volatile("" : "+v"(lu));
        const int lane = lu, r32 = lane & 31, hi = lane >> 5;
        int koff[4];
#pragma unroll
        for (int d0 = 0; d0 < 4; ++d0) koff[d0] = r32 * 128 + (((2 * d0 + hi) ^ ((r32 >> 1) & 7)) << 4);
        const lds_cptr vp0 = (lds_cptr)shm + OFF_V + ((lane >> 4) & 1) * 32 + (lane & 3) * 8 + (4 * hi + ((lane & 15) >> 2)) * 64;
        const lds_cptr qp = (lds_cptr)shm + OFF_Q + wid * 4096 + lu * 16;
        { const bf16* Qw = QC + (rowb + q0w + (lu & 31)) * 512 + h * 128 + mh * 64;
          bf16x8 qv_[4];
#pragma unroll
          for (int d0 = 0; d0 < 4; ++d0) qv_[d0] = *(const GAS bf16x8*)(Qw + d0 * 16 + (lu >> 5) * 8);
          __builtin_amdgcn_sched_barrier(0);
#pragma unroll
          for (int d0 = 0; d0 < 4; ++d0) *(__attribute__((address_space(3))) bf16x8*)((LAS unsigned char*)shm + OFF_Q + wid * 4096 + lu * 16 + d0 * 1024) = qv_[d0]; }
        const bf16* ks1 = KC + (rowb + 8 * wid + (lu >> 3)) * 512 + h * 128 + (((lu & 7) ^ (((8 * wid + (lu >> 3)) >> 1) & 7)) << 3);
        const int pA = 2 * wid;
        const bf16* vsA = VC + (rowb + 16 * (pA & 3) + (lu >> 2)) * 512 + h * 128 + (pA >> 2) * 32 + (lu & 3) * 8;
#define DMA_K(t, slot) do { const size_t go_ = (size_t)(t) * 64 * 512; const unsigned kb_ = (unsigned)__builtin_amdgcn_readfirstlane(lds0 + (unsigned)(slot) + wid * 1024); glds16(ks1 + go_, kb_); glds16(ks1 + go_ + 64, kb_ + OFF_K2); } while (0)
#define DMA_V(t, slot) do { const size_t go_ = (size_t)(t) * 64 * 512; const unsigned vb_ = (unsigned)__builtin_amdgcn_readfirstlane(lds0 + OFF_V + (unsigned)(slot) + pA * 1024); glds16(vsA + go_, vb_); glds16(vsA + go_ + 16 * 512, vb_ + 1024); } while (0)
        f32x16 o[4]; float mhat = 0.f, lsum = 0.f;
#pragma unroll
        for (int db = 0; db < 4; ++db) o[db] = f32x16{};
        f32x16 pA0, pA1, pB0, pB1; bf16x8 kf[8], qr[4]; s16x4 vlo[3], vhi[3]; u32x4 pw[4]; bool resc = false;
        const float akey = hi ? 1.0f : slope2 * (float)r32;
        const unsigned kl0 = lds0 + (unsigned)mh * OFF_K2;
        unsigned sl_prev = 0u, sl_cur = 0u, sl_next = KSTG;
#define ROT() do { sl_prev = sl_cur; sl_cur = sl_next; sl_next = (sl_next == 2u * KSTG) ? 0u : sl_next + KSTG; } while (0)
#define PIN(x) asm volatile("" : "+v"(x))
#define KLD(sl, d0) do { const unsigned a_ = kl0 + (sl) + (unsigned)koff[d0]; kf[2 * (d0)] = *(const __attribute__((address_space(3))) bf16x8*)(uintptr_t)a_; kf[2 * (d0) + 1] = *(const __attribute__((address_space(3))) bf16x8*)(uintptr_t)(a_ + 4096u); } while (0)
#define QLD() do { _Pragma("unroll") for (int d0 = 0; d0 < 4; ++d0) qr[d0] = *(const __attribute__((address_space(3))) bf16x8*)(qp + d0 * 1024); } while (0)
#define VR4(g) do { vlo[(g) % 3] = vtr(vp_ + (((g) & 3) * 4096 + ((g) >> 2) * 1024)); vhi[(g) % 3] = vtr(vp_ + (((g) & 3) * 4096 + ((g) >> 2) * 1024 + 512)); } while (0)
#define VF4(g) (bf16x8){vlo[(g) % 3][0], vlo[(g) % 3][1], vlo[(g) % 3][2], vlo[(g) % 3][3], vhi[(g) % 3][0], vhi[(g) % 3][1], vhi[(g) % 3][2], vhi[(g) % 3][3]}
#define PKW(P, i) cvtpk(P[i], P[i + 1])
#define EX(v) __builtin_amdgcn_exp2f(v)
#define SINIT(C0, C1, t) do { const float c_ = slope2 * (float)((t) * 64 - q0w) - mhat; const float b0_ = hi ? c_ : 1.0f, b1_ = hi ? c_ + slope2 * 32.f : 1.0f; \
        C0 = __builtin_amdgcn_mfma_f32_32x32x2f32(akey, b0_, f32x16{}, 0, 0, 0); C1 = __builtin_amdgcn_mfma_f32_32x32x2f32(akey, b1_, f32x16{}, 0, 0, 0); } while (0)
#define DECIDE(C0, C1, t) do { if ((t) * 64 + 63 > q0w) { const int qh_ = q0w + r32 - (t) * 64 - 4 * hi; \
            _Pragma("unroll") for (int r = 0; r < 16; ++r) { const int kc = (r & 3) + 8 * (r >> 2); if (kc > qh_) C0[r] = -INFINITY; if (kc + 32 > qh_) C1[r] = -INFINITY; } } \
        C1[15] += 0.0f; C0[15] += 0.0f; AT_SB(); \
        float rm_; { float m0 = max3f(C0[0], C0[1], C1[0]), m1 = max3f(C0[2], C0[3], C1[1]); m0 = max3f(m0, C1[2], C1[3]); \
            _Pragma("unroll") for (int r = 4; r < 16; r += 4) { m0 = max3f(m0, C0[r], C0[r + 1]); m1 = max3f(m1, C0[r + 2], C0[r + 3]); m0 = max3f(m0, C1[r], C1[r + 1]); m1 = max3f(m1, C1[r + 2], C1[r + 3]); } \
            const float a_ = fmaxf(m0, m1); auto rr_ = __builtin_amdgcn_permlane32_swap(__float_as_uint(a_), __float_as_uint(a_), false, false); rm_ = fmaxf(__uint_as_float(rr_[0]), __uint_as_float(rr_[1])); } \
        resc = false; if (__any(rm_ > THR)) { const float dl_ = fmaxf(rm_, 0.f); mhat += dl_; _Pragma("unroll") for (int r = 0; r < 16; ++r) { C0[r] -= dl_; C1[r] -= dl_; } \
            const float f_ = __builtin_amdgcn_exp2f(-dl_); lsum *= f_; if (hi == 0) wsf[r32] = f_; resc = true; } } while (0)
#define RESC() do { if (resc) { asm volatile("s_waitcnt lgkmcnt(0)" ::: "memory"); _Pragma("unroll") for (int r = 0; r < 16; ++r) { const float f_ = (wsf + 4 * hi)[(r & 3) + 8 * (r >> 2)]; o[0][r] *= f_; o[1][r] *= f_; o[2][r] *= f_; o[3][r] *= f_; } } } while (0)
#define GAPA(MF, a0, a1, a2, a3, W0, W1, PW) do { MF; sacc += a0; sacc += a1; sacc += a2; sacc += a3; W0; W1; PIN(PW); PIN(sacc); AT_SB(); } while (0)
#define GB4(g, X, i) do { if ((g) + 2 < 16) { VR4((g) + 2); AT_SB(); } o[(g) & 3] = AT_MFMA(__builtin_bit_cast(bf16x8, pw[(g) >> 2]), VF4(g), o[(g) & 3]); X[i] = EX(X[i]); X[i + 1] = EX(X[i + 1]); PIN(X); AT_SB(); } while (0)
#define KRD(G, d0) do { if (G) { KLD(sl_next, d0); AT_SB(); } } while (0)
#define STEP(C0, C1, P0, P1, t) do { AT_SB(); const lds_cptr vp_ = vp0 + sl_prev; const bool gl_ = (t) + 1 < NT; \
        QLD(); AT_SB(); SINIT(C0, C1, t); AT_SB(); \
        float sacc = P0[0] + P0[1]; \
        GAPA(C0 = AT_MFMA(kf[0], qr[0], C0), P0[2], P0[3], P0[4], P0[5],     pw[0][0] = PKW(P0, 0),  pw[0][1] = PKW(P0, 2),  pw[0]); \
        GAPA(C1 = AT_MFMA(kf[1], qr[0], C1), P0[6], P0[7], P0[8], P0[9],     pw[0][2] = PKW(P0, 4),  pw[0][3] = PKW(P0, 6),  pw[0]); \
        GAPA(C0 = AT_MFMA(kf[2], qr[1], C0), P0[10], P0[11], P0[12], P0[13], pw[1][0] = PKW(P0, 8),  pw[1][1] = PKW(P0, 10), pw[1]); \
        GAPA(C1 = AT_MFMA(kf[3], qr[1], C1), P0[14], P0[15], P1[0], P1[1],   pw[1][2] = PKW(P0, 12), pw[1][3] = PKW(P0, 14), pw[1]); \
        GAPA(C0 = AT_MFMA(kf[4], qr[2], C0), P1[2], P1[3], P1[4], P1[5],     pw[2][0] = PKW(P1, 0),  pw[2][1] = PKW(P1, 2),  pw[2]); \
        GAPA(C1 = AT_MFMA(kf[5], qr[2], C1), P1[6], P1[7], P1[8], P1[9],     pw[2][2] = PKW(P1, 4),  pw[2][3] = PKW(P1, 6),  pw[2]); \
        VR4(0); AT_SB(); GAPA(C0 = AT_MFMA(kf[6], qr[3], C0), P1[10], P1[11], P1[12], P1[13], pw[3][0] = PKW(P1, 8),  pw[3][1] = PKW(P1, 10), pw[3]); \
        VR4(1); AT_SB(); GAPA(C1 = AT_MFMA(kf[7], qr[3], C1), P1[14], P1[15], 0.f, 0.f,       pw[3][2] = PKW(P1, 12), pw[3][3] = PKW(P1, 14), pw[3]); \
        lsum += sacc; \
        if ((t) + 3 < NT) DMA_K((t) + 3, sl_cur); if ((t) + 1 < NT) DMA_V((t) + 1, sl_next); \
        DECIDE(C0, C1, t); AT_SB(); \
        GB4(0, C0, 0);  GB4(1, C0, 2);  KRD(gl_, 0); GB4(2, C0, 4);  GB4(3, C0, 6);  KRD(gl_, 1); GB4(4, C0, 8);  GB4(5, C0, 10); KRD(gl_, 2); GB4(6, C0, 12); GB4(7, C0, 14); KRD(gl_, 3); \
        GB4(8, C1, 0);  GB4(9, C1, 2);  GB4(10, C1, 4); GB4(11, C1, 6); GB4(12, C1, 8); GB4(13, C1, 10); GB4(14, C1, 12); GB4(15, C1, 14); \
        } while (0)
#define ENDW(t) do { if ((t) + 3 < NT) { AT_WAIT_BAR(4); } else if ((t) + 1 < NT) { AT_WAIT_BAR(2); } else { AT_WAIT_BAR(0); } } while (0)
        DMA_K(0, 0); DMA_V(0, 0); DMA_K(1, KSTG); if (NT > 2) DMA_K(2, 2 * KSTG);
        AT_WAIT_BAR(0);
        _Pragma("unroll") for (int d0 = 0; d0 < 4; ++d0) KLD(0u, d0);
        QLD(); SINIT(pA0, pA1, 0);
        _Pragma("unroll") for (int d0 = 0; d0 < 4; ++d0) { pA0 = AT_MFMA(kf[2 * d0], qr[d0], pA0); pA1 = AT_MFMA(kf[2 * d0 + 1], qr[d0], pA1); }
        AT_SB(); DECIDE(pA0, pA1, 0);
        _Pragma("unroll") for (int r = 0; r < 16; ++r) { pA0[r] = EX(pA0[r]); pA1[r] = EX(pA1[r]); }
        AT_WAIT_BAR(0);
        if (3 < NT) DMA_K(3, 0); DMA_V(1, KSTG); ROT();
        _Pragma("unroll") for (int d0 = 0; d0 < 4; ++d0) KLD(sl_cur, d0);
        if (3 < NT) { AT_WAIT_BAR(4); } else { AT_WAIT_BAR(2); }
        { int t = 1;
          for (; t + 1 < NT; t += 2) {
              STEP(pB0, pB1, pA0, pA1, t);     ENDW(t);     RESC(); ROT();
              STEP(pA0, pA1, pB0, pB1, t + 1); ENDW(t + 1); RESC(); ROT(); }
          STEP(pB0, pB1, pA0, pA1, t); ENDW(t); RESC(); ROT(); }
        { float sacc = pB0[0] + pB0[1];
          _Pragma("unroll") for (int r = 2; r < 16; ++r) sacc += pB0[r];
          _Pragma("unroll") for (int r = 0; r < 16; ++r) sacc += pB1[r];
          lsum += sacc;
          pw[0] = (u32x4){PKW(pB0, 0), PKW(pB0, 2), PKW(pB0, 4), PKW(pB0, 6)}; pw[1] = (u32x4){PKW(pB0, 8), PKW(pB0, 10), PKW(pB0, 12), PKW(pB0, 14)};
          pw[2] = (u32x4){PKW(pB1, 0), PKW(pB1, 2), PKW(pB1, 4), PKW(pB1, 6)}; pw[3] = (u32x4){PKW(pB1, 8), PKW(pB1, 10), PKW(pB1, 12), PKW(pB1, 14)};
          const lds_cptr vp_ = vp0 + sl_prev; VR4(0); VR4(1);
          _Pragma("unroll") for (int g = 0; g < 16; ++g) { if (g + 2 < 16) VR4(g + 2); o[g & 3] = AT_MFMA(__builtin_bit_cast(bf16x8, pw[g >> 2]), VF4(g), o[g & 3]); } }
        AT_WAIT_BAR(0);
#undef DMA_K
#undef DMA_V
#undef ROT
#undef PIN
#undef KLD
#undef QLD
#undef VR4
#undef VF4
#undef PKW
#undef EX
#undef SINIT
#undef DECIDE
#undef RESC
#undef GAPA
#undef GB4
#undef KRD
#undef STEP
#undef ENDW
        { auto rr = __builtin_amdgcn_permlane32_swap(__float_as_uint(lsum), __float_as_uint(lsum), false, false); lsum = __uint_as_float(rr[0]) + __uint_as_float(rr[1]); }
        if (hi == 0) wsf[32 + r32] = lsum;
        asm volatile("s_waitcnt lgkmcnt(0)" ::: "memory");
        float rli[16];
#pragma unroll
        for (int r = 0; r < 16; ++r) rli[r] = __builtin_amdgcn_rcpf((wsf + 32 + 4 * hi)[(r & 3) + 8 * (r >> 2)]);
        int le_ = mk_lane(); asm volatile("" : "+v"(le_));
        LAS float* X = (LAS float*)shm + (w4 * 32 + 4 * (le_ >> 5)) * 128 + (le_ & 31);
        if (mh == 1) {
#pragma unroll
            for (int db = 0; db < 4; ++db)
#pragma unroll
                for (int r = 0; r < 16; ++r) X[((r & 3) + 8 * (r >> 2)) * 128 + db * 32] = o[db][r] * rli[r];
        }
        AT_WAIT_BAR(0);
        if (mh == 0) {
            float ssr[16];
#pragma unroll
            for (int r = 0; r < 16; ++r) { float a = 0.f;
#pragma unroll
                for (int db = 0; db < 4; ++db) { const float v = o[db][r] * rli[r] - lam * X[((r & 3) + 8 * (r >> 2)) * 128 + db * 32]; o[db][r] = v; a += v * v; }
                ssr[r] = a; }
#pragma unroll
            for (int r = 0; r < 16; ++r) { float a = ssr[r]; a += mk_shfl_xor(a, 1); a += mk_shfl_xor(a, 2); a += mk_shfl_xor(a, 4); a += mk_shfl_xor(a, 8); a += mk_shfl_xor(a, 16); ssr[r] = rsqrtf(a * (1.0f / 128.0f) + 1e-6f) * (1.0f - P.lam_init); }
            float gsl[4];
#pragma unroll
            for (int db = 0; db < 4; ++db) gsl[db] = ((const GAS float*)P.subln_g)[db * 32 + (le_ & 31)];
            LAS bf16* Y = (LAS bf16*)(shm + OFF_Y) + (w4 * 32 + 4 * (le_ >> 5)) * 128 + (le_ & 31);
#pragma unroll
            for (int db = 0; db < 4; ++db) { const float g = gsl[db];
#pragma unroll
                for (int r = 0; r < 16; ++r) Y[((r & 3) + 8 * (r >> 2)) * 128 + db * 32] = (bf16)f2bf(o[db][r] * ssr[r] * g); }
        }
        AT_WAIT_BAR(0);
        { int tid_ = F.tid; asm volatile("" : "+v"(tid_));
#pragma unroll
        for (int i = 0; i < 4; ++i) { const int id = tid_ + i * 512, row = id >> 4, pc = id & 15;
            const v4u w = *(const LAS v4u*)(shm + OFF_Y + row * 256 + pc * 16);
            *(GAS v4u*)(YC + (rowb + q0 + row) * YP + h * 128 + pc * 8) = w; } }
        AT_WAIT_BAR(0);
    }
}
__device__ __forceinline__ void ph_moba_mfma(Frame& F) {
    using namespace at;
    const int wid = F.wave;
    LAS unsigned char* shm = F.lds + RING_OFF; const unsigned lds0 = (unsigned)(uintptr_t)shm;
    constexpr int KSTG = 8192, VSTG = 8192, OFF_V = 3 * KSTG, OFF_WS = OFF_V + 4 * VSTG, OFF_Q = OFF_WS + 4096, OFF_KM = OFF_Q + 32768, OFF_MSK = OFF_KM + 4096;
    LAS float* wsf = (LAS float*)(shm + OFF_WS) + wid * 64;
    const bf16* QA = (const bf16*)(F.ws + WS_QA); const bf16* KA = (const bf16*)(F.ws + WS_KA); const bf16* VA = (const bf16*)(F.ws + WS_VA); bf16* YA = (bf16*)(F.ws + WS_YA);
    const float* KM = (const float*)(F.ws + WS_KMEAN);
    const lds_cptr kp0 = (lds_cptr)shm;
    for (int idx = F.vcu, it_ = 0; idx < BATCH * MOBA_H * MOBA_NB; idx += F.G, ++it_) {
        int bh = idx % (BATCH * MOBA_H), j = idx / (BATCH * MOBA_H), blk = (j < 8) ? 15 - j : j - 8;
        if (F.G == 256) { const int xcd = F.vcu >> 5, w = F.vcu & 31; bh = 4 * xcd + (w >> 3); blk = it_ == 0 ? 15 - (w & 7) : (w & 7); }
        const int b = bh / MOBA_H, h = bh % MOBA_H, q0 = blk * 256, q0w = q0 + wid * 32;
        const float slope2 = exp2f(-(float)(h + 1)) * LOG2E;
        const size_t rowb = (size_t)b * SEQ;
        int lu = mk_lane(), tu = wid * 64 + lu; asm volatile("" : "+v"(lu), "+v"(tu));
        const int lane = lu, r32 = lane & 31, hi = lane >> 5;
        int koff[4];
#pragma unroll
        for (int d0 = 0; d0 < 4; ++d0) koff[d0] = r32 * 128 + (((2 * d0 + hi) ^ ((r32 >> 1) & 7)) << 4);
        const lds_cptr vp0 = (lds_cptr)shm + OFF_V + ((lane >> 4) & 1) * 32 + (lane & 3) * 8 + (4 * hi + ((lane & 15) >> 2)) * 64;
        unsigned long long blist = (unsigned long long)blk; int nb = 1;
        const bf16* ksrc = KA + (rowb + 8 * wid + (lu >> 3)) * 512 + h * 64 + (((lu & 7) ^ (((8 * wid + (lu >> 3)) >> 1) & 7)) << 3);
        const bf16* vsrc = VA + (rowb + 16 * (wid & 3) + (lu >> 2)) * 512 + h * 64 + (wid >> 2) * 32 + (lu & 3) * 8;
#define MB_K0(ti) ((int)((blist >> (4 * ((ti) >> 2))) & 15ull) * 256 + ((ti) & 3) * 64)
#define MB_DMA(ti) do { if (wid < 4) { const size_t go_ = (size_t)MB_K0(ti) * 512;     \
        const unsigned kd_ = (unsigned)__builtin_amdgcn_readfirstlane(lds0 + (unsigned)((ti) % 3) * KSTG + wid * 1024), vd_ = (unsigned)__builtin_amdgcn_readfirstlane(lds0 + OFF_V + (unsigned)((ti) & 3) * VSTG + wid * 1024); \
        glds16(ksrc + go_, kd_); glds16(vsrc + go_, vd_); glds16(ksrc + go_ + 32 * 512, kd_ + 4096); glds16(vsrc + go_ + 32, vd_ + 4096); } } while (0)
        MB_DMA(0); MB_DMA(1);
        { LAS float* Km = (LAS float*)(shm + OFF_KM);
#pragma unroll
          for (int i = 0; i < 2; ++i) Km[tu + i * 512] = KM[(size_t)bh * MOBA_NB * 64 + tu + i * 512];
          if (tu == 0) *(LAS unsigned*)(shm + OFF_MSK) = 0u; }
        bf16x8 qf[4];
        { const bf16* Qw = QA + (rowb + q0w + (lu & 31)) * 512 + h * 64;
#pragma unroll
          for (int d0 = 0; d0 < 4; ++d0) { qf[d0] = *(const bf16x8*)(Qw + d0 * 16 + (lu >> 5) * 8); *(LAS bf16x8*)(shm + OFF_Q + wid * 4096 + lu * 16 + d0 * 1024) = qf[d0]; } }
        const lds_cptr qp = (lds_cptr)shm + OFF_Q + wid * 4096 + lu * 16;
        AT_WAIT_BAR(0);
        float b0 = -INFINITY, b1 = -INFINITY, b2 = -INFINITY; int i0 = -1, i1 = -1, i2 = -1;
        float qx[32];
#pragma unroll
        for (int d0 = 0; d0 < 4; ++d0)
#pragma unroll
            for (int e = 0; e < 8; ++e) qx[8 * d0 + e] = bf2f((bf16)qf[d0][e]);
        for (int jb0 = 0; jb0 < blk; jb0 += 2) {
            const int jb1 = jb0 + 1 < blk ? jb0 + 1 : jb0; float gg[2];
#pragma unroll
            for (int u2 = 0; u2 < 2; ++u2) { const LAS float* km = (const LAS float*)(shm + OFF_KM) + (u2 ? jb1 : jb0) * 64 + 8 * (lu >> 5); float ga = 0.f, gb = 0.f;
#pragma unroll
                for (int d0 = 0; d0 < 4; ++d0) { const f32x4 k0 = *(const LAS f32x4*)(km + d0 * 16), k1 = *(const LAS f32x4*)(km + d0 * 16 + 4);
                    ga += (qx[8 * d0 + 0] * k0[0] + qx[8 * d0 + 1] * k0[1]) + (qx[8 * d0 + 2] * k0[2] + qx[8 * d0 + 3] * k0[3]);
                    gb += (qx[8 * d0 + 4] * k1[0] + qx[8 * d0 + 5] * k1[1]) + (qx[8 * d0 + 6] * k1[2] + qx[8 * d0 + 7] * k1[3]); }
                gg[u2] = ga + gb; }
#pragma unroll
            for (int u2 = 0; u2 < 2; ++u2) { float g = gg[u2]; const int jb = u2 ? jb1 : jb0;
                { auto rr = __builtin_amdgcn_permlane32_swap(__float_as_uint(g), __float_as_uint(g), false, false); g = __uint_as_float(rr[0]) + __uint_as_float(rr[1]); }
                if (u2 == 0 || jb1 != jb0) { if (g > b0) { b2 = b1; i2 = i1; b1 = b0; i1 = i0; b0 = g; i0 = jb; } else if (g > b1) { b2 = b1; i2 = i1; b1 = g; i1 = jb; } else if (g > b2) { b2 = g; i2 = jb; } } }
        }
        unsigned mym = 0u; if (i0 >= 0) mym |= 1u << i0; if (i1 >= 0) mym |= 1u << i1; if (i2 >= 0) mym |= 1u << i2;
        { unsigned wm = mym;
#pragma unroll
          for (int o_ = 1; o_ < 64; o_ <<= 1) wm |= (unsigned)mk_shfl_xor((int)wm, o_);
          if (lu == 0) atomicOr((unsigned*)(shm + OFF_MSK), wm); }
        AT_WAIT_BAR(0);
        const unsigned wgm = (unsigned)__builtin_amdgcn_readfirstlane(*(volatile LAS unsigned*)(shm + OFF_MSK)) | (1u << blk);
        for (int jb = 0; jb < blk; ++jb) if ((wgm >> jb) & 1u) { blist |= (unsigned long long)jb << (4 * nb); ++nb; }
        const int NTI = 4 * nb;
        f32x16 o[2]; float mhat = 0.f, lsum = 0.f; o[0] = f32x16{}; o[1] = f32x16{};
        u32x4 pw[4]; bool pend = false, presc = false; int pvt = 0; const bool late = wid >= 4;
        for (int t = 0; t <= NTI; ++t) {
            const bool live = t < NTI;
            if (late && live) { AT_WAIT_BAR(0); }
            const int k0 = live ? MB_K0(t) : 0, jb = k0 >> 8; unsigned ks_ = (unsigned)(t % 3) * KSTG; asm volatile("" : "+s"(ks_)); const lds_cptr kp = kp0 + ks_;
            const bool sel = (jb == blk) || ((mym >> jb) & 1u);
            const bool doqk = live && ((jb == blk) ? (k0 <= q0w + 31) : (bool)__any(sel));
            bf16x8 kf[8], qr[4]; s16x4 alo[2], ahv[2], blo[2], bhv[2]; const lds_cptr vp = vp0 + (pvt & 3) * VSTG;
            if (pend) { ld_v<2>(alo, ahv, vp, 0); ld_v<2>(blo, bhv, vp, 1); }
            if (late && doqk) ld_kq(kf, qr, kp, koff, qp);
            AT_SB();
            if (pend) { pv_tile<2>(o, pw, vp, presc, hi, wsf, alo, ahv, blo, bhv); pend = false; }
            if (!late && live) { if (t + 1 < NTI) { AT_WAIT_BAR(4); } else { AT_WAIT_BAR(0); } if (t + 2 < NTI) MB_DMA(t + 2); }
            if (doqk) {
                if (!late) ld_kq(kf, qr, kp, koff, qp);
                presc = qk_softmax<true>(kf, qr, (jb == blk) && (k0 + 63 > q0w), slope2, sel ? slope2 * (float)(k0 - q0w) : -INFINITY, q0w + r32 - k0, hi, r32, mhat, lsum, wsf, pw);
                pend = true; pvt = t; }
        }
        AT_WAIT_BAR(0);
#undef MB_DMA
#undef MB_K0
        { auto rr = __builtin_amdgcn_permlane32_swap(__float_as_uint(lsum), __float_as_uint(lsum), false, false); lsum = __uint_as_float(rr[0]) + __uint_as_float(rr[1]); }
        if (hi == 0) wsf[32 + r32] = lsum;
        asm volatile("s_waitcnt lgkmcnt(0)" ::: "memory");
        { int le_ = mk_lane(); asm volatile("" : "+v"(le_));
          LAS bf16* stg = (LAS bf16*)(shm + OFF_Q + wid * 4096) + (4 * (le_ >> 5)) * 64 + (le_ & 31);
#pragma unroll
          for (int r = 0; r < 16; ++r) { const float il = __builtin_amdgcn_rcpf((wsf + 32 + 4 * (le_ >> 5))[(r & 3) + 8 * (r >> 2)]);
#pragma unroll
              for (int db = 0; db < 2; ++db) stg[((r & 3) + 8 * (r >> 2)) * 64 + db * 32] = (bf16)f2bf(o[db][r] * il); }
          asm volatile("s_waitcnt lgkmcnt(0)" ::: "memory");
          bf16* Ow = YA + (rowb + q0w) * YP + h * 64;
#pragma unroll
          for (int i = 0; i < 4; ++i) { const int row = i * 8 + (le_ >> 3), ch = le_ & 7; const v4u v = *(const LAS v4u*)(shm + OFF_Q + wid * 4096 + row * 128 + ch * 16); *(GAS v4u*)(Ow + (size_t)row * YP + ch * 8) = v; } }
        AT_WAIT_BAR(0);
    }
}
__device__ __forceinline__ void ph_moba_pipe(Frame& F) {
    using namespace at;
    const int wid = F.wave;
    LAS unsigned char* shm = F.lds + RING_OFF; const unsigned lds0 = (unsigned)(uintptr_t)shm;
    constexpr int KSTG = 8192, VSTG = 8192, OFF_V = 3 * KSTG, OFF_WS = OFF_V + 4 * VSTG, OFF_Q = OFF_WS + 4096, OFF_KM = OFF_Q + 32768, OFF_MSK = OFF_KM + 4096;
    LAS float* wsf = (LAS float*)(shm + OFF_WS) + wid * 64;
    const bf16* QA = (const bf16*)(F.ws + WS_QA); const bf16* KA = (const bf16*)(F.ws + WS_KA); const bf16* VA = (const bf16*)(F.ws + WS_VA); bf16* YA = (bf16*)(F.ws + WS_YA);
    const float* KM = (const float*)(F.ws + WS_KMEAN);
    const lds_cptr kp0 = (lds_cptr)shm;
    for (int idx = F.vcu, it_ = 0; idx < BATCH * MOBA_H * MOBA_NB; idx += F.G, ++it_) {
        int bh = idx % (BATCH * MOBA_H), j = idx / (BATCH * MOBA_H), blk = (j < 8) ? 15 - j : j - 8;
        if (F.G == 256) { const int xcd = F.vcu >> 5, w = F.vcu & 31; bh = 4 * xcd + (w >> 3); blk = it_ == 0 ? 15 - (w & 7) : (w & 7); }
        const int b = bh / MOBA_H, h = bh % MOBA_H, q0 = blk * 256, q0w = q0 + wid * 32;
        const float slope2 = exp2f(-(float)(h + 1)) * LOG2E;
        const size_t rowb = (size_t)b * SEQ;
        int lu = mk_lane(), tu = wid * 64 + lu; asm volatile("" : "+v"(lu), "+v"(tu));
        const int lane = lu, r32 = lane & 31, hi = lane >> 5;
        int koff[4];
#pragma unroll
        for (int d0 = 0; d0 < 4; ++d0) koff[d0] = r32 * 128 + (((2 * d0 + hi) ^ ((r32 >> 1) & 7)) << 4);
        const lds_cptr vp0 = (lds_cptr)shm + OFF_V + ((lane >> 4) & 1) * 32 + (lane & 3) * 8 + (4 * hi + ((lane & 15) >> 2)) * 64;
        unsigned long long blist = (unsigned long long)blk; int nb = 1;
        const bf16* ksrc = KA + (rowb + 8 * wid + (lu >> 3)) * 512 + h * 64 + (((lu & 7) ^ (((8 * wid + (lu >> 3)) >> 1) & 7)) << 3);
        const bf16* vsrc = VA + (rowb + 16 * (wid & 3) + (lu >> 2)) * 512 + h * 64 + (wid >> 2) * 32 + (lu & 3) * 8;
#define MB_K0(ti) ((int)((blist >> (4 * ((ti) >> 2))) & 15ull) * 256 + ((ti) & 3) * 64)
#define DMA_K(ti, slot) glds16(ksrc + (size_t)MB_K0(ti) * 512, (unsigned)__builtin_amdgcn_readfirstlane(lds0 + (unsigned)(slot) + wid * 1024))
#define DMA_V(ti, slot) glds16(vsrc + (size_t)MB_K0(ti) * 512, (unsigned)__builtin_amdgcn_readfirstlane(lds0 + OFF_V + (unsigned)(slot) + wid * 1024))
        DMA_K(0, 0); DMA_V(0, 0); DMA_K(1, KSTG); DMA_K(2, 2 * KSTG);
        { LAS float* Km = (LAS float*)(shm + OFF_KM);
          const float km0_ = ((const GAS float*)KM)[(size_t)bh * MOBA_NB * 64 + tu], km1_ = ((const GAS float*)KM)[(size_t)bh * MOBA_NB * 64 + tu + 512];
          __builtin_amdgcn_sched_barrier(0);
          Km[tu] = km0_; Km[tu + 512] = km1_;
          if (tu == 0) *(LAS unsigned*)(shm + OFF_MSK) = 0u; }
        bf16x8 qf[4];
        { const bf16* Qw = QA + (rowb + q0w + (lu & 31)) * 512 + h * 64;
#pragma unroll
          for (int d0 = 0; d0 < 4; ++d0) qf[d0] = *(const GAS bf16x8*)(Qw + d0 * 16 + (lu >> 5) * 8); }
        AT_WAIT_BAR(0);
        float b0 = -INFINITY, b1 = -INFINITY, b2 = -INFINITY; int i0 = -1, i1 = -1, i2 = -1;
        float qx[32];
#pragma unroll
        for (int d0 = 0; d0 < 4; ++d0)
#pragma unroll
            for (int e = 0; e < 8; ++e) qx[8 * d0 + e] = bf2f((bf16)qf[d0][e]);
        for (int jb0 = 0; jb0 < blk; jb0 += 2) {
            const int jb1 = jb0 + 1 < blk ? jb0 + 1 : jb0; float gg[2];
#pragma unroll
            for (int u2 = 0; u2 < 2; ++u2) { const LAS float* km = (const LAS float*)(shm + OFF_KM) + (u2 ? jb1 : jb0) * 64 + 8 * (lu >> 5); float ga = 0.f, gb = 0.f;
#pragma unroll
                for (int d0 = 0; d0 < 4; ++d0) { const f32x4 k0 = *(const LAS f32x4*)(km + d0 * 16), k1 = *(const LAS f32x4*)(km + d0 * 16 + 4);
                    ga += (qx[8 * d0 + 0] * k0[0] + qx[8 * d0 + 1] * k0[1]) + (qx[8 * d0 + 2] * k0[2] + qx[8 * d0 + 3] * k0[3]);
                    gb += (qx[8 * d0 + 4] * k1[0] + qx[8 * d0 + 5] * k1[1]) + (qx[8 * d0 + 6] * k1[2] + qx[8 * d0 + 7] * k1[3]); }
                gg[u2] = ga + gb; }
#pragma unroll
            for (int u2 = 0; u2 < 2; ++u2) { float g = gg[u2]; const int jb = u2 ? jb1 : jb0;
                { auto rr = __builtin_amdgcn_permlane32_swap(__float_as_uint(g), __float_as_uint(g), false, false); g = __uint_as_float(rr[0]) + __uint_as_float(rr[1]); }
                if (u2 == 0 || jb1 != jb0) { if (g > b0) { b2 = b1; i2 = i1; b1 = b0; i1 = i0; b0 = g; i0 = jb; } else if (g > b1) { b2 = b1; i2 = i1; b1 = g; i1 = jb; } else if (g > b2) { b2 = g; i2 = jb; } } }
        }
        unsigned mym = 0u; if (i0 >= 0) mym |= 1u << i0; if (i1 >= 0) mym |= 1u << i1; if (i2 >= 0) mym |= 1u << i2;
        { unsigned wm = mym;
#pragma unroll
          for (int o_ = 1; o_ < 64; o_ <<= 1) wm |= (unsigned)mk_shfl_xor((int)wm, o_);
          if (lu == 0) atomicOr((unsigned*)(shm + OFF_MSK), wm); }
        AT_WAIT_BAR(0);
        const unsigned wgm = (unsigned)__builtin_amdgcn_readfirstlane(*(volatile LAS unsigned*)(shm + OFF_MSK)) | (1u << blk);
        for (int jb = 0; jb < blk; ++jb) if ((wgm >> jb) & 1u) { blist |= (unsigned long long)jb << (4 * nb); ++nb; }
        const int NTI = 4 * nb;
        f32x16 o[2]; float mhat = 0.f, lsum = 0.f; o[0] = f32x16{}; o[1] = f32x16{};
        f32x16 pA0, pA1, pB0, pB1; bf16x8 kf[8]; s16x4 vlo[8], vhi[8]; u32x4 pw0, pw1, pw2, pw3; bool resc = false;
        const float akey = hi ? 1.0f : slope2 * (float)r32;
        unsigned sl_prev = 0u, sl_cur = 0u, sl_next = KSTG;
#define ROT() do { sl_prev = sl_cur; sl_cur = sl_next; sl_next = (sl_next == 2u * KSTG) ? 0u : sl_next + KSTG; } while (0)
#define PIN(x) asm volatile("" : "+v"(x))
#define KLD(sl, d0) do { const unsigned a_ = lds0 + (sl) + (unsigned)koff[d0]; kf[2 * (d0)] = *(const __attribute__((address_space(3))) bf16x8*)(uintptr_t)a_; kf[2 * (d0) + 1] = *(const __attribute__((address_space(3))) bf16x8*)(uintptr_t)(a_ + 4096u); } while (0)
#define VRD(i) do { vlo[i] = vtr(vp_ + (((i) >> 2) * 4096 + ((i) & 3) * 1024)); vhi[i] = vtr(vp_ + (((i) >> 2) * 4096 + ((i) & 3) * 1024 + 512)); } while (0)
#define VFR(i) (bf16x8){vlo[i][0], vlo[i][1], vlo[i][2], vlo[i][3], vhi[i][0], vhi[i][1], vhi[i][2], vhi[i][3]}
#define PKW(P, i) cvtpk(P[i], P[i + 1])
#define PAF(k) __builtin_bit_cast(bf16x8, pw##k)
#define EX(v) __builtin_amdgcn_exp2f(v)
#define SINIT(C0, C1, t) do { const int k0_ = MB_K0(t), jb_ = k0_ >> 8; const bool sel_ = (jb_ == blk) || ((mym >> jb_) & 1u); const float c_ = (sel_ ? slope2 * (float)(k0_ - q0w) : -INFINITY) - mhat; \
        const float b0_ = hi ? c_ : 1.0f, b1_ = hi ? c_ + slope2 * 32.f : 1.0f; C0 = __builtin_amdgcn_mfma_f32_32x32x2f32(akey, b0_, f32x16{}, 0, 0, 0); C1 = __builtin_amdgcn_mfma_f32_32x32x2f32(akey, b1_, f32x16{}, 0, 0, 0); } while (0)
#define DECIDE(C0, C1, t) do { if ((t) < 4) { const int qh_ = q0w + r32 - MB_K0(t) - 4 * hi; \
            _Pragma("unroll") for (int r = 0; r < 16; ++r) { const int kc = (r & 3) + 8 * (r >> 2); if (kc > qh_) C0[r] = -INFINITY; if (kc + 32 > qh_) C1[r] = -INFINITY; } } \
        C1[15] += 0.0f; C0[15] += 0.0f; AT_SB(); \
        float rm_; { float m0 = max3f(C0[0], C0[1], C1[0]), m1 = max3f(C0[2], C0[3], C1[1]); m0 = max3f(m0, C1[2], C1[3]); \
            _Pragma("unroll") for (int r = 4; r < 16; r += 4) { m0 = max3f(m0, C0[r], C0[r + 1]); m1 = max3f(m1, C0[r + 2], C0[r + 3]); m0 = max3f(m0, C1[r], C1[r + 1]); m1 = max3f(m1, C1[r + 2], C1[r + 3]); } \
            const float a_ = fmaxf(m0, m1); auto rr_ = __builtin_amdgcn_permlane32_swap(__float_as_uint(a_), __float_as_uint(a_), false, false); rm_ = fmaxf(__uint_as_float(rr_[0]), __uint_as_float(rr_[1])); } \
        resc = false; if (__any(rm_ > THR)) { const float dl_ = fmaxf(rm_, 0.f); mhat += dl_; _Pragma("unroll") for (int r = 0; r < 16; ++r) { C0[r] -= dl_; C1[r] -= dl_; } \
            const float f_ = __builtin_amdgcn_exp2f(-dl_); lsum *= f_; if (hi == 0) wsf[r32] = f_; resc = true; } } while (0)
#define RESC() do { if (resc) { asm volatile("s_waitcnt lgkmcnt(0)" ::: "memory"); _Pragma("unroll") for (int r = 0; r < 16; ++r) { const float f_ = (wsf + 4 * hi)[(r & 3) + 8 * (r >> 2)]; o[0][r] *= f_; o[1][r] *= f_; } } } while (0)
#define GAPA(MF, a0, a1, a2, a3, W0, W1, PW) do { MF; sacc += a0; sacc += a1; sacc += a2; sacc += a3; W0; W1; PIN(PW); PIN(sacc); AT_SB(); } while (0)
#define GAPB(MF, X, i) do { MF; X[i] = EX(X[i]); X[i + 1] = EX(X[i + 1]); X[i + 2] = EX(X[i + 2]); X[i + 3] = EX(X[i + 3]); PIN(X); AT_SB(); } while (0)
#define KRD(G, d0) do { if (G) { KLD(sl_next, d0); AT_SB(); } } while (0)
#define STEP(C0, C1, P0, P1, t) do { AT_SB(); const lds_cptr vp_ = vp0 + sl_prev; const bool gl_ = (t) + 1 < NTI; \
        SINIT(C0, C1, t); AT_SB(); \
        VRD(0); AT_SB(); float sacc = P0[0] + P0[1]; \
                         GAPA(C0 = AT_MFMA(kf[0], qf[0], C0), P0[2], P0[3], P0[4], P0[5],     pw0[0] = PKW(P0, 0),  pw0[1] = PKW(P0, 2),  pw0); \
        VRD(4); AT_SB(); GAPA(C1 = AT_MFMA(kf[1], qf[0], C1), P0[6], P0[7], P0[8], P0[9],     pw0[2] = PKW(P0, 4),  pw0[3] = PKW(P0, 6),  pw0); \
        VRD(1); AT_SB(); GAPA(C0 = AT_MFMA(kf[2], qf[1], C0), P0[10], P0[11], P0[12], P0[13], pw1[0] = PKW(P0, 8),  pw1[1] = PKW(P0, 10), pw1); \
        VRD(5); AT_SB(); GAPA(C1 = AT_MFMA(kf[3], qf[1], C1), P0[14], P0[15], P1[0], P1[1],   pw1[2] = PKW(P0, 12), pw1[3] = PKW(P0, 14), pw1); \
        VRD(2); AT_SB(); GAPA(C0 = AT_MFMA(kf[4], qf[2], C0), P1[2], P1[3], P1[4], P1[5],     pw2[0] = PKW(P1, 0),  pw2[1] = PKW(P1, 2),  pw2); \
        VRD(6); AT_SB(); GAPA(C1 = AT_MFMA(kf[5], qf[2], C1), P1[6], P1[7], P1[8], P1[9],     pw2[2] = PKW(P1, 4),  pw2[3] = PKW(P1, 6),  pw2); \
        VRD(3); AT_SB(); GAPA(C0 = AT_MFMA(kf[6], qf[3], C0), P1[10], P1[11], P1[12], P1[13], pw3[0] = PKW(P1, 8),  pw3[1] = PKW(P1, 10), pw3); \
        VRD(7); AT_SB(); GAPA(C1 = AT_MFMA(kf[7], qf[3], C1), P1[14], P1[15], 0.f, 0.f,       pw3[2] = PKW(P1, 12), pw3[3] = PKW(P1, 14), pw3); \
        lsum += sacc; \
        if ((t) + 3 < NTI) DMA_K((t) + 3, sl_cur); if ((t) + 1 < NTI) DMA_V((t) + 1, sl_next);        \
        DECIDE(C0, C1, t); AT_SB(); \
        GAPB(o[0] = AT_MFMA(PAF(0), VFR(0), o[0]), C0, 0);               GAPB(o[1] = AT_MFMA(PAF(0), VFR(4), o[1]), C0, 4); \
        KRD(gl_, 0); GAPB(o[0] = AT_MFMA(PAF(1), VFR(1), o[0]), C0, 8);  KRD(gl_, 1); GAPB(o[1] = AT_MFMA(PAF(1), VFR(5), o[1]), C0, 12); \
        KRD(gl_, 2); GAPB(o[0] = AT_MFMA(PAF(2), VFR(2), o[0]), C1, 0);  KRD(gl_, 3); GAPB(o[1] = AT_MFMA(PAF(2), VFR(6), o[1]), C1, 4); \
        GAPB(o[0] = AT_MFMA(PAF(3), VFR(3), o[0]), C1, 8);               GAPB(o[1] = AT_MFMA(PAF(3), VFR(7), o[1]), C1, 12); \
        } while (0)
#define ENDW(t) do { if ((t) + 3 < NTI) { AT_WAIT_BAR(2); } else if ((t) + 1 < NTI) { AT_WAIT_BAR(1); } else { AT_WAIT_BAR(0); } } while (0)
        _Pragma("unroll") for (int d0 = 0; d0 < 4; ++d0) KLD(0u, d0);
        SINIT(pA0, pA1, 0);
        _Pragma("unroll") for (int d0 = 0; d0 < 4; ++d0) { pA0 = AT_MFMA(kf[2 * d0], qf[d0], pA0); pA1 = AT_MFMA(kf[2 * d0 + 1], qf[d0], pA1); }
        AT_SB(); DECIDE(pA0, pA1, 0);
        _Pragma("unroll") for (int r = 0; r < 16; ++r) { pA0[r] = EX(pA0[r]); pA1[r] = EX(pA1[r]); }
        AT_WAIT_BAR(0);
        DMA_K(3, 0); DMA_V(1, KSTG); ROT();
        _Pragma("unroll") for (int d0 = 0; d0 < 4; ++d0) KLD(sl_cur, d0);
        AT_WAIT_BAR(2);
        { int t = 1;
          for (; t + 1 < NTI; t += 2) {
              STEP(pB0, pB1, pA0, pA1, t);     ENDW(t);     RESC(); ROT();
              STEP(pA0, pA1, pB0, pB1, t + 1); ENDW(t + 1); RESC(); ROT(); }
          STEP(pB0, pB1, pA0, pA1, t); ENDW(t); RESC(); ROT(); }
        { float sacc = pB0[0] + pB0[1];
          _Pragma("unroll") for (int r = 2; r < 16; ++r) sacc += pB0[r];
          _Pragma("unroll") for (int r = 0; r < 16; ++r) sacc += pB1[r];
          lsum += sacc;
          pw0 = (u32x4){PKW(pB0, 0), PKW(pB0, 2), PKW(pB0, 4), PKW(pB0, 6)}; pw1 = (u32x4){PKW(pB0, 8), PKW(pB0, 10), PKW(pB0, 12), PKW(pB0, 14)};
          pw2 = (u32x4){PKW(pB1, 0), PKW(pB1, 2), PKW(pB1, 4), PKW(pB1, 6)}; pw3 = (u32x4){PKW(pB1, 8), PKW(pB1, 10), PKW(pB1, 12), PKW(pB1, 14)};
          const lds_cptr vp_ = vp0 + sl_prev; _Pragma("unroll") for (int i = 0; i < 8; ++i) VRD(i);
          o[0] = AT_MFMA(PAF(0), VFR(0), o[0]); o[1] = AT_MFMA(PAF(0), VFR(4), o[1]); o[0] = AT_MFMA(PAF(1), VFR(1), o[0]); o[1] = AT_MFMA(PAF(1), VFR(5), o[1]);
          o[0] = AT_MFMA(PAF(2), VFR(2), o[0]); o[1] = AT_MFMA(PAF(2), VFR(6), o[1]); o[0] = AT_MFMA(PAF(3), VFR(3), o[0]); o[1] = AT_MFMA(PAF(3), VFR(7), o[1]); }
        AT_WAIT_BAR(0);
#undef DMA_K
#undef DMA_V
#undef ROT
#undef PIN
#undef KLD
#undef VRD
#undef VFR
#undef PKW
#undef PAF
#undef EX
#undef SINIT
#undef DECIDE
#undef RESC
#undef GAPA
#undef GAPB
#undef KRD
#undef STEP
#undef ENDW
#undef MB_K0
        { auto rr = __builtin_amdgcn_permlane32_swap(__float_as_uint(lsum), __float_as_uint(lsum), false, false); lsum = __uint_as_float(rr[0]) + __uint_as_float(rr[1]); }
        if (hi == 0) wsf[32 + r32] = lsum;
        asm volatile("s_waitcnt lgkmcnt(0)" ::: "memory");
        { int le_ = mk_lane(); asm volatile("" : "+v"(le_));
          LAS bf16* stg = (LAS bf16*)(shm + OFF_Q + wid * 4096) + (4 * (le_ >> 5)) * 64 + (le_ & 31);
#pragma unroll
          for (int r = 0; r < 16; ++r) { const float il = __builtin_amdgcn_rcpf((wsf + 32 + 4 * (le_ >> 5))[(r & 3) + 8 * (r >> 2)]);
#pragma unroll
              for (int db = 0; db < 2; ++db) stg[((r & 3) + 8 * (r >> 2)) * 64 + db * 32] = (bf16)f2bf(o[db][r] * il); }
          asm volatile("s_waitcnt lgkmcnt(0)" ::: "memory");
          bf16* Ow = YA + (rowb + q0w) * YP + h * 64;
#pragma unroll
          for (int i = 0; i < 4; ++i) { const int row = i * 8 + (le_ >> 3), ch = le_ & 7; const v4u v = *(const LAS v4u*)(shm + OFF_Q + wid * 4096 + row * 128 + ch * 16); *(GAS v4u*)(Ow + (size_t)row * YP + ch * 8) = v; } }
        AT_WAIT_BAR(0);
    }
}
__device__ __forceinline__ void ph_moba_naive(Frame& F) {
    LAS float* Ks = (LAS float*)(F.lds + RING_OFF); LAS float* Vs = Ks + 64 * 64; LAS float* Km = Vs + 64 * 64; LAS unsigned* msk = (LAS unsigned*)(Km + MOBA_NB * 64);
    const bf16* QA = (const bf16*)(F.ws + WS_QA); const bf16* KA = (const bf16*)(F.ws + WS_KA); const bf16* VA = (const bf16*)(F.ws + WS_VA); bf16* YA = (bf16*)(F.ws + WS_YA);
    const float* KM = (const float*)(F.ws + WS_KMEAN);
    const int row = F.tid >> 2, qd = F.tid & 3;
    for (int idx = F.vcu; idx < BATCH * MOBA_H * 32; idx += F.G) {
        int bh, qt; causal_unit(idx, BATCH * MOBA_H, true, bh, qt);
        const int b = bh / MOBA_H, h = bh % MOBA_H, blk = qt >> 1; const int qpos = qt * 128 + row; const size_t grow = (size_t)b * SEQ + qpos;
        const float slope2 = exp2f(-(float)(h + 1)) * LOG2E;
        __syncthreads();
        for (int i = F.tid; i < MOBA_NB * 64; i += NWAVES * 64) Km[i] = KM[(size_t)bh * MOBA_NB * 64 + i];
        if (F.tid == 0) msk[0] = 0u;
        __syncthreads();
        float q[16]; load_q16(q, QA + grow * 512 + h * 64 + qd * 16);
        float b0 = -INFINITY, b1 = -INFINITY, b2 = -INFINITY; int i0 = -1, i1 = -1, i2 = -1;
        for (int j = 0; j < blk; ++j) { float g = 0.f;
#pragma unroll
            for (int d = 0; d < 16; ++d) g += q[d] * Km[j * 64 + qd * 16 + d];
            g += mk_shfl_xor(g, 1); g += mk_shfl_xor(g, 2);
            if (g > b0) { b2 = b1; i2 = i1; b1 = b0; i1 = i0; b0 = g; i0 = j; } else if (g > b1) { b2 = b1; i2 = i1; b1 = g; i1 = j; } else if (g > b2) { b2 = g; i2 = j; } }
        unsigned mym = 0u; if (i0 >= 0) mym |= 1u << i0; if (i1 >= 0) mym |= 1u << i1; if (i2 >= 0) mym |= 1u << i2;
        atomicOr((unsigned*)msk, mym);
        __syncthreads();
        const unsigned wgm = msk[0];
        float o[16]; float mr = -INFINITY, lr = 0.f;
#pragma unroll
        for (int d = 0; d < 16; ++d) o[d] = 0.f;
        for (int jb = blk; jb >= 0; --jb) {
            if (jb != blk && !((wgm >> jb) & 1u)) continue;
            const bool mine = (jb == blk) || ((mym >> jb) & 1u);
            const int ktop = (jb == blk) ? (2 * (qt & 1) + 1) : 3;
            for (int kt = ktop; kt >= 0; --kt) {
                __syncthreads();
                const size_t krow = (size_t)b * SEQ + jb * 256 + kt * 64;
                naive_stage<64>(F, Ks, Vs, KA + krow * 512 + h * 64, VA + krow * 512 + h * 64);
                __syncthreads();
                naive_tile<16, 64>(Ks, Vs, q, o, mr, lr, qpos, jb * 256 + kt * 64, slope2, mine, qd);
            }
        }
        const float il = __builtin_amdgcn_rcpf(lr); bf16* yp = YA + grow * YP + h * 64 + qd * 16;
#pragma unroll
        for (int d = 0; d < 16; d += 8) { v4u w; w.x = pk2(o[d] * il, o[d + 1] * il); w.y = pk2(o[d + 2] * il, o[d + 3] * il); w.z = pk2(o[d + 4] * il, o[d + 5] * il); w.w = pk2(o[d + 6] * il, o[d + 7] * il); *(GAS v4u*)(yp + d) = w; }
    }
    __syncthreads();
}
template <bool FIX> __device__ __forceinline__ void ph_rglru_mfma(Frame& F, const RgP& P) {
    using namespace at;
    const int wid = F.wave;
    constexpr int OFF_CT = 16384, OFF_RAW = 18432, RAWB = 9216;
    LAS unsigned char* shm = F.lds + RING_OFF; const unsigned lds0 = (unsigned)(uintptr_t)shm;
    LAS unsigned char* wfr = shm; LAS float* ctab = (LAS float*)(shm + OFF_CT); const lds_cptr rawp = (lds_cptr)shm + OFF_RAW + wid * RAWB;
    const bf16* RX = (const bf16*)(F.ws + WS_RX); const bf16* RG = (const bf16*)(F.ws + WS_RG); bf16* YB = (bf16*)(F.ws + WS_YB);
    bf16* XRp = (bf16*)(F.ws + WS_MG);
    float* AG = (float*)(F.ws + WS_AGG); float* BG = AG + (size_t)BATCH * RG_NCH * D; const float* CI = (const float*)(F.ws + WS_CARRY);
    const bf16* WT = (const bf16*)(F.ws + WS_RGW);
    const bf16* ZR = (const bf16*)(F.ws + 640 * 1024);
    const bool grp = (F.G % RG_NB) == 0;
    const int nstart = grp ? F.vcu % RG_NB : 0, nstep = grp ? RG_NB : 1, wn = grp ? (F.vcu / RG_NB) * NWAVES + wid : F.vcu * NWAVES + wid, NWn = grp ? (F.G / RG_NB) * NWAVES : F.G * NWAVES;
    for (int n = nstart; n < RG_NB; n += nstep) {
        __syncthreads();
        const bf16* SRCX = FIX ? XRp : RX; constexpr int HAL = FIX ? 0 : 3, NPC = FIX ? 8 : 9;
#define RG_DMA(Q_) do { const int b_ = (Q_) / RG_NCH, c_ = (Q_) % RG_NCH; int ld_ = mk_lane(); \
            _Pragma("unroll") for (int i = 0; i < NPC; ++i) { const int br = 8 * i + (ld_ >> 3), chunk = (ld_ & 7) ^ ((br >> 1) & 7); int trow = c_ * RG_CHUNK - HAL + br; const int tmax = c_ * RG_CHUNK + RG_CHUNK - 1; \
                const bf16* src = trow >= 0 ? SRCX + ((size_t)b_ * SEQ + (trow > tmax ? tmax : trow)) * D + n * 64 + chunk * 8 : ZR + chunk * 8; \
                glds16(src, (unsigned)__builtin_amdgcn_readfirstlane(lds0 + OFF_RAW + wid * RAWB + i * 1024)); } } while (0)
        const bool blocked = FIX && ((BATCH * RG_NCH) % NWn == 0);
        const int upw = blocked ? (BATCH * RG_NCH) / NWn : 0, qstep = blocked ? 1 : NWn, qbeg = blocked ? wn * upw : wn, qend = blocked ? qbeg + upw : BATCH * RG_NCH;
        if (qbeg < qend) RG_DMA(qbeg);
        float ba[2], bx[2], c8[2];
        { int t_ = wid * 64 + mk_lane(); asm volatile("" : "+v"(t_));
          bf16x8 wv_[2]; float ctv_ = 0.f, pa_[2], px_[2], pl_[2];
#pragma unroll
          for (int i = 0; i < 2; ++i) { const int p = t_ + i * 512, f = p >> 6, ln = p & 63, ct = f >> 3, g = (f >> 2) & 1, ks = f & 3;
              wv_[i] = *(const GAS bf16x8*)(WT + ((size_t)(g * RG_NB + n) * 64 + 32 * ct + (ln & 31)) * 64 + 16 * ks + 8 * (ln >> 5)); }
          if (!FIX && t_ < 320) ctv_ = t_ < 256 ? ((const GAS float*)P.conv_w)[(t_ >> 6) * D + n * 64 + (t_ & 63)] : ((const GAS float*)P.conv_b)[n * 64 + (t_ & 63)];
#pragma unroll
          for (int ct = 0; ct < 2; ++ct) { const int ch = n * 64 + 32 * ct + (t_ & 31); pa_[ct] = ((const GAS float*)P.b_a)[ch]; px_[ct] = ((const GAS float*)P.b_x)[ch]; pl_[ct] = ((const GAS float*)P.lam)[ch]; }
          __builtin_amdgcn_sched_barrier(0);
#pragma unroll
          for (int i = 0; i < 2; ++i) *(LAS bf16x8*)(wfr + (t_ + i * 512) * 16) = wv_[i];
          if (!FIX && t_ < 320) ctab[t_] = ctv_;
#pragma unroll
          for (int ct = 0; ct < 2; ++ct) { ba[ct] = -pa_[ct] * LOG2E; bx[ct] = -px_[ct] * LOG2E; c8[ct] = -8.0f * log1pf(expf(-pl_[ct])) * LOG2E; } }
        __syncthreads();
        int prevq = -2; float hprev[2] = {0.f, 0.f};
        for (int q = qbeg; q < qend; q += qstep) {
            const int c = q % RG_NCH, b = q / RG_NCH;
            const int lq_ = mk_lane(), r32o = lq_ & 31, hio = lq_ >> 5;
            const size_t rb = (size_t)b * SEQ; const size_t aidx = ((size_t)b * RG_NCH + c) * D + n * 64 + r32o;
            float h[2] = {0.f, 0.f}, pa[2] = {1.f, 1.f};
            if (FIX && c != 0) {
                if (q == prevq + 1) { h[0] = hprev[0]; h[1] = hprev[1]; }
                else { const float* Ap = AG + (size_t)b * RG_NCH * D + n * 64 + r32o; const float* Bp = BG + (size_t)b * RG_NCH * D + n * 64 + r32o;
                    for (int k0 = 0; k0 < c; k0 += 16) { float a0[16], b0[16], a1[16], b1[16];
#pragma unroll
                        for (int j = 0; j < 16; ++j) { const size_t o_ = (size_t)(k0 + j < c ? k0 + j : 0) * D; a0[j] = ((const GAS float*)Ap)[o_]; b0[j] = ((const GAS float*)Bp)[o_]; a1[j] = ((const GAS float*)Ap)[o_ + 32]; b1[j] = ((const GAS float*)Bp)[o_ + 32]; }
                        __builtin_amdgcn_sched_barrier(0);
#pragma unroll
                        for (int j = 0; j < 16; ++j) { const bool ok = k0 + j < c; h[0] = (ok ? a0[j] : 1.f) * h[0] + (ok ? b0[j] : 0.f); h[1] = (ok ? a1[j] : 1.f) * h[1] + (ok ? b1[j] : 0.f); } } } }
            asm volatile("s_waitcnt vmcnt(0)" ::: "memory");
#pragma unroll 1
            for (int tt = 0; tt < 2; ++tt) {
                const int t0 = c * RG_CHUNK + tt * 32;
                int lt_ = mk_lane(); const int r32 = lt_ & 31, hi = lt_ >> 5;
                bf16x8 Af[4];
#pragma unroll
                for (int ks = 0; ks < 4; ++ks) { const int cc = 16 * ks + 8 * hi; float x8[8];
                    if (FIX) { const int br = tt * 32 + r32; Af[ks] = *(const LAS bf16x8*)(rawp + br * 128 + (((2 * ks + hi) ^ ((br >> 1) & 7)) << 4)); continue; }
                    { const f32x4 b0 = *(const LAS f32x4*)(ctab + 256 + cc), b1 = *(const LAS f32x4*)(ctab + 256 + cc + 4); x8[0] = b0[0]; x8[1] = b0[1]; x8[2] = b0[2]; x8[3] = b0[3]; x8[4] = b1[0]; x8[5] = b1[1]; x8[6] = b1[2]; x8[7] = b1[3]; }
#pragma unroll
                    for (int j = 0; j < 4; ++j) { const int br = tt * 32 + r32 + j; const v4u w = *(const LAS v4u*)(rawp + br * 128 + (((2 * ks + hi) ^ ((br >> 1) & 7)) << 4));
                        const f32x4 w0 = *(const LAS f32x4*)(ctab + j * 64 + cc), w1 = *(const LAS f32x4*)(ctab + j * 64 + cc + 4);
                        x8[0] += w0[0] * bf_lo(w.x); x8[1] += w0[1] * bf_hi(w.x); x8[2] += w0[2] * bf_lo(w.y); x8[3] += w0[3] * bf_hi(w.y);
                        x8[4] += w1[0] * bf_lo(w.z); x8[5] += w1[1] * bf_hi(w.z); x8[6] += w1[2] * bf_lo(w.w); x8[7] += w1[3] * bf_hi(w.w); }
                    const u32x4 pk = (u32x4){cvtpk(x8[0], x8[1]), cvtpk(x8[2], x8[3]), cvtpk(x8[4], x8[5]), cvtpk(x8[6], x8[7])}; Af[ks] = __builtin_bit_cast(bf16x8, pk);
                    *(GAS u32x4*)(XRp + ((size_t)b * SEQ + c * RG_CHUNK + tt * 32 + r32) * D + n * 64 + cc) = pk;
                    }
                if (tt == 1 && q + qstep < qend) { asm volatile("s_waitcnt lgkmcnt(0)" ::: "memory"); RG_DMA(q + qstep); }
#pragma unroll
            for (int ct = 0; ct < 2; ++ct) {
                bf16 rgv[16];
                if (FIX) { const GAS bf16* rgp = (const GAS bf16*)RG + (rb + t0 + 4 * hi) * D + n * 64 + 32 * ct + r32;
#pragma unroll
                    for (int r = 0; r < 16; ++r) rgv[r] = rgp[(size_t)((r & 3) + 8 * (r >> 2)) * D];
                    __builtin_amdgcn_sched_barrier(0); }
                f32x16 accr = f32x16{}, acci = f32x16{}, accx = f32x16{};
                { bf16x8 Br[4], Bi[4];
#pragma unroll
                  for (int ks = 0; ks < 4; ++ks) { Br[ks] = *(const LAS bf16x8*)(wfr + ((ct * 2 + 0) * 4 + ks) * 1024 + lt_ * 16); Bi[ks] = *(const LAS bf16x8*)(wfr + ((ct * 2 + 1) * 4 + ks) * 1024 + lt_ * 16); }
#pragma unroll
                  for (int ks = 0; ks < 4; ++ks) { accr = AT_MFMA(Af[ks], Br[ks], accr); acci = AT_MFMA(Af[ks], Bi[ks], acci); } }
#pragma unroll
                for (int kk = 0; kk < 2; ++kk) { const int ks = 2 * ct + kk; bf16x8 idf;
#pragma unroll
                    for (int j = 0; j < 8; ++j) idf[j] = (16 * kk + 8 * hi + j == r32) ? (short)0x3F80 : (short)0;
                    accx = AT_MFMA(Af[ks], idf, accx); }
                float a[16], bb[16];
#pragma unroll
                for (int r = 0; r < 16; ++r) { const float rg = __builtin_amdgcn_rcpf(1.0f + __builtin_amdgcn_exp2f(__builtin_fmaf(accr[r], -LOG2E, ba[ct]))), ig = __builtin_amdgcn_rcpf(1.0f + __builtin_amdgcn_exp2f(__builtin_fmaf(acci[r], -LOG2E, bx[ct])));
                    const float la2 = c8[ct] * rg; a[r] = __builtin_amdgcn_exp2f(la2); const float om = 1.0f - a[r] * a[r]; bb[r] = __builtin_amdgcn_sqrtf(fmaxf(om, 0.f)) * (ig * accx[r]); }
                float Ag[4], Bg[4], pA[4], pB[4];
#pragma unroll
                for (int g = 0; g < 4; ++g) { Ag[g] = (a[4 * g] * a[4 * g + 1]) * (a[4 * g + 2] * a[4 * g + 3]); Bg[g] = ((bb[4 * g] * a[4 * g + 1] + bb[4 * g + 1]) * a[4 * g + 2] + bb[4 * g + 2]) * a[4 * g + 3] + bb[4 * g + 3];
                    auto ra = __builtin_amdgcn_permlane32_swap(__float_as_uint(Ag[g]), __float_as_uint(Ag[g]), false, false); pA[g] = __uint_as_float(hi ? ra[0] : ra[1]);
                    auto rbb = __builtin_amdgcn_permlane32_swap(__float_as_uint(Bg[g]), __float_as_uint(Bg[g]), false, false); pB[g] = __uint_as_float(hi ? rbb[0] : rbb[1]); }
                float cin[4], cc_ = h[ct], pp = pa[ct];
#pragma unroll
                for (int k = 0; k < 8; ++k) { const int g = k >> 1; const bool mine = (hi == (k & 1)); if (mine) cin[g] = cc_;
                    const float Ak = mine ? Ag[g] : pA[g], Bk = mine ? Bg[g] : pB[g]; cc_ = Ak * cc_ + Bk; pp *= Ak; }
                h[ct] = cc_; pa[ct] = pp;
                if (FIX) { GAS bf16* yg = (GAS bf16*)YB + (rb + t0 + 4 * hi) * YP + n * 64 + 32 * ct + r32;
#pragma unroll
                    for (int g = 0; g < 4; ++g) { float hv = cin[g];
#pragma unroll
                        for (int e = 0; e < 4; ++e) { const int r = 4 * g + e; hv = a[r] * hv + bb[r]; yg[(size_t)(e + 8 * g) * YP] = (bf16)f2bf(hv * bf2f(rgv[r])); } } }
            }
            }
            if (!FIX && hio == 0) {
#pragma unroll
                for (int ct = 0; ct < 2; ++ct) { ((GAS float*)AG)[aidx + 32 * ct] = pa[ct]; ((GAS float*)BG)[aidx + 32 * ct] = h[ct]; } }
            prevq = q; hprev[0] = h[0]; hprev[1] = h[1];
        }
#undef RG_DMA
    }
    asm volatile("s_waitcnt vmcnt(0)" ::: "memory");
}
__device__ __forceinline__ void ph_ffnact(Frame& F, const float* cw  , const float* cbias  ) {
    const bf16* U = (const bf16*)(F.ws + WS_U); bf16* ACT = (bf16*)(F.ws + WS_ACT);
    constexpr int RW = 16, NCK = DFF / 8; const int total = (M / RW) * NCK, stride = F.G * NWAVES * 64;
    for (int i = F.vcu * NWAVES * 64 + F.tid; i < total; i += stride) {
        const int rg = i / NCK, c = (i % NCK) * 8, row0 = rg * RW, t0 = row0 % SEQ;
        float wg[3][8], wv[3][8], bg[8], bv[8];
#pragma unroll
        for (int j = 0; j < 3; ++j) { const f32x4 a0 = *(const GAS f32x4*)(cw + (size_t)j * DFF2 + c), a1 = *(const GAS f32x4*)(cw + (size_t)j * DFF2 + c + 4), v0 = *(const GAS f32x4*)(cw + (size_t)j * DFF2 + DFF + c), v1 = *(const GAS f32x4*)(cw + (size_t)j * DFF2 + DFF + c + 4);
            wg[j][0] = a0[0]; wg[j][1] = a0[1]; wg[j][2] = a0[2]; wg[j][3] = a0[3]; wg[j][4] = a1[0]; wg[j][5] = a1[1]; wg[j][6] = a1[2]; wg[j][7] = a1[3];
            wv[j][0] = v0[0]; wv[j][1] = v0[1]; wv[j][2] = v0[2]; wv[j][3] = v0[3]; wv[j][4] = v1[0]; wv[j][5] = v1[1]; wv[j][6] = v1[2]; wv[j][7] = v1[3]; }
        { const f32x4 a0 = *(const GAS f32x4*)(cbias + c), a1 = *(const GAS f32x4*)(cbias + c + 4), v0 = *(const GAS f32x4*)(cbias + DFF + c), v1 = *(const GAS f32x4*)(cbias + DFF + c + 4);
          bg[0] = a0[0]; bg[1] = a0[1]; bg[2] = a0[2]; bg[3] = a0[3]; bg[4] = a1[0]; bg[5] = a1[1]; bg[6] = a1[2]; bg[7] = a1[3]; bv[0] = v0[0]; bv[1] = v0[1]; bv[2] = v0[2]; bv[3] = v0[3]; bv[4] = v1[0]; bv[5] = v1[1]; bv[6] = v1[2]; bv[7] = v1[3]; }
        v4u g2 = (v4u){0u, 0u, 0u, 0u}, g1 = g2, v2 = g2, v1_ = g2;
        if (t0 >= 2) { const bf16* up = U + (size_t)(row0 - 2) * DFF2 + c; g2 = *(const GAS v4u*)up; v2 = *(const GAS v4u*)(up + DFF); }
        if (t0 >= 1) { const bf16* up = U + (size_t)(row0 - 1) * DFF2 + c; g1 = *(const GAS v4u*)up; v1_ = *(const GAS v4u*)(up + DFF); }
#pragma unroll 4
        for (int r = 0; r < RW; ++r) {
            const bf16* up = U + (size_t)(row0 + r) * DFF2 + c; const v4u g0 = *(const GAS v4u*)up, v0 = *(const GAS v4u*)(up + DFF);
            float ug[8], uv[8];
#define FA_ROW(D_, W_, X_) D_[0] += W_[0] * bf_lo(X_.x); D_[1] += W_[1] * bf_hi(X_.x); D_[2] += W_[2] * bf_lo(X_.y); D_[3] += W_[3] * bf_hi(X_.y); D_[4] += W_[4] * bf_lo(X_.z); D_[5] += W_[5] * bf_hi(X_.z); D_[6] += W_[6] * bf_lo(X_.w); D_[7] += W_[7] * bf_hi(X_.w);
#pragma unroll
            for (int e = 0; e < 8; ++e) { ug[e] = bg[e]; uv[e] = bv[e]; }
            FA_ROW(ug, wg[0], g2) FA_ROW(ug, wg[1], g1) FA_ROW(ug, wg[2], g0) FA_ROW(uv, wv[0], v2) FA_ROW(uv, wv[1], v1_) FA_ROW(uv, wv[2], v0)
#undef FA_ROW
            v4u w; w.x = pk2(pg8::gelu_tanh_f(ug[0]) * uv[0], pg8::gelu_tanh_f(ug[1]) * uv[1]); w.y = pk2(pg8::gelu_tanh_f(ug[2]) * uv[2], pg8::gelu_tanh_f(ug[3]) * uv[3]);
            w.z = pk2(pg8::gelu_tanh_f(ug[4]) * uv[4], pg8::gelu_tanh_f(ug[5]) * uv[5]); w.w = pk2(pg8::gelu_tanh_f(ug[6]) * uv[6], pg8::gelu_tanh_f(ug[7]) * uv[7]);
            *(GAS v4u*)(ACT + (size_t)(row0 + r) * DFF + c) = w;
            g2 = g1; g1 = g0; v2 = v1_; v1_ = v0;
        }
    }
}
__device__ __forceinline__ void ph_ffnfix(Frame& F, const float* cw  , const float* cbias  , int panel = -1  ) {
    const bf16* UH = (const bf16*)(F.ws + WS_U); bf16* ACT = (bf16*)(F.ws + WS_ACT);
    constexpr int NCK = DFF / 8; const int total = (panel >= 0 ? 4 : M / 64) * 2 * NCK, stride = panel >= 0 ? NWAVES * 64 : F.G * NWAVES * 64;
    for (int i = (panel >= 0 ? 0 : F.vcu * NWAVES * 64) + F.tid; i < total; i += stride) {
        const int c = (i % NCK) * 8, sk = i / NCK + (panel >= 0 ? panel * 8 : 0), k = sk & 1, sl = sk >> 1; const bool hasprev = (sl % (SEQ / 64)) != 0;
        const bf16* r0 = UH + ((size_t)sl * 4 + (k == 0 ? 0 : 1)) * DFF2 + c;
        const bf16* r1 = k == 0 ? UH + ((size_t)(sl - 1) * 4 + 3) * DFF2 + c : UH + ((size_t)sl * 4 + 0) * DFF2 + c;
        const bf16* r2 = k == 0 ? UH + ((size_t)(sl - 1) * 4 + 2) * DFF2 + c : UH + ((size_t)(sl - 1) * 4 + 3) * DFF2 + c;
        const bool v1ok = (k == 1) || hasprev, v2ok = hasprev; const v4u z = (v4u){0u, 0u, 0u, 0u};
        const v4u g0 = *(const GAS v4u*)r0, v0 = *(const GAS v4u*)(r0 + DFF), g1 = v1ok ? *(const GAS v4u*)r1 : z, v1_ = v1ok ? *(const GAS v4u*)(r1 + DFF) : z, g2 = v2ok ? *(const GAS v4u*)r2 : z, v2 = v2ok ? *(const GAS v4u*)(r2 + DFF) : z;
        f32x4 wv[6][2], bs[4];
        { const GAS float* cg = (const GAS float*)cw + c; const GAS float* bg = (const GAS float*)cbias + c;
#pragma unroll
          for (int r = 0; r < 3; ++r) { wv[r][0] = *(const GAS f32x4*)(cg + r * DFF2); wv[r][1] = *(const GAS f32x4*)(cg + r * DFF2 + 4); wv[3 + r][0] = *(const GAS f32x4*)(cg + r * DFF2 + DFF); wv[3 + r][1] = *(const GAS f32x4*)(cg + r * DFF2 + DFF + 4); }
          bs[0] = *(const GAS f32x4*)bg; bs[1] = *(const GAS f32x4*)(bg + 4); bs[2] = *(const GAS f32x4*)(bg + DFF); bs[3] = *(const GAS f32x4*)(bg + DFF + 4); }
        __builtin_amdgcn_sched_barrier(0);
        float ug[8], uv[8];
#pragma unroll
        for (int e = 0; e < 4; ++e) { ug[e] = bs[0][e]; ug[4 + e] = bs[1][e]; uv[e] = bs[2][e]; uv[4 + e] = bs[3][e]; }
#define FX_ROW(D_, W_, X_) D_[0] += (W_)[0][0] * bf_lo(X_.x); D_[1] += (W_)[0][1] * bf_hi(X_.x); D_[2] += (W_)[0][2] * bf_lo(X_.y); D_[3] += (W_)[0][3] * bf_hi(X_.y); D_[4] += (W_)[1][0] * bf_lo(X_.z); D_[5] += (W_)[1][1] * bf_hi(X_.z); D_[6] += (W_)[1][2] * bf_lo(X_.w); D_[7] += (W_)[1][3] * bf_hi(X_.w);
        FX_ROW(ug, wv[0], g2) FX_ROW(ug, wv[1], g1) FX_ROW(ug, wv[2], g0) FX_ROW(uv, wv[3], v2) FX_ROW(uv, wv[4], v1_) FX_ROW(uv, wv[5], v0)
#undef FX_ROW
        v4u w; w.x = pk2(pg8::gelu_tanh_f(ug[0]) * uv[0], pg8::gelu_tanh_f(ug[1]) * uv[1]); w.y = pk2(pg8::gelu_tanh_f(ug[2]) * uv[2], pg8::gelu_tanh_f(ug[3]) * uv[3]);
        w.z = pk2(pg8::gelu_tanh_f(ug[4]) * uv[4], pg8::gelu_tanh_f(ug[5]) * uv[5]); w.w = pk2(pg8::gelu_tanh_f(ug[6]) * uv[6], pg8::gelu_tanh_f(ug[7]) * uv[7]);
        *(GAS v4u*)(ACT + ((size_t)sl * 64 + k) * DFF + c) = w;
    }
}
__device__ __forceinline__ void ph_final(Frame& F, const bf16* xh, const bf16* xlo, float* out, const float* g) {
    (void)xlo; static_assert(RESID_LO == 0, "the residual stream is xh only");
    typedef unsigned u32x2v __attribute__((ext_vector_type(2)));
    const int gw = F.vcu * NWAVES + F.wave, NGW = F.G * NWAVES;
    f32x4 gg[4];
#pragma unroll
    for (int j = 0; j < 4; ++j) gg[j] = *((const GAS f32x4*)g + F.lane + 64 * j);
    for (int m = gw; m < M; m += 2 * NGW) {
        const int m1 = m + NGW; const bool two = m1 < M;
        const GAS u32x2v* hr0 = (const GAS u32x2v*)(xh + (size_t)m * D) + F.lane; const GAS u32x2v* hr1 = (const GAS u32x2v*)(xh + (size_t)(two ? m1 : m) * D) + F.lane;
        u32x2v h0[4], h1[4];
#pragma unroll
        for (int j = 0; j < 4; ++j) { h0[j] = hr0[64 * j]; h1[j] = hr1[64 * j]; }
        f32x4 v0[4], v1[4]; float s0 = 0.f, s1 = 0.f;
#pragma unroll
        for (int j = 0; j < 4; ++j) { v0[j] = (f32x4){bf_lo(h0[j].x), bf_hi(h0[j].x), bf_lo(h0[j].y), bf_hi(h0[j].y)}; v1[j] = (f32x4){bf_lo(h1[j].x), bf_hi(h1[j].x), bf_lo(h1[j].y), bf_hi(h1[j].y)};
            s0 += (v0[j].x * v0[j].x + v0[j].y * v0[j].y) + (v0[j].z * v0[j].z + v0[j].w * v0[j].w); s1 += (v1[j].x * v1[j].x + v1[j].y * v1[j].y) + (v1[j].z * v1[j].z + v1[j].w * v1[j].w); }
        const float rs0 = rsqrtf(wave_sum(s0) * (1.0f / D) + 1e-6f), rs1 = rsqrtf(wave_sum(s1) * (1.0f / D) + 1e-6f);
        GAS f32x4* o0 = (GAS f32x4*)(out + (size_t)m * D) + F.lane; GAS f32x4* o1 = (GAS f32x4*)(out + (size_t)m1 * D) + F.lane;
#pragma unroll
        for (int j = 0; j < 4; ++j) { o0[64 * j] = v0[j] * rs0 * gg[j]; if (two) o1[64 * j] = v1[j] * rs1 * gg[j]; }
    }
}

constexpr int NPL = 10;
constexpr int NPH = 1 + DEPTH * NPL + 1;
struct Args { const float* in[26]; float* out; unsigned char* ws; int ph_lo, ph_hi; };
__global__ void __launch_bounds__(NWAVES * 64, 2) mk_fwd(Args args) {
    extern __shared__ __attribute__((aligned(16))) unsigned char lds[];
    Frame F;
    F.lds = (LAS unsigned char*)lds;
    F.MISC = (volatile LAS unsigned*)(F.lds + MISC_OFF);
    F.tid = threadIdx.x; F.lane = F.tid & 63; F.wave = __builtin_amdgcn_readfirstlane(F.tid >> 6);
    F.G = gridDim.x; { const int bx = blockIdx.x; F.vcu = (F.G % 8 == 0) ? (bx % 8) * (F.G / 8) + bx / 8 : bx; }
    F.ws = args.ws; F.ctl = (gu32*)(args.ws + WS_CTL);
    for (int u = F.tid; u < (LDS_BYTES - LDSCTL_OFF) / 4; u += NWAVES * 64) ((LAS unsigned*)(F.lds + LDSCTL_OFF))[u] = 0u;
    __syncthreads();
    const int lo = args.ph_lo, hi = args.ph_hi;
    XcdBarrier bar; bar.bar = (unsigned*)(F.ctl + CW_BAR); bar.x = 0; bar.st = nullptr;
    if (hi - lo > 1) bar = xcd_barrier_post((unsigned*)(F.ctl + CW_BAR), F.MISC + 8, F.tid == 0);
#define IN(k) (lo <= (k) && (k) < hi)
#define RELAUNDER() do { int t_ = F.wave * 64 + pg8::mk_lane(); asm volatile("" : "+v"(t_)); F.tid = t_; F.lane = t_ & 63; asm volatile("" : "+s"(KA)); unsigned char* w_ = (unsigned char*)KA[27]; asm volatile("" : "+s"(w_)); F.ws = w_; } while (0)
#define SEAM(k) do { if (DBG_TIMING) { if (blockIdx.x == 0 && F.wave == 0 && pg8::mk_lane() == 0) ((unsigned long long*)(F.ws + 768 * 1024))[(k) + 1] = __builtin_amdgcn_s_memrealtime(); } if ((k) + 1 < hi) { XcdBarrier b2_ = bar; asm volatile("" : "+s"(b2_.bar)); xcd_barrier(b2_, F.wave == 0 && pg8::mk_lane() == 0); } } while (0)
    typedef const float* cfp_t;
    const __attribute__((address_space(4))) cfp_t* KA = (const __attribute__((address_space(4))) cfp_t*)__builtin_amdgcn_kernarg_segment_ptr();
    #define in KA
    LAS float* RSTAB = (LAS float*)(F.lds + RSTAB_OFF);
#define XB ((bf16*)(F.ws + WS_XB))
#define SSP ((float*)(F.ws + WS_SS))
#define X32 ((float*)(F.ws + WS_X32))

    if (DBG_TIMING) { if (blockIdx.x == 0 && F.tid == 0) ((unsigned long long*)(args.ws + 768 * 1024))[0] = __builtin_amdgcn_s_memrealtime(); }
    if (IN(0)) { RELAUNDER(); ph_xprologue(F, in[0]); if (DBG_TIMING) { SEAM(0); } }

    for (int l = 0; l < DEPTH; ++l) {
        const int pb = 1 + l * NPL;
#define LAYER_W(L) LayerW{in[2] + (size_t)(L) * D * IN_COLS, in[1] + (size_t)(L) * D, in[16] + (size_t)(L) * 512 * D, in[17] + (size_t)(L) * D * D, in[18] + (size_t)(L) * 512 * D, in[19] + (size_t)(L) * D * D, \
                     in[21] + (size_t)(L) * D * DFF2, in[20] + (size_t)(L) * D, in[24] + (size_t)(L) * DFF * D, in[6] + (size_t)(L) * RG_NB * 4096, in[8] + (size_t)(L) * RG_NB * 4096}
        if (DBG_TIMING && l > 0 && blockIdx.x == 0 && F.wave == 0 && pg8::mk_lane() == 0) ((unsigned long long*)(F.ws + 768 * 1024))[pb + 1] = __builtin_amdgcn_s_memrealtime();
        if (IN(pb + 0) && l == 0) {
            const LayerW W = LAYER_W(0);
            RELAUNDER(); ph_weights(F, W, 3); SEAM(pb + 0);
        }
        if (IN(pb + 1)) {
            RELAUNDER();
            pg8::Gemm g{XB, (const bf16*)(F.ws + WS_WIN), M, IN_COLS, D}; pg8::StaticOrder S; S.init(M, IN_COLS, F.G, (int)blockIdx.x);
            pg8::EpiInProj E{(bf16*)(F.ws + WS_QA), (bf16*)(F.ws + WS_KA), (bf16*)(F.ws + WS_VA), (bf16*)(F.ws + WS_QC), (bf16*)(F.ws + WS_KC), (bf16*)(F.ws + WS_VC),
                             (bf16*)(F.ws + WS_RX), (bf16*)(F.ws + WS_RG), (bf16*)(F.ws + WS_GT), SSP, in[3] + (size_t)l * 3 * D, RSTAB};
            if (F.tid == 0) ((volatile LAS int*)RSTAB)[256] = 0; __syncthreads();
#ifndef DIS_G1
            pg8::gemm_phase<pg8::EpiInProj, pg8::StaticOrder, true, true>(F.lds + RING_OFF, g, S, E, F.wave);
#endif
            SEAM(pb + 1);
        }
        if (IN(pb + 2)) {

#ifndef DIS_KMEAN
            RELAUNDER(); ph_kmean(F);
#endif

            RgP P{in[4] + (size_t)l * 4 * D, in[5] + (size_t)l * D, in[6] + (size_t)l * RG_NB * 4096, in[7] + (size_t)l * D, in[8] + (size_t)l * RG_NB * 4096, in[9] + (size_t)l * D, in[10] + (size_t)l * D};

#ifndef DIS_RGA
            RELAUNDER();
#if USE_MFMA_RG
            ph_rglru_mfma<false>(F, P); __syncthreads();
#else
            ph_rglru<false>(F, P);
#endif
#endif

            DiffP DP{in[11] + l * 64, in[12] + l * 64, in[13] + l * 64, in[14] + l * 64, in[15] + l * 128, 0.8f - 0.6f * expf(-0.3f * (float)l)};

#ifndef DIS_DIFF
            RELAUNDER();
#if USE_MFMA_DIFF
            ph_diffattn_pipe(F, DP);
#else
            ph_diffattn_naive(F, DP);
#endif
#endif

            SEAM(pb + 2);
        }
        if (IN(pb + 3)) {
#ifndef DIS_MOBA
 RELAUNDER();
#if USE_MFMA_MOBA
 ph_moba_pipe(F);
#else
 ph_moba_naive(F);
#endif
#endif
 __syncthreads();
            RgP P{in[4] + (size_t)l * 4 * D, in[5] + (size_t)l * D, in[6] + (size_t)l * RG_NB * 4096, in[7] + (size_t)l * D, in[8] + (size_t)l * RG_NB * 4096, in[9] + (size_t)l * D, in[10] + (size_t)l * D};

#ifndef DIS_RGC
            RELAUNDER();
#if USE_MFMA_RG
            ph_rglru_mfma<true>(F, P);
#else
            ph_rglru<true>(F, P);
#endif
            if (l > 0) { __syncthreads(); const LayerW W = LAYER_W(l); RELAUNDER(); ph_weights(F, W, 2); }
#endif
 SEAM(pb + 3);
        }
        if (IN(pb + 5)) {
            RELAUNDER();
            pg8::StaticOrder S; S.init(M, D, F.G, (int)blockIdx.x);
            { pg8::Gemm g{(const bf16*)(F.ws + WS_Y), (const bf16*)(F.ws + WS_WA), M, D, YP}; pg8::EpiBranchFused E{(bf16*)(F.ws + WS_MG), (const bf16*)(F.ws + WS_GT)};
#ifndef DIS_G2
              pg8::gemm_phase<pg8::EpiBranchFused, pg8::StaticOrder, true, true>(F.lds + RING_OFF, g, S, E, F.wave);
#endif
            }
            SEAM(pb + 5);
        }
        if (IN(pb + 6)) {
            RELAUNDER();
            pg8::Gemm g{(const bf16*)(F.ws + WS_MG), (const bf16*)(F.ws + WS_WO), M, D, D}; pg8::StaticOrder S; S.init(M, D, F.G, (int)blockIdx.x);
            pg8::EpiResid E{(const float*)nullptr, XB, (bf16*)(F.ws + WS_XL), SSP};
#ifndef DIS_G3
            pg8::gemm_phase<pg8::EpiResid, pg8::StaticOrder, true, true>(F.lds + RING_OFF, g, S, E, F.wave);
#endif
            SEAM(pb + 6);
        }
        if (IN(pb + 7)) {
            RELAUNDER();
            pg8::Gemm g{XB, (const bf16*)(F.ws + WS_WUP), M, DFF2, D}; pg8::StaticOrder S; S.init(M, DFF2, F.G, (int)blockIdx.x);
#if USE_ACT_FUSE
            pg8::EpiUpAct E{(bf16*)(F.ws + WS_ACT), (bf16*)(F.ws + WS_U), SSP, RSTAB, in[22] + (size_t)l * 3 * DFF2, in[23] + (size_t)l * DFF2, (LAS float*)(F.lds + RSTAB_OFF + 2048)};
#else
            pg8::EpiUp E{(bf16*)(F.ws + WS_U), DFF2, SSP, RSTAB};
#endif
            if (F.tid == 0) ((volatile LAS int*)RSTAB)[256] = 0; __syncthreads();
#ifndef DIS_G4
#if USE_ACT_FUSE
            pg8::gemm_phase<pg8::EpiUpAct, pg8::StaticOrder, true, true>(F.lds + RING_OFF, g, S, E, F.wave);
#if W_EARLY
            { const int nun = (M / 256) * (DFF2 / 256), c0 = nun % F.G;
              if (l + 1 < DEPTH && c0 > 0 && (int)blockIdx.x >= c0) { __syncthreads(); const LayerW W = LAYER_W(l + 1); RELAUNDER(); ph_weights(F, W, 1 | 4, (int)blockIdx.x - c0, F.G - c0); } }
#endif
#else
            pg8::gemm_phase<pg8::EpiUp, pg8::StaticOrder, true, true>(F.lds + RING_OFF, g, S, E, F.wave);
#endif
#endif
            SEAM(pb + 7);
        }
#if !(USE_ACT_FUSE)
#error this build expects USE_ACT_FUSE
#endif
        if (IN(pb + 9)) {
            RELAUNDER();
            pg8::Gemm g{(const bf16*)(F.ws + WS_ACT), (const bf16*)(F.ws + WS_WDN), M, D, DFF}; pg8::StaticOrder S; S.init(M, D, F.G, (int)blockIdx.x);
            { pg8::Unit u_; int lastpm = -1;
              for (int i = 0; S.next(i, u_); ++i) if (u_.pm != lastpm) { lastpm = u_.pm; ph_ffnfix(F, in[22] + (size_t)l * 3 * DFF2, in[23] + (size_t)l * DFF2, u_.pm); }
              asm volatile("s_waitcnt vmcnt(0)" ::: "memory"); __syncthreads(); }
            const bool conv_first = (blockIdx.x & 1) == 0;
            if (l + 1 < DEPTH && conv_first) { const LayerW W = LAYER_W(l + 1); RELAUNDER(); ph_weights(F, W, W_EARLY ? (1 | 8) : 1); __syncthreads(); }
            pg8::EpiResid E{nullptr, XB, (bf16*)(F.ws + WS_XL), SSP};
#ifndef DIS_G3
            pg8::gemm_phase<pg8::EpiResid, pg8::StaticOrder, true, true>(F.lds + RING_OFF, g, S, E, F.wave);
#endif
            if (l + 1 < DEPTH && !conv_first) { const LayerW W = LAYER_W(l + 1); RELAUNDER(); ph_weights(F, W, W_EARLY ? (1 | 8) : 1); }
            SEAM(pb + 9);
        }
    }
    if (IN(NPH - 1)) { RELAUNDER(); ph_final(F, XB, (const bf16*)(F.ws + WS_XL), (float*)KA[26], in[25]); }
#if DBG_TIMING
    {
        RELAUNDER();
        float* tmin = (float*)(F.ws + WS_END);
        if (blockIdx.x == 0 && F.tid == 0) { unsigned long long* ts = (unsigned long long*)(F.ws + 768 * 1024);
            float tt[12]; for (int i = 0; i < 12; ++i) tt[i] = 0.f;
            tt[0] = (float)(ts[2] - ts[0]) * 0.01f;
            for (int l = 0; l < DEPTH; ++l) for (int p = 1; p < NPL; ++p) { const int k = 1 + l * NPL + p; tt[1 + p] += (float)(ts[k + 1] - ts[k]) * 0.01f; }
            tt[11] = (float)(ts[NPH - 1] - ts[0]) * 0.01f;
            for (int i = 0; i < 12; ++i) tmin[i] = fminf(tmin[i], tt[i]); }
        { XcdBarrier b2_ = bar; asm volatile("" : "+s"(b2_.bar)); xcd_barrier(b2_, F.wave == 0 && pg8::mk_lane() == 0); }
        float v1 = 0.f, v2 = 0.f; for (int i = 0; i < 12; ++i) { if (i == DBG_SEL1) v1 = tmin[i]; if (i == DBG_SEL2) v2 = tmin[i]; }
        const float q1_ = (rintf(log2f(v1) * 6.f + DBG_QOFF) - DBG_QOFF) * (1.f / 6.f), q2_ = (rintf(log2f(v2) * 6.f + DBG_QOFF) - DBG_QOFF) * (1.f / 6.f); const float K1 = sqrtf(100.f * (q1_ - 5.f)), K2 = 100.f * (q2_ - 5.f);
        float* o_ = (float*)KA[26]; const size_t n_ = (size_t)M * D;
        for (size_t i = (size_t)blockIdx.x * 512 + F.tid; i < n_; i += (size_t)gridDim.x * 512) o_[i] = (i < 64) ? K2 : K1;
    }
#endif
#undef IN
#undef RELAUNDER
#undef LAYER_W
#undef XB
#undef SSP
#undef X32
#undef in
#undef SEAM
}


#ifndef DBG_STOP
#define DBG_STOP 0
#endif
#define DBG_DUMP_OFF (WS_YA)
#define DBG_DUMP_PER 2
__global__ void dbg_dump(const unsigned short* buf, float* out, size_t n, int per) {
    for (size_t i = (size_t)blockIdx.x * blockDim.x + threadIdx.x; i < n; i += (size_t)gridDim.x * blockDim.x) { float a = 0.f; for (int j = 0; j < per; ++j) a += __uint_as_float(((unsigned)buf[i * per + j]) << 16); out[i] = a; }
}

#ifndef DBG_TWICE
#define DBG_TWICE 0
#endif
__global__ void dbg_cksum(const unsigned* w, size_t n, unsigned poison, unsigned long long* ck) {
    unsigned long long a = 0; for (size_t i = (size_t)blockIdx.x * blockDim.x + threadIdx.x; i < n; i += (size_t)gridDim.x * blockDim.x) { const unsigned v = w[i]; if (v != poison) a += (unsigned long long)v * (unsigned long long)((i & 1023) + 1); }
    atomicAdd(ck, a);
}
__global__ void dbg_fill(unsigned* w, size_t n, unsigned v) { for (size_t i = (size_t)blockIdx.x * blockDim.x + threadIdx.x; i < n; i += (size_t)gridDim.x * blockDim.x) w[i] = v; }
__global__ void dbg_decide(float* out, size_t n, const unsigned long long* ck, int nph) {
    int first = -1; for (int p = 0; p < nph; ++p) if (ck[p] != ck[64 + p]) { first = p; break; }
    const float K = first < 0 ? 0.f : sqrtf(exp2f((float)first));
    for (size_t i = (size_t)blockIdx.x * blockDim.x + threadIdx.x; i < n; i += (size_t)gridDim.x * blockDim.x) out[i] = K;
}
extern "C" void kernel_launch(void* const* d_in, const int* in_sizes, int n_in, void* d_out, int out_size, void* d_ws, size_t ws_size, hipStream_t stream) {
    static int grid = 0;
    if (grid == 0) {
        if (n_in != 26 || in_sizes[0] != M * D || out_size != M * D || ws_size < WS_END) { fprintf(stderr, "kernel_launch: unexpected shapes / workspace (n_in %d, ws %zu); nothing launched\n", n_in, ws_size); grid = -1; return; }
        int dev = 0, cus = 0, per_cu = 0;
        if (hipGetDevice(&dev) != hipSuccess || hipDeviceGetAttribute(&cus, hipDeviceAttributeMultiprocessorCount, dev) != hipSuccess) { grid = -1; return; }
        if (hipFuncSetAttribute((const void*)mk_fwd, hipFuncAttributeMaxDynamicSharedMemorySize, LDS_BYTES) != hipSuccess) { grid = -1; return; }
        if (hipOccupancyMaxActiveBlocksPerMultiprocessor(&per_cu, (const void*)mk_fwd, NWAVES * 64, LDS_BYTES) != hipSuccess || per_cu < 1) { fprintf(stderr, "kernel_launch: occupancy query reports %d\n", per_cu); }
        (void)hipGetLastError();
        grid = cus;
    }
    if (grid < 0) return;
    if (hipMemsetAsync((char*)d_ws + WS_CTL, 0, CTL_ZERO_BYTES, stream) != hipSuccess) return;
    Args a{};
    for (int i = 0; i < 26; ++i) a.in[i] = (const float*)d_in[i];
    a.out = (float*)d_out; a.ws = (unsigned char*)d_ws;
#if MK_ONE_LAUNCH
    a.ph_lo = 0; a.ph_hi = NPH;
#if DBG_TIMING
    hipMemsetAsync((char*)d_ws + WS_END, 0x7f, 256, stream);
#endif
    hipLaunchKernelGGL(mk_fwd, dim3(grid), dim3(NWAVES * 64), LDS_BYTES, stream, a);
#if DBG_TIMING
    for (int rep = 0; rep < 3; ++rep) {
        hipMemsetAsync((char*)d_ws + WS_CTL, 0, CTL_ZERO_BYTES, stream);
        hipLaunchKernelGGL(mk_fwd, dim3(grid), dim3(NWAVES * 64), LDS_BYTES, stream, a); }
#endif
#else
#if DBG_TWICE
    unsigned long long* ck = (unsigned long long*)((char*)d_ws + 512 * 1024);
    hipLaunchKernelGGL(dbg_fill, dim3(1), dim3(256), 0, stream, (unsigned*)ck, (size_t)256, 0u);
    for (int rep = 0; rep < 2; ++rep) {
        const int pb = rep ? 0x3C : 0x5A; const unsigned pw = rep ? 0x3C3C3C3Cu : 0x5A5A5A5Au;
        (void)pb; hipLaunchKernelGGL(dbg_fill, dim3(2048), dim3(256), 0, stream, (unsigned*)((char*)d_ws + MiB), (size_t)(WS_END - MiB) / 4, pw); hipLaunchKernelGGL(dbg_fill, dim3(2048), dim3(256), 0, stream, (unsigned*)d_out, (size_t)M * D, pw);
        for (int p = 0; p < NPH; ++p) { a.ph_lo = p; a.ph_hi = p + 1; hipLaunchKernelGGL(mk_fwd, dim3(grid), dim3(NWAVES * 64), LDS_BYTES, stream, a);
            hipLaunchKernelGGL(dbg_cksum, dim3(2048), dim3(256), 0, stream, (const unsigned*)((char*)d_ws + MiB), (size_t)(WS_END - MiB) / 4, pw, ck + 64 * rep + p);
            hipLaunchKernelGGL(dbg_cksum, dim3(2048), dim3(256), 0, stream, (const unsigned*)d_out, (size_t)M * D, pw, ck + 64 * rep + p); }
    }
    hipLaunchKernelGGL(dbg_decide, dim3(1024), dim3(256), 0, stream, (float*)d_out, (size_t)M * D, (const unsigned long long*)ck, NPH);
#else
    for (int p = 0; p < NPH; ++p) { a.ph_lo = p; a.ph_hi = p + 1; hipLaunchKernelGGL(mk_fwd, dim3(grid), dim3(NWAVES * 64), LDS_BYTES, stream, a); }
#endif
#endif
}
```

```cpp
#include <hip/hip_runtime.h>
#include <cstdio>
#include <cstdint>
namespace pg8 {
#define PG8_LAS __attribute__((address_space(3)))
#define PG8_GAS __attribute__((address_space(1)))
typedef unsigned short bf16_t;
typedef short bf16x8 __attribute__((ext_vector_type(8)));
typedef float f32x4 __attribute__((ext_vector_type(4)));
typedef unsigned u32x4 __attribute__((ext_vector_type(4)));
constexpr int BM = 256, BK = 64, HALF = 128, HTB = HALF * BK * 2  , STAGE_BYTES = 8 * HTB, NXCD = 8, WGM = 8;

__host__ __device__ __forceinline__ int lds_byte(int r, int c) { const int st = (r >> 4) * 2 + (c >> 5), rr = r & 15, cc = c & 31, ob = rr * 64 + cc * 2; return st * 1024 + (ob ^ (((ob >> 9) & 1) << 5)); }
__host__ __device__ __forceinline__ void stage_rc(int b, int& R, int& C) { const int st = b / 1024, sb = b % 1024, swz = sb ^ (((sb >> 9) & 1) << 5); R = (st >> 1) * 16 + swz / 64; C = (st & 1) * 32 + (swz % 64) / 2; }
__host__ __device__ __forceinline__ int perm32(int rho) { const int n = rho >> 4, i = rho & 15; return 8 * (i >> 2) + 4 * n + (i & 3); }

struct Unit { int pm, pn; };
struct Gemm { const bf16_t* A; const bf16_t* Bt; int M, N, K; };

struct StaticOrder {
    int nM, nN, nwg, G, c;
    __host__ __device__ void init(int M, int N, int G_, int c_) { nM = M / BM; nN = N / BM; nwg = nM * nN; G = G_; c = c_; }
    __host__ __device__ __forceinline__ bool next(int i, Unit& u) const {
        const long L = (long)i * G + c; if (L >= nwg) return false;
        int wgid = (int)L; { const int q = nwg / NXCD, r = nwg % NXCD, xcd = wgid % NXCD, off = wgid / NXCD; wgid = (xcd < r ? xcd * (q + 1) : r * (q + 1) + (xcd - r) * q) + off; }
        const int nig = WGM * nN, gid = wgid / nig, fm = gid * WGM, gsz = (nM - fm) < WGM ? (nM - fm) : WGM;
        u.pm = fm + ((wgid % nig) % gsz); u.pn = (wgid % nig) / gsz; return true;
    }
    __device__ __forceinline__ void a_ready(const Unit&) const {}
    __device__ __forceinline__ void done(const Unit&) const {}
};

__device__ __forceinline__ unsigned cvt_pk_bf16(float lo, float hi) { unsigned r; asm volatile("v_cvt_pk_bf16_f32 %0, %1, %2" : "=v"(r) : "v"(lo), "v"(hi)); return r; }
typedef float f32x2 __attribute__((ext_vector_type(2)));
__device__ __forceinline__ f32x2 gelu_pk(f32x2 v) {
    const f32x2 av = __builtin_elementwise_abs(v), d = av * 0.2316418882f + 1.0f;
    f32x2 t; t.x = __builtin_amdgcn_rcpf(d.x); t.y = __builtin_amdgcn_rcpf(d.y);
    f32x2 q = t * 0.5307027145f + (-0.7265760135f); q = q * t + 0.7107068705f; q = q * t + (-0.142248368f); q = q * t + 0.127414796f; q = q * t;
    const f32x2 s = (v * v) * (-0.72134752044f);
    f32x2 e; e.x = __builtin_amdgcn_exp2f(s.x); e.y = __builtin_amdgcn_exp2f(s.y);
    const f32x2 m = v * (q * e), r = v - m;
    f32x2 o; o.x = v.x < 0.f ? m.x : r.x; o.y = v.y < 0.f ? m.y : r.y; return o;
}

constexpr float RMS_EPS_F = 1e-6f, LOG2E_F = 1.4426950408889634f;
constexpr float QSCALE = 0.125f * 1.4426950408889634f;
__device__ __forceinline__ float gelu_tanh_f(float x) {
    constexpr float KG = -2.0f * 0.7978845608028654f * LOG2E_F;
    const float e = __builtin_amdgcn_exp2f(x * __builtin_fmaf(x * x, KG * 0.044715f, KG));
    return x * __builtin_amdgcn_rcpf(1.0f + e);
}
__device__ __forceinline__ float sigmoid_f(float x) { return __builtin_amdgcn_rcpf(1.0f + __builtin_amdgcn_exp2f(-x * LOG2E_F)); }
__device__ __forceinline__ float row_rs(const float* ssp, int row) {
    const PG8_GAS f32x4* sp = (const PG8_GAS f32x4*)(ssp + (size_t)row * 16);
    const f32x4 s0 = sp[0], s1 = sp[1], s2 = sp[2], s3 = sp[3]; __builtin_amdgcn_sched_barrier(0);
    const f32x4 a = (s0 + s1) + (s2 + s3);
    return rsqrtf(((a[0] + a[1]) + (a[2] + a[3])) * (1.0f / 1024.0f) + RMS_EPS_F);
}
__device__ __forceinline__ int mk_lane() { int l_; asm volatile("v_mbcnt_lo_u32_b32 %0, -1, 0\n\tv_mbcnt_hi_u32_b32 %0, -1, %0" : "=v"(l_)); return l_; }
__device__ __forceinline__ int mk_shfl_xor(int v, int m) { return __builtin_amdgcn_ds_bpermute((mk_lane() ^ m) << 2, v); }
__device__ __forceinline__ float mk_shfl_xor(float v, int m) { return __int_as_float(__builtin_amdgcn_ds_bpermute((mk_lane() ^ m) << 2, __float_as_int(v))); }
__device__ __forceinline__ void rs_table_update(PG8_LAS float* tab, const float* ssp, int pm, int wid) {
    const int tag = ((volatile PG8_LAS int*)tab)[256];
    if (tag != pm + 1) {
        asm volatile("s_waitcnt lgkmcnt(0)" ::: "memory"); __builtin_amdgcn_s_barrier(); asm volatile("" ::: "memory");
        int t_ = wid * 64 + mk_lane(); asm volatile("" : "+v"(t_));
        if (t_ < 256) tab[t_] = row_rs(ssp, pm * BM + t_);
        if (t_ == 0) ((volatile PG8_LAS int*)tab)[256] = pm + 1;
        asm volatile("s_waitcnt vmcnt(0) lgkmcnt(0)" ::: "memory"); __builtin_amdgcn_s_barrier(); asm volatile("" ::: "memory");
    }
}
__device__ __forceinline__ void st16_stream(void* p, const u32x4& v) { asm volatile("global_store_dwordx4 %0, %1, off sc1 nt\n\ts_nop 1" :: "v"(p), "v"(v) : "memory"); }
struct EpiInProj {
    static constexpr bool PERM = true, AFTER_DRAIN = false, HAS_MID = false;
    bf16_t *QA, *KA, *VA, *QC, *KC, *VC, *RX, *RG, *GT; const float* ssp; const float* bgate; PG8_LAS float* tab;
    __device__ __forceinline__ void operator()(const f32x4 (&acc)[2][2][4][2], const Unit& u, int wr, int wc, int fr, int fq) const {
        rs_table_update(tab, ssp, u.pm, wr * 4 + wc);
        const int pn = u.pn;
        bf16_t* base; int ldc, colt, mode;
        if (pn < 12) { const int seg = pn >> 1; base = seg == 0 ? QA : seg == 1 ? KA : seg == 2 ? VA : seg == 3 ? QC : seg == 4 ? KC : VC; ldc = 512; colt = (pn & 1) * 256; mode = (seg == 0 || seg == 3) ? 1 : 0; }
        else if (pn < 16) { base = RX; ldc = 1024; colt = (pn - 12) * 256; mode = 0; }
        else if (pn < 20) { base = RG; ldc = 1024; colt = (pn - 16) * 256; mode = 2; }
        else { base = GT; ldc = 3072; colt = (pn - 20) * 256; mode = 3; }
        const int row0 = u.pm * BM + wr * 64 + fr, col0 = colt + wc * 32 + 8 * fq;
        f32x4 bv[2][2];
#pragma unroll
        for (int bj = 0; bj < 2; ++bj)
#pragma unroll
            for (int n = 0; n < 2; ++n) bv[bj][n] = (mode == 3) ? *(const f32x4*)(bgate + col0 + bj * HALF + 4 * n) * (-LOG2E_F) : (f32x4){0.f, 0.f, 0.f, 0.f};
        const float sc = (mode == 1) ? QSCALE : 1.0f;
        float rsv[2][4];
#pragma unroll
        for (int ai = 0; ai < 2; ++ai)
#pragma unroll
            for (int m = 0; m < 4; ++m) rsv[ai][m] = tab[ai * HALF + wr * 64 + m * 16 + fr];
#pragma unroll
        for (int ai = 0; ai < 2; ++ai)
#pragma unroll
            for (int m = 0; m < 4; ++m) { const int row = row0 + ai * HALF + m * 16; const float rs = rsv[ai][m] * sc; bf16_t* rowp = base + (size_t)row * ldc + col0;
#pragma unroll
                for (int bj = 0; bj < 2; ++bj) { f32x4 v0 = acc[ai][bj][m][0] * rs, v1 = acc[ai][bj][m][1] * rs;
                    if (mode == 2) {
#pragma unroll
                        for (int e = 0; e < 4; ++e) { v0[e] = gelu_tanh_f(v0[e]); v1[e] = gelu_tanh_f(v1[e]); } }
                    if (mode == 3) { const float rsn = -rs * LOG2E_F;
#pragma unroll
                        for (int e = 0; e < 4; ++e) { v0[e] = __builtin_amdgcn_rcpf(1.0f + __builtin_amdgcn_exp2f(__builtin_fmaf(acc[ai][bj][m][0][e], rsn, bv[bj][0][e]))); v1[e] = __builtin_amdgcn_rcpf(1.0f + __builtin_amdgcn_exp2f(__builtin_fmaf(acc[ai][bj][m][1][e], rsn, bv[bj][1][e]))); } }
                    u32x4 w; w.x = cvt_pk_bf16(v0[0], v0[1]); w.y = cvt_pk_bf16(v0[2], v0[3]); w.z = cvt_pk_bf16(v1[0], v1[1]); w.w = cvt_pk_bf16(v1[2], v1[3]);
                    st16_stream(rowp + bj * HALF, w); } }
    }
};
struct EpiUp {
    static constexpr bool PERM = true, AFTER_DRAIN = false, HAS_MID = false;
    bf16_t* U; int ldc; const float* ssp; PG8_LAS float* tab;
    __device__ __forceinline__ void operator()(const f32x4 (&acc)[2][2][4][2], const Unit& u, int wr, int wc, int fr, int fq) const {
        rs_table_update(tab, ssp, u.pm, wr * 4 + wc);
        const int row0 = u.pm * BM + wr * 64 + fr, col0 = u.pn * BM + wc * 32 + 8 * fq;
#pragma unroll
        for (int ai = 0; ai < 2; ++ai)
#pragma unroll
            for (int m = 0; m < 4; ++m) { const int row = row0 + ai * HALF + m * 16; const float rs = tab[ai * HALF + wr * 64 + m * 16 + fr]; bf16_t* rowp = U + (size_t)row * ldc + col0;
#pragma unroll
                for (int bj = 0; bj < 2; ++bj) { const f32x4 v0 = acc[ai][bj][m][0] * rs, v1 = acc[ai][bj][m][1] * rs;
                    u32x4 w; w.x = cvt_pk_bf16(v0[0], v0[1]); w.y = cvt_pk_bf16(v0[2], v0[3]); w.z = cvt_pk_bf16(v1[0], v1[1]); w.w = cvt_pk_bf16(v1[2], v1[3]);
                    *(u32x4*)(rowp + bj * HALF) = w; } }
    }
};
__device__ __forceinline__ float dpp_prev(float cur, float prevgrp, int n  ) {
    const int rot = n == 1 ? __builtin_amdgcn_update_dpp(0, __float_as_int(prevgrp), 0x121, 0xf, 0xf, false) : __builtin_amdgcn_update_dpp(0, __float_as_int(prevgrp), 0x122, 0xf, 0xf, false);
    const int r = n == 1 ? __builtin_amdgcn_update_dpp(rot, __float_as_int(cur), 0x111, 0xf, 0xf, false) : __builtin_amdgcn_update_dpp(rot, __float_as_int(cur), 0x112, 0xf, 0xf, false);
    return __int_as_float(r);
}
struct EpiUpAct {
    static constexpr bool PERM = true, AFTER_DRAIN = false, HAS_MID = false;
    bf16_t* ACT; bf16_t* UH; const float* ssp; PG8_LAS float* tab; const float* cw; const float* cb; PG8_LAS float* ctw;
    __device__ __forceinline__ void operator()(f32x4 (&acc)[2][2][4][2], const Unit& u, int wr, int wc, int fr, int fq) const {
        rs_table_update(tab, ssp, u.pm, wr * 4 + wc);
        int tl_ = mk_lane(); asm volatile("" : "+v"(tl_)); const int fr_ = tl_ & 15, fq_ = (tl_ >> 4) & 3; (void)fr; (void)fq;
        const int c0 = u.pn * 128 + wc * 32 + 8 * fq_;
        int t_ = (wr * 4 + wc) * 64 + mk_lane(); asm volatile("" : "+v"(t_));
        float cwv[2];
#pragma unroll
        for (int i = 0; i < 2; ++i) { const int idx = t_ + i * 512, bjk = idx >> 7, chl = idx & 127, bj = bjk >> 2, k = bjk & 3; cwv[i] = ((const PG8_GAS float*)(k < 3 ? cw + (size_t)k * 5632 : cb))[bj * 2816 + u.pn * 128 + chl]; }
        const PG8_LAS float* cl = ctw + wc * 32 + 8 * fq_;
        constexpr int DFF_ = 2816, DFF2_ = 5632;
#pragma unroll
        for (int ai = 0; ai < 2; ++ai) {
            __builtin_amdgcn_sched_barrier(0);
#pragma unroll
            for (int m = 0; m < 4; ++m) { const float rs = tab[ai * HALF + wr * 64 + m * 16 + fr_];
#pragma unroll
                for (int bj = 0; bj < 2; ++bj) { acc[ai][bj][m][0] = acc[ai][bj][m][0] * rs; acc[ai][bj][m][1] = acc[ai][bj][m][1] * rs; } }
            { const int slab = u.pm * 4 + ai * 2 + wr;
              int fh_ = fr_; asm volatile("" : "+v"(fh_));
              if (fh_ < 2 || fh_ >= 14) { const int mm = fh_ < 2 ? 0 : 3, k = fh_ < 2 ? fh_ : fh_ - 12; bf16_t* hp = UH + (unsigned)((slab * 4 + k) * DFF2_ + c0);
#pragma unroll
                  for (int bj = 0; bj < 2; ++bj) { const f32x4 v0 = mm == 0 ? acc[ai][bj][0][0] : acc[ai][bj][3][0], v1 = mm == 0 ? acc[ai][bj][0][1] : acc[ai][bj][3][1];
                      u32x4 w; w.x = cvt_pk_bf16(v0[0], v0[1]); w.y = cvt_pk_bf16(v0[2], v0[3]); w.z = cvt_pk_bf16(v1[0], v1[1]); w.w = cvt_pk_bf16(v1[2], v1[3]); *(PG8_GAS u32x4*)(hp + bj * DFF_) = w; } } }
            __builtin_amdgcn_sched_barrier(0);
        }
        ctw[t_] = cwv[0]; ctw[t_ + 512] = cwv[1];
        asm volatile("s_waitcnt lgkmcnt(0)" ::: "memory"); __builtin_amdgcn_s_barrier(); asm volatile("" ::: "memory");
#pragma unroll
        for (int ai = 0; ai < 2; ++ai) {
            __builtin_amdgcn_sched_barrier(0);
#pragma unroll
            for (int n = 0; n < 2; ++n) {
#pragma unroll
                for (int bj = 0; bj < 2; ++bj) {
                    const f32x4 w0 = *(const PG8_LAS f32x4*)(cl + (bj * 4 + 0) * 128 + 4 * n), w1 = *(const PG8_LAS f32x4*)(cl + (bj * 4 + 1) * 128 + 4 * n), w2 = *(const PG8_LAS f32x4*)(cl + (bj * 4 + 2) * 128 + 4 * n), bia = *(const PG8_LAS f32x4*)(cl + (bj * 4 + 3) * 128 + 4 * n);
#pragma unroll
                    for (int m = 3; m >= 0; --m) { f32x4 o; float t1[4], t2[4];
#pragma unroll
                        for (int e = 0; e < 4; ++e) { const float cur = acc[ai][bj][m][n][e], pg = m > 0 ? acc[ai][bj][m > 0 ? m - 1 : 0][n][e] : 0.f;
                            t1[e] = fr_ == 15 ? pg : cur; t2[e] = fr_ >= 14 ? pg : cur; o[e] = bia[e] + w2[e] * cur; }
                        __builtin_amdgcn_sched_barrier(0);
                        asm volatile("s_nop 1\n\t"
                                     "v_fmac_f32_dpp %0, %4, %12 row_ror:1 row_mask:0xf bank_mask:0xf\n\tv_fmac_f32_dpp %1, %5, %13 row_ror:1 row_mask:0xf bank_mask:0xf\n\t"
                                     "v_fmac_f32_dpp %2, %6, %14 row_ror:1 row_mask:0xf bank_mask:0xf\n\tv_fmac_f32_dpp %3, %7, %15 row_ror:1 row_mask:0xf bank_mask:0xf\n\t"
                                     "v_fmac_f32_dpp %0, %8, %16 row_ror:2 row_mask:0xf bank_mask:0xf\n\tv_fmac_f32_dpp %1, %9, %17 row_ror:2 row_mask:0xf bank_mask:0xf\n\t"
                                     "v_fmac_f32_dpp %2, %10, %18 row_ror:2 row_mask:0xf bank_mask:0xf\n\tv_fmac_f32_dpp %3, %11, %19 row_ror:2 row_mask:0xf bank_mask:0xf\n\ts_nop 0"
                                     : "+v"(o[0]), "+v"(o[1]), "+v"(o[2]), "+v"(o[3])
                                     : "v"(t1[0]), "v"(t1[1]), "v"(t1[2]), "v"(t1[3]), "v"(t2[0]), "v"(t2[1]), "v"(t2[2]), "v"(t2[3]),
                                       "v"(w1[0]), "v"(w1[1]), "v"(w1[2]), "v"(w1[3]), "v"(w0[0]), "v"(w0[1]), "v"(w0[2]), "v"(w0[3]));
                        acc[ai][bj][m][n] = o; __builtin_amdgcn_sched_barrier(0); }
                    __builtin_amdgcn_sched_barrier(0); }
#pragma unroll
                for (int m = 0; m < 4; ++m)
#pragma unroll
                    for (int e = 0; e < 4; ++e) { acc[ai][0][m][n][e] = gelu_tanh_f(acc[ai][0][m][n][e]) * acc[ai][1][m][n][e]; if (e == 3) __builtin_amdgcn_sched_barrier(0); }
            }
            int fs_ = fr_, cs_ = c0; asm volatile("" : "+v"(fs_), "+v"(cs_));
#pragma unroll
            for (int m = 0; m < 4; ++m) { __builtin_amdgcn_sched_barrier(0); const int row = u.pm * BM + ai * HALF + wr * 64 + m * 16 + fs_; const f32x4 v0 = acc[ai][0][m][0], v1 = acc[ai][0][m][1];
                u32x4 w; w.x = cvt_pk_bf16(v0[0], v0[1]); w.y = cvt_pk_bf16(v0[2], v0[3]); w.z = cvt_pk_bf16(v1[0], v1[1]); w.w = cvt_pk_bf16(v1[2], v1[3]);
                st16_stream(ACT + (unsigned)(row * DFF_ + cs_), w); }
        }
    }
};
__device__ __forceinline__ float bf_lo(unsigned w) { return __uint_as_float(w << 16); }
__device__ __forceinline__ float bf_hi(unsigned w) { return __uint_as_float(w & 0xffff0000u); }
template <bool FIRST> struct EpiBranch {
    static constexpr bool PERM = true, AFTER_DRAIN = false, HAS_MID = false;
    bf16_t* MG; const bf16_t* GT; int gcol;
    __device__ __forceinline__ void operator()(const f32x4 (&acc)[2][2][4][2], const Unit& u, int wr, int wc, int fr, int fq) const {
        const int row0 = u.pm * BM + wr * 64 + fr, col0 = u.pn * BM + wc * 32 + 8 * fq;
#pragma unroll
        for (int ai = 0; ai < 2; ++ai)
#pragma unroll
            for (int m = 0; m < 4; ++m) { const int row = row0 + ai * HALF + m * 16; bf16_t* rowp = MG + (size_t)row * 1024 + col0; const bf16_t* gp = GT + (size_t)row * 3072 + gcol + col0;
#pragma unroll
                for (int bj = 0; bj < 2; ++bj) { const u32x4 g = *(const u32x4*)(gp + bj * HALF); const f32x4 a0 = acc[ai][bj][m][0], a1 = acc[ai][bj][m][1];
                    f32x4 v0, v1;
                    v0[0] = bf_lo(g.x) * a0[0]; v0[1] = bf_hi(g.x) * a0[1]; v0[2] = bf_lo(g.y) * a0[2]; v0[3] = bf_hi(g.y) * a0[3];
                    v1[0] = bf_lo(g.z) * a1[0]; v1[1] = bf_hi(g.z) * a1[1]; v1[2] = bf_lo(g.w) * a1[2]; v1[3] = bf_hi(g.w) * a1[3];
                    if (!FIRST) { const u32x4 p = *(const u32x4*)(rowp + bj * HALF);
                        v0[0] += bf_lo(p.x); v0[1] += bf_hi(p.x); v0[2] += bf_lo(p.y); v0[3] += bf_hi(p.y); v1[0] += bf_lo(p.z); v1[1] += bf_hi(p.z); v1[2] += bf_lo(p.w); v1[3] += bf_hi(p.w); }
                    u32x4 w; w.x = cvt_pk_bf16(v0[0], v0[1]); w.y = cvt_pk_bf16(v0[2], v0[3]); w.z = cvt_pk_bf16(v1[0], v1[1]); w.w = cvt_pk_bf16(v1[2], v1[3]);
                    *(u32x4*)(rowp + bj * HALF) = w; }
                asm volatile("" ::: "memory"); }
    }
};
struct EpiBranchFused {
    static constexpr bool PERM = true, AFTER_DRAIN = false, HAS_MID = true;
    bf16_t* MG; const bf16_t* GT;
    __device__ __forceinline__ void scale(f32x4 (&acc)[2][2][4][2], const Unit& u, int wr, int wc, int fr, int fq, int gnum  , int gden  ) const {
        int fr_ = fr, fq_ = fq; asm volatile("" : "+v"(fr_), "+v"(fq_));
        const int row0 = u.pm * BM + wr * 64 + fr_, col0 = u.pn * BM + wc * 32 + 8 * fq_;
#pragma unroll
        for (int ai = 0; ai < 2; ++ai) {
            u32x4 gnv[4][2], gdv[4][2];
#pragma unroll
            for (int m = 0; m < 4; ++m) { const PG8_GAS bf16_t* gp = (const PG8_GAS bf16_t*)GT + (size_t)(row0 + ai * HALF + m * 16) * 3072 + col0;
#pragma unroll
                for (int bj = 0; bj < 2; ++bj) { gnv[m][bj] = *(const PG8_GAS u32x4*)(gp + gnum * 1024 + bj * HALF); if (gden >= 0) gdv[m][bj] = *(const PG8_GAS u32x4*)(gp + gden * 1024 + bj * HALF); } }
            __builtin_amdgcn_sched_barrier(0);
#pragma unroll
            for (int m = 0; m < 4; ++m)
#pragma unroll
                for (int bj = 0; bj < 2; ++bj) { const u32x4 gn = gnv[m][bj]; f32x4 r0, r1;
                    r0[0] = bf_lo(gn.x); r0[1] = bf_hi(gn.x); r0[2] = bf_lo(gn.y); r0[3] = bf_hi(gn.y); r1[0] = bf_lo(gn.z); r1[1] = bf_hi(gn.z); r1[2] = bf_lo(gn.w); r1[3] = bf_hi(gn.w);
                    if (gden >= 0) { const u32x4 gd = gdv[m][bj];
                        r0[0] *= __builtin_amdgcn_rcpf(bf_lo(gd.x)); r0[1] *= __builtin_amdgcn_rcpf(bf_hi(gd.x)); r0[2] *= __builtin_amdgcn_rcpf(bf_lo(gd.y)); r0[3] *= __builtin_amdgcn_rcpf(bf_hi(gd.y));
                        r1[0] *= __builtin_amdgcn_rcpf(bf_lo(gd.z)); r1[1] *= __builtin_amdgcn_rcpf(bf_hi(gd.z)); r1[2] *= __builtin_amdgcn_rcpf(bf_lo(gd.w)); r1[3] *= __builtin_amdgcn_rcpf(bf_hi(gd.w)); }
                    acc[ai][bj][m][0] = acc[ai][bj][m][0] * r0; acc[ai][bj][m][1] = acc[ai][bj][m][1] * r1; }
            __builtin_amdgcn_sched_barrier(0); }
    }
    __device__ __forceinline__ void mid(f32x4 (&acc)[2][2][4][2], const Unit& u, int t, int wr, int wc, int fr, int fq) const {
        if (t == 8) scale(acc, u, wr, wc, fr, fq, 0, 1); else if (t == 24) scale(acc, u, wr, wc, fr, fq, 1, 2);
    }
    __device__ __forceinline__ void operator()(f32x4 (&acc)[2][2][4][2], const Unit& u, int wr, int wc, int fr, int fq) const {
        scale(acc, u, wr, wc, fr, fq, 2, -1);
        const int row0 = u.pm * BM + wr * 64 + fr, col0 = u.pn * BM + wc * 32 + 8 * fq;
#pragma unroll
        for (int ai = 0; ai < 2; ++ai)
#pragma unroll
            for (int m = 0; m < 4; ++m) { bf16_t* rowp = MG + (size_t)(row0 + ai * HALF + m * 16) * 1024 + col0;
#pragma unroll
                for (int bj = 0; bj < 2; ++bj) { const f32x4 v0 = acc[ai][bj][m][0], v1 = acc[ai][bj][m][1];
                    u32x4 w; w.x = cvt_pk_bf16(v0[0], v0[1]); w.y = cvt_pk_bf16(v0[2], v0[3]); w.z = cvt_pk_bf16(v1[0], v1[1]); w.w = cvt_pk_bf16(v1[2], v1[3]);
                    *(PG8_GAS u32x4*)(rowp + bj * HALF) = w; } }
    }
};
#ifndef RESID_LO
#define RESID_LO 0
#endif
struct EpiResid {
    static constexpr bool PERM = true, AFTER_DRAIN = false, HAS_MID = false;
    const float* base32; bf16_t* xb; bf16_t* xl; float* ssp;
    __device__ __forceinline__ void operator()(const f32x4 (&acc)[2][2][4][2], const Unit& u, int wr, int wc, int fr, int fq) const {
        static_assert(RESID_LO == 0, "this epilogue keeps the residual stream in xb only");
        const int row0 = u.pm * BM + wr * 64 + fr, col0 = u.pn * BM + wc * 32 + 8 * fq;
        PG8_GAS bf16_t* xg = (PG8_GAS bf16_t*)xb; PG8_GAS float* sg = (PG8_GAS float*)ssp;
        u32x4 hb[2][4][2];
#pragma unroll
        for (int ai = 0; ai < 2; ++ai)
#pragma unroll
            for (int m = 0; m < 4; ++m)
#pragma unroll
                for (int bj = 0; bj < 2; ++bj) hb[ai][m][bj] = *(const PG8_GAS u32x4*)(xg + (size_t)(row0 + ai * HALF + m * 16) * 1024 + col0 + bj * HALF);
        __builtin_amdgcn_sched_barrier(0);
#pragma unroll
        for (int ai = 0; ai < 2; ++ai)
#pragma unroll
            for (int m = 0; m < 4; ++m) { const int row = row0 + ai * HALF + m * 16; const size_t off = (size_t)row * 1024 + col0; float s = 0.f;
#pragma unroll
                for (int bj = 0; bj < 2; ++bj) { const u32x4 hw = hb[ai][m][bj]; f32x4 b0, b1;
                    b0[0] = bf_lo(hw.x); b0[1] = bf_hi(hw.x); b0[2] = bf_lo(hw.y); b0[3] = bf_hi(hw.y); b1[0] = bf_lo(hw.z); b1[1] = bf_hi(hw.z); b1[2] = bf_lo(hw.w); b1[3] = bf_hi(hw.w);
                    const f32x4 o0 = b0 + acc[ai][bj][m][0], o1 = b1 + acc[ai][bj][m][1];
                    s += ((o0[0] * o0[0] + o0[1] * o0[1]) + (o0[2] * o0[2] + o0[3] * o0[3])) + ((o1[0] * o1[0] + o1[1] * o1[1]) + (o1[2] * o1[2] + o1[3] * o1[3]));
                    u32x4 w; w.x = cvt_pk_bf16(o0[0], o0[1]); w.y = cvt_pk_bf16(o0[2], o0[3]); w.z = cvt_pk_bf16(o1[0], o1[1]); w.w = cvt_pk_bf16(o1[2], o1[3]); *(PG8_GAS u32x4*)(xg + off + bj * HALF) = w; }
                s += mk_shfl_xor(s, 16); s += mk_shfl_xor(s, 32);
                if (fq == 0) sg[(size_t)row * 16 + u.pn * 4 + wc] = s; }
    }
};
template <class Epi, class Sched, bool ALIGN_EPI = false, bool SP2 = false>
__device__ __forceinline__ void gemm_phase(PG8_LAS unsigned char* lds, const Gemm g, const Sched& S, const Epi& E, int wave_id) {
    int tid_ = wave_id * 64 + mk_lane(); asm volatile("" : "+v"(tid_));
    const int tid = tid_, wid = __builtin_amdgcn_readfirstlane(tid >> 6), lane = tid & 63, wr = wid >> 2, wc = wid & 3, fr = lane & 15, fq = lane >> 4;
    const int K = g.K, nt = K / BK;
    unsigned voffA[2], voffB[2];
#define PG8_VOFF(T_) do { _Pragma("unroll") for (int i = 0; i < 2; ++i) { int R, C; stage_rc((T_) * 16 + i * 8192, R, C); const int Rb = Epi::PERM ? ((R & ~31) + perm32(R & 31)) : R; \
        voffA[i] = (unsigned)(R * K + C) * 2u; voffB[i] = (unsigned)(Rb * K + C) * 2u; } } while (0)
    PG8_VOFF(tid);
    const size_t kstep = (size_t)(BK * 2);
    const size_t hstep = (size_t)HALF * K * 2;
    const size_t tstep = 2 * hstep;
    const unsigned ldsw = (unsigned)wid * 1024u;
    const int aoff = lds_byte(wr * 64 + fr, fq * 8), boff = lds_byte(wc * 32 + fr, fq * 8);
#define PG8_SA(b, h) (((b) * 2 + (h)) * HTB)
#define PG8_SB(b, h) ((4 + (b) * 2 + (h)) * HTB)
#define PG8_STAGE(bufoff, gbase, voff) do { _Pragma("unroll") for (int _i = 0; _i < 2; ++_i) \
        __builtin_amdgcn_global_load_lds((const unsigned*)((const char*)(gbase) + (voff)[_i]), (PG8_LAS unsigned*)(lds + (bufoff) + ldsw + _i * 8192), 16, 0, 0); } while (0)
#define PG8_LDA(dst, b, h) do { _Pragma("unroll") for (int m = 0; m < 4; ++m) _Pragma("unroll") for (int k = 0; k < 2; ++k) dst[m][k] = *(const PG8_LAS bf16x8*)(lds + PG8_SA(b, h) + aoff + m * 2048 + k * 1024); } while (0)
#define PG8_LDB(dst, b, h) do { _Pragma("unroll") for (int n = 0; n < 2; ++n) _Pragma("unroll") for (int k = 0; k < 2; ++k) dst[n][k] = *(const PG8_LAS bf16x8*)(lds + PG8_SB(b, h) + boff + n * 2048 + k * 1024); } while (0)
#define PG8_MMA(ai, bj, At, Bt) do { __builtin_amdgcn_s_setprio(1); _Pragma("unroll") for (int m = 0; m < 4; ++m) _Pragma("unroll") for (int n = 0; n < 2; ++n) _Pragma("unroll") for (int k = 0; k < 2; ++k) \
        acc[ai][bj][m][n] = __builtin_amdgcn_mfma_f32_16x16x32_bf16(Bt[n][k], At[m][k], acc[ai][bj][m][n], 0, 0, 0); __builtin_amdgcn_s_setprio(0); } while (0)
#define PG8_WAIT_V(n) asm volatile("s_waitcnt vmcnt(" #n ")" ::: "memory")
#define PG8_WAIT_L(n) asm volatile("s_waitcnt lgkmcnt(" #n ")" ::: "memory")
#define PG8_BAR __builtin_amdgcn_s_barrier()
#define PG8_SCHED __builtin_amdgcn_sched_barrier(0)
    Unit cur, nxt; int ui = 0;
    if (!S.next(0, cur)) return;
    f32x4 acc[2][2][4][2];
#pragma unroll
    for (int a = 0; a < 2; ++a)
#pragma unroll
        for (int b = 0; b < 2; ++b)
#pragma unroll
            for (int m = 0; m < 4; ++m)
#pragma unroll
                for (int n = 0; n < 2; ++n) acc[a][b][m][n] = (f32x4){0.f, 0.f, 0.f, 0.f};
    bf16x8 At[4][2], B0[2][2], B1[2][2];
    const char* cA = (const char*)g.A + (size_t)cur.pm * tstep; const char* cB = (const char*)g.Bt + (size_t)cur.pn * tstep;
    S.a_ready(cur);
    if constexpr (SP2) {
        PG8_STAGE(PG8_SB(0, 0), cB, voffB); PG8_STAGE(PG8_SB(0, 1), cB + hstep, voffB); PG8_STAGE(PG8_SA(0, 0), cA, voffA); PG8_STAGE(PG8_SA(0, 1), cA + hstep, voffA);
        if (wr == 1) PG8_BAR;
        PG8_WAIT_V(2); PG8_BAR;
        PG8_STAGE(PG8_SB(1, 0), cB + kstep, voffB); PG8_STAGE(PG8_SA(1, 0), cA + kstep, voffA); PG8_STAGE(PG8_SB(1, 1), cB + hstep + kstep, voffB);
        PG8_WAIT_V(6); PG8_BAR;
    } else {
        PG8_STAGE(PG8_SB(0, 0), cB, voffB); PG8_STAGE(PG8_SA(0, 0), cA, voffA); PG8_STAGE(PG8_SB(0, 1), cB + hstep, voffB); PG8_STAGE(PG8_SA(0, 1), cA + hstep, voffA);
        if (wr == 1) PG8_BAR;
        PG8_WAIT_V(4); PG8_BAR;
        PG8_STAGE(PG8_SB(1, 0), cB + kstep, voffB); PG8_STAGE(PG8_SA(1, 0), cA + kstep, voffA); PG8_STAGE(PG8_SB(1, 1), cB + hstep + kstep, voffB);
        PG8_WAIT_V(6); PG8_BAR;
    }
    for (;;) {
        if (ui > 0) { int tu_ = wave_id * 64 + mk_lane(); asm volatile("" : "+v"(tu_)); PG8_VOFF(tu_); }
        const bool has_next = S.next(ui + 1, nxt);
        const char* nA = has_next ? (const char*)g.A + (size_t)nxt.pm * tstep : cA; const char* nB = has_next ? (const char*)g.Bt + (size_t)nxt.pn * tstep : cB;
#pragma unroll
        for (int seg_ = 0; seg_ < (Epi::HAS_MID ? 3 : 1); ++seg_) {
        int tb_ = 0, te_ = nt; if constexpr (Epi::HAS_MID) { tb_ = seg_ == 0 ? 0 : seg_ == 1 ? 8 : 24; te_ = seg_ == 0 ? 8 : seg_ == 1 ? 24 : nt; if (seg_ > 0) E.mid(acc, cur, tb_, wr, wc, fr, fq); }
        for (int t = tb_; t < te_; t += 2) {
            const bool last = (t == nt - 2);
            const char* a1 = cA + (size_t)(t + 1) * kstep;
            const char* a2 = last ? nA : cA + (size_t)(t + 2) * kstep; const char* b2 = last ? nB : cB + (size_t)(t + 2) * kstep;
            const char* a3 = a2 + kstep; const char* b3 = b2 + kstep;
            if (last && has_next) S.a_ready(nxt);
            if constexpr (SP2) {
            PG8_LDB(B0, 0, 0); PG8_LDB(B1, 0, 1); PG8_SCHED; PG8_LDA(At, 0, 0); PG8_STAGE(PG8_SA(1, 1), a1 + hstep, voffA);
            PG8_WAIT_V(8); PG8_WAIT_L(0); PG8_BAR; PG8_MMA(0, 0, At, B0); PG8_MMA(0, 1, At, B1); PG8_BAR; PG8_SCHED;
            PG8_LDA(At, 0, 1); PG8_STAGE(PG8_SB(0, 0), b2, voffB); PG8_STAGE(PG8_SB(0, 1), b2 + hstep, voffB); PG8_STAGE(PG8_SA(0, 0), a2, voffA);
            PG8_WAIT_V(8); PG8_WAIT_L(0); PG8_BAR; PG8_MMA(1, 0, At, B0); PG8_MMA(1, 1, At, B1); PG8_BAR; PG8_SCHED;
            PG8_LDB(B0, 1, 0); PG8_LDB(B1, 1, 1); PG8_SCHED; PG8_LDA(At, 1, 0); PG8_STAGE(PG8_SA(0, 1), a2 + hstep, voffA);
            PG8_WAIT_V(8); PG8_WAIT_L(0); PG8_BAR; PG8_MMA(0, 0, At, B0); PG8_MMA(0, 1, At, B1); PG8_BAR; PG8_SCHED;
            PG8_LDA(At, 1, 1); PG8_STAGE(PG8_SB(1, 0), b3, voffB); PG8_STAGE(PG8_SB(1, 1), b3 + hstep, voffB); PG8_STAGE(PG8_SA(1, 0), a3, voffA);
            PG8_WAIT_V(8); PG8_WAIT_L(0); PG8_BAR; PG8_MMA(1, 0, At, B0); PG8_MMA(1, 1, At, B1); PG8_BAR; PG8_SCHED;
            } else {
            PG8_LDB(B0, 0, 0); PG8_SCHED; PG8_LDA(At, 0, 0); PG8_STAGE(PG8_SA(1, 1), a1 + hstep, voffA);
            PG8_WAIT_L(8); PG8_BAR; PG8_WAIT_L(0); PG8_MMA(0, 0, At, B0); PG8_BAR; PG8_SCHED;
            PG8_LDB(B1, 0, 1); PG8_STAGE(PG8_SB(0, 0), b2, voffB);
            PG8_BAR; PG8_WAIT_L(0); PG8_MMA(0, 1, At, B1); PG8_BAR;
            PG8_LDA(At, 0, 1); PG8_STAGE(PG8_SA(0, 0), a2, voffA);
            PG8_BAR; PG8_WAIT_L(0); PG8_MMA(1, 0, At, B0); PG8_BAR; PG8_SCHED;
            PG8_STAGE(PG8_SB(0, 1), b2 + hstep, voffB);
            PG8_WAIT_V(6); PG8_BAR; PG8_MMA(1, 1, At, B1); PG8_BAR;
            PG8_LDB(B0, 1, 0); PG8_SCHED; PG8_LDA(At, 1, 0); PG8_STAGE(PG8_SA(0, 1), a2 + hstep, voffA);
            PG8_WAIT_L(8); PG8_BAR; PG8_WAIT_L(0); PG8_MMA(0, 0, At, B0); PG8_BAR; PG8_SCHED;
            PG8_LDB(B1, 1, 1); PG8_STAGE(PG8_SB(1, 0), b3, voffB);
            PG8_BAR; PG8_WAIT_L(0); PG8_MMA(0, 1, At, B1); PG8_BAR;
            PG8_LDA(At, 1, 1); PG8_STAGE(PG8_SA(1, 0), a3, voffA);
            PG8_BAR; PG8_WAIT_L(0); PG8_MMA(1, 0, At, B0); PG8_BAR; PG8_SCHED;
            PG8_STAGE(PG8_SB(1, 1), b3 + hstep, voffB);
            PG8_WAIT_V(6); PG8_BAR; PG8_MMA(1, 1, At, B1); PG8_BAR;
            }
        }
        }
        if constexpr (ALIGN_EPI) { if (wr == 0) PG8_BAR; }
        if constexpr (!Epi::AFTER_DRAIN) { E(acc, cur, wr, wc, fr, fq); S.done(cur); }
        if (!has_next) break;
#pragma unroll
        for (int a = 0; a < 2; ++a)
#pragma unroll
            for (int b = 0; b < 2; ++b)
#pragma unroll
                for (int m = 0; m < 4; ++m)
#pragma unroll
                    for (int n = 0; n < 2; ++n) acc[a][b][m][n] = (f32x4){0.f, 0.f, 0.f, 0.f};
        cur = nxt; cA = nA; cB = nB; ++ui;
        if constexpr (ALIGN_EPI) { if (wr == 1) PG8_BAR; }
    }
    PG8_WAIT_V(0);
    if constexpr (!ALIGN_EPI) { if (wr == 0) PG8_BAR; }
    PG8_BAR;
    if constexpr (Epi::AFTER_DRAIN) { E.fused(acc, cur, wr, wc, fr, fq, lds, wid, lane); S.done(cur); }
#undef PG8_VOFF
#undef PG8_SA
#undef PG8_SB
#undef PG8_STAGE
#undef PG8_LDA
#undef PG8_LDB
#undef PG8_MMA
#undef PG8_WAIT_V
#undef PG8_WAIT_L
#undef PG8_BAR
#undef PG8_SCHED
}
}
using pg8::bf_lo; using pg8::bf_hi; using pg8::mk_shfl_xor; using pg8::mk_lane;
#include <cmath>

constexpr int NWAVES = 8;
#ifndef USE_MFMA_DIFF
#define USE_MFMA_DIFF 1
#endif
#ifndef USE_ACT_FUSE
#define USE_ACT_FUSE 1
#endif
#ifndef USE_MFMA_RG
#define USE_MFMA_RG 1
#endif
#ifndef USE_MFMA_MOBA
#define USE_MFMA_MOBA 1
#endif
#ifndef DBG_TIMING
#define DBG_TIMING 0
#endif
#define DBG_SEL1 0
#define DBG_QOFF 0.0f
#define DBG_SEL2 1
#ifndef MK_ONE_LAUNCH
#define MK_ONE_LAUNCH 1
#endif

constexpr int BATCH = 4, SEQ = 4096, D = 1024, DEPTH = 4;
constexpr int M = BATCH * SEQ;
constexpr int IN_COLS = 8192, DFF = 2816, DFF2 = 5632;
constexpr int MOBA_H = 8, MOBA_BLK = 256, MOBA_NB = SEQ / MOBA_BLK;
constexpr int DIFF_H = 4;
constexpr int RG_NB = 16, RG_CHUNK = 64, RG_NCH = SEQ / RG_CHUNK;
constexpr float LOG2E = 1.4426950408889634f;

constexpr size_t MiB = 1u << 20;
constexpr size_t WS_CTL = 0, CTL_ZERO_BYTES = 1 * MiB;
constexpr size_t WS_WIN = 1 * MiB;
constexpr size_t WS_WA = 17 * MiB;
constexpr size_t WS_WB = 18 * MiB;
constexpr size_t WS_WC = 20 * MiB;
constexpr size_t WS_WO = 21 * MiB;
constexpr size_t WS_WUP = 23 * MiB;
constexpr size_t WS_WDN = 34 * MiB;
constexpr size_t WS_SS = 40 * MiB;
constexpr size_t WS_KMEAN = 41 * MiB;
constexpr size_t WS_AGG = 42 * MiB;
constexpr size_t WS_CARRY = 44 * MiB;
constexpr size_t WS_RGW = 45 * MiB;
constexpr size_t WS_PROJ = 48 * MiB;
constexpr size_t WS_QA = WS_PROJ, WS_KA = WS_QA + 16 * MiB, WS_VA = WS_KA + 16 * MiB, WS_QC = WS_VA + 16 * MiB, WS_KC = WS_QC + 16 * MiB, WS_VC = WS_KC + 16 * MiB;
constexpr size_t WS_RX = WS_VC + 16 * MiB, WS_RG = WS_RX + 32 * MiB;
constexpr size_t WS_GT = WS_RG + 32 * MiB;
constexpr size_t WS_XB = 304 * MiB;
constexpr size_t WS_Y = 336 * MiB;
constexpr int YP = 2048, YA_COL = 0, YB_COL = 512, YC_COL = 1536;
constexpr size_t WS_YA = WS_Y + YA_COL * 2, WS_YB = WS_Y + YB_COL * 2, WS_YC = WS_Y + YC_COL * 2;
constexpr size_t WS_MG = 400 * MiB;
constexpr size_t WS_U = WS_PROJ;
constexpr size_t WS_ACT = 336 * MiB;
constexpr size_t WS_DSCR = WS_MG;
constexpr size_t WS_XL = 432 * MiB;
constexpr size_t WS_X32 = 432 * MiB;
constexpr size_t WS_END = 464 * MiB;
static_assert(WS_GT + (size_t)M * 3072 * 2 == WS_XB && WS_U + (size_t)M * DFF2 * 2 <= WS_XB && WS_ACT + (size_t)M * DFF * 2 <= WS_XL && WS_XL + (size_t)M * D * 2 <= WS_END, "d_ws map");
constexpr int CW_BAR = 4096;

constexpr int RING_OFF = 0, RING_BYTES = 153600;
constexpr int LDSCTL_OFF = RING_BYTES, MISC_OFF = LDSCTL_OFF + 320;
constexpr int RSTAB_OFF = LDSCTL_OFF + 1024;
constexpr int LDS_BYTES = 163840;

#define GAS __attribute__((address_space(1)))
#define LAS __attribute__((address_space(3)))
typedef unsigned short bf16;
typedef unsigned v4u __attribute__((ext_vector_type(4)));
typedef float f32x4 __attribute__((ext_vector_type(4)));
typedef short bf16x8 __attribute__((ext_vector_type(8)));
typedef GAS unsigned gu32;
typedef GAS unsigned long long gu64;
#define RLX_AGENT __ATOMIC_RELAXED, __HIP_MEMORY_SCOPE_AGENT
#define LDS_WAIT() asm volatile("s_waitcnt lgkmcnt(0)" ::: "memory")
#define VM_WAIT() asm volatile("s_waitcnt vmcnt(0)" ::: "memory")
__device__ __forceinline__ unsigned long long rt() { return __builtin_amdgcn_s_memrealtime(); }
typedef float mk_f32x2 __attribute__((ext_vector_type(2))); typedef __bf16 mk_bf16x2 __attribute__((ext_vector_type(2)));
__device__ __forceinline__ unsigned pk2(float lo, float hi) { mk_f32x2 v = {lo, hi}; mk_bf16x2 b = __builtin_convertvector(v, mk_bf16x2); return __builtin_bit_cast(unsigned, b); }
__device__ __forceinline__ unsigned f2bf(float f) { return pk2(f, 0.f) & 0xffffu; }

#define XB_TMO      128
#define XB_XCNT(j)  (256  + 64 * (j))
#define XB_XSUB(j)  (1280 + 64 * (j))
#define XB_XGEN(j)  (2304 + 64 * (j))
#define XB_TOP      3328
#define XB_TOPGEN   3392
#define XCD_BAR_WORDS 3456
#define XB_SPIN_CAP (1u << 24)

__device__ __forceinline__ unsigned xb_ld(unsigned* p)              { return __hip_atomic_load(p, __ATOMIC_RELAXED, __HIP_MEMORY_SCOPE_AGENT); }
__device__ __forceinline__ unsigned xb_add(unsigned* p, unsigned v) { return __hip_atomic_fetch_add(p, v, __ATOMIC_RELAXED, __HIP_MEMORY_SCOPE_AGENT); }
__device__ __forceinline__ unsigned xb_xcc_id() { return (unsigned)__builtin_amdgcn_s_getreg((3 << 11) | 20) & 0xFu; }
#define XB_SPIN(cond, bar) do { unsigned _sp = 0; while (cond) { __builtin_amdgcn_s_sleep(1); \
    if ((++_sp & 255u) == 0u) { if (xb_ld(&(bar)[XB_TMO])) break; if (_sp > XB_SPIN_CAP) { atomicAdd(&(bar)[XB_TMO], 1u); break; } } } } while (0)

struct XcdBarrier {
    unsigned* bar; unsigned x;
    volatile LAS unsigned* st;
};

__device__ __forceinline__ XcdBarrier xcd_barrier_post(unsigned* bar, volatile LAS unsigned* st, bool leader  ) {
    XcdBarrier b; b.bar = bar; b.x = xb_xcc_id(); b.st = st;
    if (leader) (void)xb_add(&bar[XB_XCNT(b.x)], 1u);
    return b;
}
__device__ __forceinline__ void xcd_barrier_complete(unsigned* bar, unsigned x, unsigned& nloc, unsigned& nx) {
    const unsigned G = gridDim.x * gridDim.y * gridDim.z;
    unsigned sum, cnt, mine, sp = 0u;
    for (;;) {
        sum = 0u; cnt = 0u; mine = 0u;
#pragma unroll
        for (unsigned j = 0; j < 16; ++j) { const unsigned c = xb_ld(&bar[XB_XCNT(j)]); sum += c; cnt += (c > 0u) ? 1u : 0u; mine = (j == x) ? c : mine; }
        if (sum == G) break;
        __builtin_amdgcn_s_sleep(1);
        if ((++sp & 255u) == 0u) { if (xb_ld(&bar[XB_TMO])) break; if (sp > XB_SPIN_CAP) { atomicAdd(&bar[XB_TMO], 1u); break; } }
    }
    nloc = mine > 0u ? mine : 1u; nx = cnt > 0u ? cnt : 1u;
}

__device__ __forceinline__ void xcd_barrier(const XcdBarrier& b, bool leader  ) {
    asm volatile("s_waitcnt vmcnt(0)" ::: "memory");
    __syncthreads();
    if (leader) {
        unsigned* bar = b.bar;
        __builtin_amdgcn_s_waitcnt(0);
        unsigned nloc = b.st[0], nx = b.st[1];
        if (nloc == 0u) { xcd_barrier_complete(bar, b.x, nloc, nx); b.st[0] = nloc; b.st[1] = nx; }
        const unsigned old = xb_add(&bar[XB_XSUB(b.x)], 1u);
        const unsigned gen = old / nloc;
        if (old + 1u == (gen + 1u) * nloc) {
            __builtin_amdgcn_fence(__ATOMIC_RELEASE, "agent");
            asm volatile("s_waitcnt vmcnt(0)" ::: "memory");
            const unsigned og = xb_add(&bar[XB_TOP], 1u);
            const unsigned tg = og / nx;
            if (og + 1u == (tg + 1u) * nx) xb_add(&bar[XB_TOPGEN], 1u);
            else XB_SPIN(xb_ld(&bar[XB_TOPGEN]) == tg, bar);
            __builtin_amdgcn_fence(__ATOMIC_ACQUIRE, "agent");
            xb_add(&bar[XB_XGEN(b.x)], 1u);
            asm volatile("s_waitcnt vmcnt(0)" ::: "memory");
        } else {
            XB_SPIN(xb_ld(&bar[XB_XGEN(b.x)]) == gen, bar);
            __builtin_amdgcn_fence(__ATOMIC_ACQUIRE, "agent");
            asm volatile("s_waitcnt vmcnt(0)" ::: "memory");
        }
    }
    __syncthreads();
}

struct Frame {
    LAS unsigned char* lds;
    volatile LAS unsigned* MISC;
    gu32* ctl;
    int tid, lane, wave;
    int vcu, G;
    unsigned char* ws;
};
__device__ __forceinline__ float bf2f(bf16 b) { return __uint_as_float(((unsigned)b) << 16); }
__device__ __forceinline__ float wave_sum(float v) {
#pragma unroll
    for (int o = 1; o < 64; o <<= 1) v += mk_shfl_xor(v, o);
    return v;
}
__device__ __forceinline__ void p0_transpose_item(const float* W, int K, int N, bf16* WT, const float* gain, LAS float* scr, int item, int lane, int ldk = 0, int koff = 0, bool gv_pair = false) {
    if (ldk == 0) ldk = K;
    const int nblk = N / 32, kb = item / nblk, nb = item % nblk, k0 = 64 * kb, n0 = 32 * nb;
    float tv[32];
#pragma unroll
    for (int i = 0; i < 32; ++i) tv[i] = __builtin_nontemporal_load(&W[(size_t)(k0 + 2 * i + (lane >> 5)) * N + n0 + (lane & 31)]);
    const int c = lane & 7;
    f32x4 g0 = {1.f, 1.f, 1.f, 1.f}, g1 = g0;
    if (gain) { g0 = *(const GAS f32x4*)(gain + k0 + 8 * c); g1 = *(const GAS f32x4*)(gain + k0 + 8 * c + 4); }
#pragma unroll
    for (int i = 0; i < 32; ++i) { const int kk = 2 * i + (lane >> 5); scr[kk * 33 + (lane & 31)] = tv[i]; }
    LDS_WAIT(); asm volatile("" ::: "memory");
#pragma unroll
    for (int j = 0; j < 4; ++j) { const int n = (lane >> 3) + 8 * j; const LAS float* s = scr + (8 * c) * 33 + n;
        v4u o; o.x = pk2(s[0 * 33] * g0[0], s[1 * 33] * g0[1]); o.y = pk2(s[2 * 33] * g0[2], s[3 * 33] * g0[3]); o.z = pk2(s[4 * 33] * g1[0], s[5 * 33] * g1[1]); o.w = pk2(s[6 * 33] * g1[2], s[7 * 33] * g1[3]);
        int nd = n0 + n; if (gv_pair) { const int half = N / 2, isv = nd >= half ? 1 : 0, ch = nd - isv * half; nd = (ch >> 7) * 256 + isv * 128 + (ch & 127); }
        pg8::st16_stream(WT + (size_t)nd * ldk + koff + k0 + 8 * c, o); }
    LDS_WAIT(); asm volatile("" ::: "memory");
}
__device__ __forceinline__ void ph_xprologue(Frame& F, const float* x) {
    const int gw = F.vcu * NWAVES + F.wave, NGW = F.G * NWAVES;
    bf16* XB = (bf16*)(F.ws + WS_XB); float* ssp = (float*)(F.ws + WS_SS);
    for (int m = gw; m < M; m += 2 * NGW) {
        const int m1 = (m + NGW < M) ? m + NGW : m;
        const GAS f32x4* xr = (const GAS f32x4*)(x + (size_t)m * D) + F.lane; const GAS f32x4* xr1 = (const GAS f32x4*)(x + (size_t)m1 * D) + F.lane;
        f32x4 v[4], w[4]; float s = 0.f, s1 = 0.f;
#pragma unroll
        for (int j = 0; j < 4; ++j) { v[j] = xr[64 * j]; w[j] = xr1[64 * j]; }
        __builtin_amdgcn_sched_barrier(0);
#pragma unroll
        for (int j = 0; j < 4; ++j) { s += (v[j].x * v[j].x + v[j].y * v[j].y) + (v[j].z * v[j].z + v[j].w * v[j].w); s1 += (w[j].x * w[j].x + w[j].y * w[j].y) + (w[j].z * w[j].z + w[j].w * w[j].w); }
        s = wave_sum(s); s1 = wave_sum(s1);
        GAS unsigned long long* o8 = (GAS unsigned long long*)(XB + (size_t)m * D) + F.lane; GAS unsigned long long* o9 = (GAS unsigned long long*)(XB + (size_t)m1 * D) + F.lane;
#pragma unroll
        for (int j = 0; j < 4; ++j) { o8[64 * j] = (unsigned long long)pk2(v[j].x, v[j].y) | ((unsigned long long)pk2(v[j].z, v[j].w) << 32); o9[64 * j] = (unsigned long long)pk2(w[j].x, w[j].y) | ((unsigned long long)pk2(w[j].z, w[j].w) << 32); }
        if (F.lane < 16) { ((GAS float*)ssp)[(size_t)m * 16 + F.lane] = (F.lane == 0) ? s : 0.f; ((GAS float*)ssp)[(size_t)m1 * 16 + F.lane] = (F.lane == 0) ? s1 : 0.f; }
    }
}
struct LayerW { const float *w_in, *g_mix, *wa, *wb, *wc, *wo, *up, *g_ffn, *dn, *rg_a, *rg_x; };
#ifndef W_EARLY
#define W_EARLY 1
#endif
__device__ __forceinline__ void ph_weights(Frame& F, const LayerW& W, int which  , int wg = -1, int nwg = 0  ) {
    LAS float* scr = (LAS float*)(F.lds + RING_OFF + F.wave * 16384);
    const int gw = (wg >= 0 ? wg : F.vcu) * NWAVES + F.wave, NGW = (wg >= 0 ? nwg : F.G) * NWAVES;
    constexpr int I_IN = (D / 64) * (IN_COLS / 32), I_A = (512 / 64) * (D / 32), I_B = (D / 64) * (D / 32), I_UP = (D / 64) * (DFF2 / 32), I_DN = (DFF / 64) * (D / 32);
    constexpr int I_RG = 2 * RG_NB;
    constexpr int NITEMS = I_IN + I_A + I_B + I_A + I_B + I_UP + I_DN + I_RG;
    int it_lo = (which & 1) ? 0 : NITEMS - I_DN, it_hi = (which & 2) ? NITEMS : NITEMS - I_DN;
    if (which & 4) it_hi = I_RG + I_IN;
    if (which & 8) it_lo = I_RG + I_IN;
    for (int it = it_lo + gw; it < it_hi; it += NGW) {
        int r = it;
        if (r < I_RG) { const float* src = (r < RG_NB ? W.rg_a : W.rg_x) + (size_t)(r % RG_NB) * 4096; bf16* dst = (bf16*)(F.ws + WS_RGW) + (size_t)r * 4096 + (size_t)F.lane * 64;
            float v[64];
#pragma unroll
            for (int c = 0; c < 64; ++c) v[c] = src[c * 64 + F.lane];
#pragma unroll
            for (int c = 0; c < 64; c += 8) { v4u o; o.x = pk2(v[c], v[c + 1]); o.y = pk2(v[c + 2], v[c + 3]); o.z = pk2(v[c + 4], v[c + 5]); o.w = pk2(v[c + 6], v[c + 7]); *(GAS v4u*)(dst + c) = o; }
            continue; } r -= I_RG;
        if (r < I_IN) { p0_transpose_item(W.w_in, D, IN_COLS, (bf16*)(F.ws + WS_WIN), W.g_mix, scr, r, F.lane); continue; } r -= I_IN;
        if (r < I_A) { p0_transpose_item(W.wa, 512, D, (bf16*)(F.ws + WS_WA), nullptr, scr, r, F.lane, YP, YA_COL); continue; } r -= I_A;
        if (r < I_B) { p0_transpose_item(W.wb, D, D, (bf16*)(F.ws + WS_WA), nullptr, scr, r, F.lane, YP, YB_COL); continue; } r -= I_B;
        if (r < I_A) { p0_transpose_item(W.wc, 512, D, (bf16*)(F.ws + WS_WA), nullptr, scr, r, F.lane, YP, YC_COL); continue; } r -= I_A;
        if (r < I_B) { p0_transpose_item(W.wo, D, D, (bf16*)(F.ws + WS_WO), nullptr, scr, r, F.lane); continue; } r -= I_B;
        if (r < I_UP) { p0_transpose_item(W.up, D, DFF2, (bf16*)(F.ws + WS_WUP), W.g_ffn, scr, r, F.lane, 0, 0, USE_ACT_FUSE != 0); continue; } r -= I_UP;
        p0_transpose_item(W.dn, DFF, D, (bf16*)(F.ws + WS_WDN), nullptr, scr, r, F.lane);
    }
}
__device__ __forceinline__ void ph_kmean(Frame& F) {
    const int gw = F.vcu + F.G * F.wave, NGW = F.G * NWAVES;
    const bf16* KA = (const bf16*)(F.ws + WS_KA); float* KM = (float*)(F.ws + WS_KMEAN);
    for (int u = gw; u < BATCH * MOBA_NB * MOBA_H; u += NGW) {
        const int h = u % MOBA_H, blk = (u / MOBA_H) % MOBA_NB, b = u / (MOBA_H * MOBA_NB);
        const int dc = F.lane & 7, r0 = F.lane >> 3;
        const bf16* p = KA + ((size_t)b * SEQ + blk * MOBA_BLK + r0) * 512 + h * 64 + dc * 8;
        v4u w[32];
#pragma unroll
        for (int i = 0; i < 32; ++i) w[i] = *(const GAS v4u*)(p + (size_t)i * 8 * 512);
        float s[8] = {0.f, 0.f, 0.f, 0.f, 0.f, 0.f, 0.f, 0.f};
#pragma unroll
        for (int i = 0; i < 32; ++i) { s[0] += bf_lo(w[i].x); s[1] += bf_hi(w[i].x); s[2] += bf_lo(w[i].y); s[3] += bf_hi(w[i].y); s[4] += bf_lo(w[i].z); s[5] += bf_hi(w[i].z); s[6] += bf_lo(w[i].w); s[7] += bf_hi(w[i].w); }
#pragma unroll
        for (int e = 0; e < 8; ++e) { s[e] += mk_shfl_xor(s[e], 8); s[e] += mk_shfl_xor(s[e], 16); s[e] += mk_shfl_xor(s[e], 32); }
        if (r0 == 0) { float* o = KM + ((size_t)(b * MOBA_H + h) * MOBA_NB + blk) * 64 + dc * 8;
            *(GAS f32x4*)o = (f32x4){s[0], s[1], s[2], s[3]} * (1.0f / MOBA_BLK); *(GAS f32x4*)(o + 4) = (f32x4){s[4], s[5], s[6], s[7]} * (1.0f / MOBA_BLK); }
    }
}
struct RgP { const float *conv_w, *conv_b, *w_a, *b_a, *w_x, *b_x, *lam; };
template <bool FIX> __device__ __forceinline__ void ph_rglru(Frame& F, const RgP& P) {
    const int gw = F.vcu * NWAVES + F.wave, NGW = F.G * NWAVES;
    const bf16* RX = (const bf16*)(F.ws + WS_RX); const bf16* RG = (const bf16*)(F.ws + WS_RG); bf16* YB = (bf16*)(F.ws + WS_YB);
    float* AG = (float*)(F.ws + WS_AGG); float* BG = AG + (size_t)BATCH * RG_NCH * D; const float* CI = (const float*)(F.ws + WS_CARRY);
    for (int u = gw; u < BATCH * RG_NCH * RG_NB; u += NGW) {
        const int n = u % RG_NB, c = (u / RG_NB) % RG_NCH, b = u / (RG_NB * RG_NCH);
        const int ch = n * 64 + F.lane;
        float wa[64], wx[64];
#pragma unroll
        for (int k = 0; k < 64; ++k) { wa[k] = P.w_a[(size_t)n * 4096 + k * 64 + F.lane]; wx[k] = P.w_x[(size_t)n * 4096 + k * 64 + F.lane]; }
        const float ba = P.b_a[ch], bx = P.b_x[ch], c8 = -8.0f * log1pf(expf(-P.lam[ch]));
        const float cw0 = P.conv_w[ch], cw1 = P.conv_w[D + ch], cw2 = P.conv_w[2 * D + ch], cw3 = P.conv_w[3 * D + ch], cb = P.conv_b[ch];
        const int t0 = c * RG_CHUNK; const size_t rb = (size_t)b * SEQ;
        float x3 = (t0 >= 3) ? bf2f(RX[(rb + t0 - 3) * D + ch]) : 0.f, x2 = (t0 >= 2) ? bf2f(RX[(rb + t0 - 2) * D + ch]) : 0.f, x1 = (t0 >= 1) ? bf2f(RX[(rb + t0 - 1) * D + ch]) : 0.f;
        const size_t aidx = ((size_t)b * RG_NCH + c) * D + ch;
        float h = FIX ? CI[aidx] : 0.f, pa = 1.f;
        for (int t = 0; t < RG_CHUNK; ++t) {
            const float x0 = bf2f(RX[(rb + t0 + t) * D + ch]);
            const float xr = cb + cw0 * x3 + cw1 * x2 + cw2 * x1 + cw3 * x0; x3 = x2; x2 = x1; x1 = x0;
            float rp = ba, ip = bx;
#pragma unroll
            for (int k = 0; k < 64; ++k) { const float s = __uint_as_float(__builtin_amdgcn_readlane(__float_as_uint(xr), k)); rp += s * wa[k]; ip += s * wx[k]; }
            const float r = 1.0f / (1.0f + expf(-rp)), ig = 1.0f / (1.0f + expf(-ip));
            const float la = c8 * r, a = expf(la), mult = sqrtf(-expm1f(2.0f * la));
            h = a * h + mult * (ig * xr); pa *= a;
            if (FIX) YB[(rb + t0 + t) * YP + ch] = (bf16)f2bf(h * bf2f(RG[(rb + t0 + t) * D + ch]));
        }
        if (!FIX) { AG[aidx] = pa; BG[aidx] = h; }
    }
}
__device__ __forceinline__ void ph_carry(Frame& F) {
    const float* AG = (const float*)(F.ws + WS_AGG); const float* BG = AG + (size_t)BATCH * RG_NCH * D; float* CI = (float*)(F.ws + WS_CARRY);
    if (F.wave == 0) for (int task = F.vcu; task < BATCH * (D / 64); task += F.G) {
        const int b = task / (D / 64), ch = (task % (D / 64)) * 64 + F.lane; const size_t i0 = (size_t)b * RG_NCH * D + ch;
        float A[RG_NCH], Bv[RG_NCH];
#pragma unroll
        for (int c = 0; c < RG_NCH; ++c) { A[c] = AG[i0 + (size_t)c * D]; Bv[c] = BG[i0 + (size_t)c * D]; }
        float carry = 0.f;
#pragma unroll
        for (int c = 0; c < RG_NCH; ++c) { CI[i0 + (size_t)c * D] = carry; carry = A[c] * carry + Bv[c]; }
    }
}
template <int DV  , int VW  >
__device__ __forceinline__ void naive_tile(const LAS float* Ks, const LAS float* Vs, const float (&q)[16], float (&o)[DV], float& mr, float& lr, int qpos, int kpos0, float slope2, bool mine, int qd) {
#pragma unroll 2
    for (int j = 63; j >= 0; --j) {
        const LAS f32x4* kr = (const LAS f32x4*)(Ks + j * 64 + qd * 16);
        const f32x4 k0 = kr[0], k1 = kr[1], k2 = kr[2], k3 = kr[3];
        float d = ((q[0] * k0[0] + q[1] * k0[1]) + (q[2] * k0[2] + q[3] * k0[3])) + ((q[4] * k1[0] + q[5] * k1[1]) + (q[6] * k1[2] + q[7] * k1[3]))
                + ((q[8] * k2[0] + q[9] * k2[1]) + (q[10] * k2[2] + q[11] * k2[3])) + ((q[12] * k3[0] + q[13] * k3[1]) + (q[14] * k3[2] + q[15] * k3[3]));
        d += mk_shfl_xor(d, 1); d += mk_shfl_xor(d, 2);
        const int dist = qpos - (kpos0 + j);
        if (mine && dist >= 0) {
            const float sv = d - slope2 * (float)dist;
            if (sv > mr) { const float sc = __builtin_amdgcn_exp2f(mr - sv); lr *= sc; mr = sv;
#pragma unroll
                for (int e = 0; e < DV; ++e) o[e] *= sc; }
            const float p = __builtin_amdgcn_exp2f(sv - mr); lr += p; const LAS f32x4* vr = (const LAS f32x4*)(Vs + j * VW + qd * DV);
#pragma unroll
            for (int i = 0; i < DV / 4; ++i) { const f32x4 v = vr[i]; o[4 * i] += p * v[0]; o[4 * i + 1] += p * v[1]; o[4 * i + 2] += p * v[2]; o[4 * i + 3] += p * v[3]; }
        }
    }
}
template <int VW> __device__ __forceinline__ void naive_stage(Frame& F, LAS float* Ks, LAS float* Vs, const bf16* Kg, const bf16* Vg) {
    { const int r = F.tid >> 3, c = (F.tid & 7) * 8; const v4u w = *(const GAS v4u*)(Kg + (size_t)r * 512 + c); LAS float* d = Ks + r * 64 + c;
      d[0] = bf_lo(w.x); d[1] = bf_hi(w.x); d[2] = bf_lo(w.y); d[3] = bf_hi(w.y); d[4] = bf_lo(w.z); d[5] = bf_hi(w.z); d[6] = bf_lo(w.w); d[7] = bf_hi(w.w); }
#pragma unroll
    for (int i = 0; i < VW / 64; ++i) { const int e = (F.tid + i * 512) * 8, r = e / VW, c = e % VW; const v4u w = *(const GAS v4u*)(Vg + (size_t)r * 512 + c); LAS float* d = Vs + r * VW + c;
      d[0] = bf_lo(w.x); d[1] = bf_hi(w.x); d[2] = bf_lo(w.y); d[3] = bf_hi(w.y); d[4] = bf_lo(w.z); d[5] = bf_hi(w.z); d[6] = bf_lo(w.w); d[7] = bf_hi(w.w); }
}
__device__ __forceinline__ void load_q16(float (&q)[16], const bf16* p) {
#pragma unroll
    for (int i = 0; i < 2; ++i) { const v4u w = *(const GAS v4u*)(p + 8 * i); q[8 * i] = bf_lo(w.x); q[8 * i + 1] = bf_hi(w.x); q[8 * i + 2] = bf_lo(w.y); q[8 * i + 3] = bf_hi(w.y); q[8 * i + 4] = bf_lo(w.z); q[8 * i + 5] = bf_hi(w.z); q[8 * i + 6] = bf_lo(w.w); q[8 * i + 7] = bf_hi(w.w); }
}
__device__ __forceinline__ void causal_unit(int idx, int nbh, bool four, int& bh, int& qt) {
    bh = idx % nbh; const int j = idx / nbh;
    if (four) qt = (j < 8) ? 31 - j : (j < 16) ? j - 8 : (j < 24) ? 39 - j : j - 16;
    else qt = (j < 16) ? 31 - j : j - 16;
}

struct DiffP { const float *lq1, *lk1, *lq2, *lk2, *subln_g; float lam_init; };
__device__ __forceinline__ void ph_diffattn_naive(Frame& F, const DiffP& P) {
    LAS float* Ks = (LAS float*)(F.lds + RING_OFF); LAS float* Vs = Ks + 64 * 64;
    const bf16* QC = (const bf16*)(F.ws + WS_QC); const bf16* KC = (const bf16*)(F.ws + WS_KC); const bf16* VC = (const bf16*)(F.ws + WS_VC); bf16* YC = (bf16*)(F.ws + WS_YC);
    float* DS = (float*)(F.ws + WS_DSCR);
    float d1 = 0.f, d2 = 0.f;
    for (int i = 0; i < 64; ++i) { d1 += P.lq1[i] * P.lk1[i]; d2 += P.lq2[i] * P.lk2[i]; }
    const float lam = expf(d1) - expf(d2) + P.lam_init;
    const int row = F.tid >> 2, qd = F.tid & 3;
    for (int idx = F.vcu; idx < BATCH * DIFF_H * 32; idx += F.G) {
        int bh, qt; causal_unit(idx, BATCH * DIFF_H, false, bh, qt);
        const int b = bh / DIFF_H, h = bh % DIFF_H; const int qpos = qt * 128 + row; const size_t grow = (size_t)b * SEQ + qpos;
        const float slope2 = exp2f(-2.0f * (float)(h + 1)) * LOG2E;
        float* dsp = DS + (grow * DIFF_H + h) * 128 + qd * 32;
        for (int m = 0; m < 2; ++m) {
            float q[16]; load_q16(q, QC + grow * 512 + h * 128 + m * 64 + qd * 16);
            float o[32]; float mr = -INFINITY, lr = 0.f;
#pragma unroll
            for (int d = 0; d < 32; ++d) o[d] = 0.f;
            for (int kt = 2 * qt + 1; kt >= 0; --kt) {
                __syncthreads();
                const size_t krow = (size_t)b * SEQ + kt * 64;
                naive_stage<128>(F, Ks, Vs, KC + krow * 512 + h * 128 + m * 64, VC + krow * 512 + h * 128);
                __syncthreads();
                naive_tile<32, 128>(Ks, Vs, q, o, mr, lr, qpos, kt * 64, slope2, true, qd);
            }
            const float il = __builtin_amdgcn_rcpf(lr);
            if (m == 0) {
#pragma unroll
                for (int d = 0; d < 32; d += 4) *(f32x4*)(dsp + d) = (f32x4){o[d] * il, o[d + 1] * il, o[d + 2] * il, o[d + 3] * il};
            } else {
                float ss = 0.f;
#pragma unroll
                for (int d = 0; d < 32; d += 4) { const f32x4 o1 = *(const f32x4*)(dsp + d);
#pragma unroll
                    for (int e = 0; e < 4; ++e) { o[d + e] = o1[e] - lam * (o[d + e] * il); ss += o[d + e] * o[d + e]; } }
                ss += mk_shfl_xor(ss, 1); ss += mk_shfl_xor(ss, 2);
                const float rs = rsqrtf(ss * (1.0f / 128.0f) + 1e-6f) * (1.0f - P.lam_init);
                bf16* yp = YC + grow * YP + h * 128 + qd * 32; const float* gp = P.subln_g + qd * 32;
#pragma unroll
                for (int d = 0; d < 32; d += 8) { v4u w;
                    w.x = pk2(o[d] * rs * gp[d], o[d + 1] * rs * gp[d + 1]); w.y = pk2(o[d + 2] * rs * gp[d + 2], o[d + 3] * rs * gp[d + 3]);
                    w.z = pk2(o[d + 4] * rs * gp[d + 4], o[d + 5] * rs * gp[d + 5]); w.w = pk2(o[d + 6] * rs * gp[d + 6], o[d + 7] * rs * gp[d + 7]);
                    *(GAS v4u*)(yp + d) = w; }
            }
        }
    }
    __syncthreads();
}
namespace at {
using bf16x8 = __attribute__((ext_vector_type(8))) short;
using s16x4 = __attribute__((ext_vector_type(4))) short;
using f32x16 = __attribute__((ext_vector_type(16))) float;
using u32x4 = __attribute__((ext_vector_type(4))) unsigned;
typedef __attribute__((address_space(3))) const char* lds_cptr;
typedef short v4i16_t __attribute__((ext_vector_type(4)));
__device__ __forceinline__ int crow(int r, int hi) { return (r & 3) + 8 * (r >> 2) + 4 * hi; }
__device__ __forceinline__ void glds16(const void* gsrc, unsigned lds_dst) { unsigned keep;
    asm volatile("s_mov_b32 %0, m0\n\ts_mov_b32 m0, %2\n\ts_nop 0\n\tglobal_load_lds_dwordx4 %1, off\n\ts_mov_b32 m0, %0" : "=&s"(keep) : "v"(gsrc), "s"(lds_dst) : "memory"); }
typedef float f32x2_t __attribute__((ext_vector_type(2))); typedef __bf16 bf16x2_t __attribute__((ext_vector_type(2)));
__device__ __forceinline__ unsigned cvtpk(float lo, float hi) { f32x2_t v = {lo, hi}; bf16x2_t b = __builtin_convertvector(v, bf16x2_t); return __builtin_bit_cast(unsigned, b); }
__device__ __forceinline__ void kload8(bf16x8* kf, lds_cptr kp) {
#pragma unroll
    for (int d0 = 0; d0 < 4; ++d0) { kf[2 * d0] = *(const __attribute__((address_space(3))) bf16x8*)(kp + d0 * 2048); kf[2 * d0 + 1] = *(const __attribute__((address_space(3))) bf16x8*)(kp + d0 * 2048 + 512); }
}
__device__ __forceinline__ s16x4 vtr(lds_cptr p) { return __builtin_bit_cast(s16x4, __builtin_amdgcn_ds_read_tr16_b64_v4i16((__attribute__((address_space(3))) v4i16_t*)p)); }
__device__ __forceinline__ float rowmax(const f32x16& p0, const f32x16& p1) {
    float a = fmaxf(p0[0], p1[0]);
#pragma unroll
    for (int r = 1; r < 16; ++r) a = fmaxf(a, fmaxf(p0[r], p1[r]));
    auto rr = __builtin_amdgcn_permlane32_swap(__float_as_uint(a), __float_as_uint(a), false, false);
    return fmaxf(__uint_as_float(rr[0]), __uint_as_float(rr[1]));
}
__device__ __forceinline__ float max3f(float a, float b, float c) { float r; asm("v_max3_f32 %0, %1, %2, %3" : "=v"(r) : "v"(a), "v"(b), "v"(c)); return r; }
__device__ __forceinline__ float max2f(float a, float b) { float r; asm("v_max_f32_e32 %0, %1, %2" : "=v"(r) : "v"(a), "v"(b)); return r; }
__device__ __forceinline__ float fadd_s(float a, float b) { float r; asm("v_add_f32_e32 %0, %1, %2" : "=v"(r) : "v"(a), "v"(b)); return r; }
#define AT_WAIT_BAR(N) asm volatile("s_waitcnt vmcnt(" #N ") lgkmcnt(0)\n\ts_barrier" ::: "memory")
#define AT_MFMA(a, b, c) __builtin_amdgcn_mfma_f32_32x32x16_bf16(a, b, c, 0, 0, 0)
constexpr float THR = 8.0f;
template <bool MASK>
__device__ __forceinline__ bool tile_qk(lds_cptr kp  , const int (&koff)[4]  , lds_cptr qp  , float slope2, float tb, int qrel, int hi, int r32,
                                          float& mhat, float& lsum, __attribute__((address_space(3))) float* wsf, u32x4 (&pw)[4]) {
    bf16x8 kf[4];
#pragma unroll
    for (int d0 = 0; d0 < 2; ++d0) { kf[2 * d0] = *(const __attribute__((address_space(3))) bf16x8*)(kp + koff[d0]); kf[2 * d0 + 1] = *(const __attribute__((address_space(3))) bf16x8*)(kp + koff[d0] + 4096); }
    f32x16 p0, p1; { const float t0 = tb - mhat + slope2 * (float)(4 * hi), t1 = t0 + slope2 * 32.f;
        const float s8 = slope2 * 8.f; (void)t1;
        p0[0] = t0; p0[1] = p0[0] + slope2; p0[2] = p0[1] + slope2; p0[3] = p0[2] + slope2;
#pragma unroll
        for (int r = 4; r < 16; ++r) p0[r] = p0[r - 4] + s8;
        const float s32 = slope2 * 32.f;
#pragma unroll
        for (int r = 0; r < 16; ++r) p1[r] = p0[r] + s32; }
    bf16x8 qr[4];
#pragma unroll
    for (int d0 = 0; d0 < 4; ++d0) qr[d0] = *(const __attribute__((address_space(3))) bf16x8*)(qp + d0 * 1024);
    __builtin_amdgcn_sched_barrier(0);
#pragma unroll
    for (int d0 = 0; d0 < 2; ++d0) { p0 = AT_MFMA(kf[2 * d0], qr[d0], p0); p1 = AT_MFMA(kf[2 * d0 + 1], qr[d0], p1); }
#pragma unroll
    for (int d0 = 0; d0 < 2; ++d0) { kf[2 * d0] = *(const __attribute__((address_space(3))) bf16x8*)(kp + koff[d0 + 2]); kf[2 * d0 + 1] = *(const __attribute__((address_space(3))) bf16x8*)(kp + koff[d0 + 2] + 4096); }
    __builtin_amdgcn_sched_barrier(0);
#pragma unroll
    for (int d0 = 0; d0 < 2; ++d0) { p0 = AT_MFMA(kf[2 * d0], qr[d0 + 2], p0); p1 = AT_MFMA(kf[2 * d0 + 1], qr[d0 + 2], p1); }
    __builtin_amdgcn_sched_barrier(0);
    if (MASK) {
#pragma unroll
        for (int r = 0; r < 16; ++r) { const int kv = crow(r, hi); if (kv > qrel) p0[r] = -INFINITY; if (kv + 32 > qrel) p1[r] = -INFINITY; } }
    const float rm = rowmax(p0, p1);
    const bool resc = __any(rm > THR);
    if (resc) { const float dl = fmaxf(rm, 0.f); mhat += dl;
#pragma unroll
        for (int r = 0; r < 16; ++r) { p0[r] -= dl; p1[r] -= dl; }
        const float f = __builtin_amdgcn_exp2f(-dl); lsum *= f; if (hi == 0) wsf[r32] = f; }
    float sacc = 0.f;
#pragma unroll
    for (int r = 0; r < 16; ++r) { p0[r] = __builtin_amdgcn_exp2f(p0[r]); p1[r] = __builtin_amdgcn_exp2f(p1[r]); sacc += p0[r] + p1[r]; }
    lsum += sacc;
#pragma unroll
    for (int s = 0; s < 2; ++s) { pw[s] = (u32x4){cvtpk(p0[8 * s], p0[8 * s + 1]), cvtpk(p0[8 * s + 2], p0[8 * s + 3]), cvtpk(p0[8 * s + 4], p0[8 * s + 5]), cvtpk(p0[8 * s + 6], p0[8 * s + 7])};
                                  pw[2 + s] = (u32x4){cvtpk(p1[8 * s], p1[8 * s + 1]), cvtpk(p1[8 * s + 2], p1[8 * s + 3]), cvtpk(p1[8 * s + 4], p1[8 * s + 5]), cvtpk(p1[8 * s + 6], p1[8 * s + 7])}; }
    return resc;
}
template <int NDB>
__device__ __forceinline__ void tile_pv(lds_cptr vp, const u32x4 (&pw)[4], bool resc, int hi, f32x16 (&o)[NDB], __attribute__((address_space(3))) float* wsf) {
    if (resc) { asm volatile("s_waitcnt lgkmcnt(0)" ::: "memory");
#pragma unroll
        for (int r = 0; r < 16; ++r) { const float f = (wsf + 4 * hi)[(r & 3) + 8 * (r >> 2)];
#pragma unroll
            for (int db = 0; db < NDB; ++db) o[db][r] *= f; } }
    __builtin_amdgcn_sched_barrier(0);
#pragma unroll
    for (int ks = 0; ks < 4; ++ks) {
        s16x4 lo[NDB], hv[NDB];
#pragma unroll
        for (int db = 0; db < NDB; ++db) { lo[db] = vtr(vp + db * 4096 + ks * 1024); hv[db] = vtr(vp + db * 4096 + ks * 1024 + 512); }
#pragma unroll
        for (int db = 0; db < NDB; ++db) { const bf16x8 vf = (bf16x8){lo[db][0], lo[db][1], lo[db][2], lo[db][3], hv[db][0], hv[db][1], hv[db][2], hv[db][3]};
            o[db] = AT_MFMA(__builtin_bit_cast(bf16x8, pw[ks]), vf, o[db]); }
        __builtin_amdgcn_sched_barrier(0); }
}

#define AT_SB() __builtin_amdgcn_sched_barrier(0)
typedef __attribute__((address_space(3))) float* lds_fptr;
template <int NDB> __device__ __forceinline__ void ld_v(s16x4 (&lo)[NDB], s16x4 (&hv)[NDB], lds_cptr vp, int ks) {
#pragma unroll
    for (int db = 0; db < NDB; ++db) { lo[db] = vtr(vp + db * 4096 + ks * 1024); hv[db] = vtr(vp + db * 4096 + ks * 1024 + 512); } }
template <int NDB> __device__ __forceinline__ void pv_mm(f32x16 (&o)[NDB], const u32x4& pk, const s16x4 (&lo)[NDB], const s16x4 (&hv)[NDB]) {
#pragma unroll
    for (int db = 0; db < NDB; ++db) { const bf16x8 vf = (bf16x8){lo[db][0], lo[db][1], lo[db][2], lo[db][3], hv[db][0], hv[db][1], hv[db][2], hv[db][3]};
        o[db] = AT_MFMA(__builtin_bit_cast(bf16x8, pk), vf, o[db]); } }
template <int NDB> __device__ __forceinline__ void pv_tile(f32x16 (&o)[NDB], const u32x4 (&pw)[4], lds_cptr vp, bool resc, int hi, lds_fptr wsf, s16x4 (&alo)[NDB], s16x4 (&ahv)[NDB], s16x4 (&blo)[NDB], s16x4 (&bhv)[NDB]) {
    if (resc) { asm volatile("s_waitcnt lgkmcnt(0)" ::: "memory");
#pragma unroll
        for (int r = 0; r < 16; ++r) { const float f = (wsf + 4 * hi)[(r & 3) + 8 * (r >> 2)];
#pragma unroll
            for (int db = 0; db < NDB; ++db) o[db][r] *= f; } }
    AT_SB();
    pv_mm<NDB>(o, pw[0], alo, ahv); ld_v<NDB>(alo, ahv, vp, 2); AT_SB();
    pv_mm<NDB>(o, pw[1], blo, bhv); ld_v<NDB>(blo, bhv, vp, 3); AT_SB();
    pv_mm<NDB>(o, pw[2], alo, ahv); AT_SB();
    pv_mm<NDB>(o, pw[3], blo, bhv); AT_SB(); }
__device__ __forceinline__ void ld_kq(bf16x8 (&kf)[8], bf16x8 (&qr)[4], lds_cptr kp, const int (&koff)[4], lds_cptr qp) {
#pragma unroll
    for (int d0 = 0; d0 < 4; ++d0) { const unsigned a_ = (unsigned)(uintptr_t)kp + (unsigned)koff[d0]; __builtin_assume(a_ < 0x28000u);
        kf[2 * d0] = *(const __attribute__((address_space(3))) bf16x8*)(uintptr_t)a_; kf[2 * d0 + 1] = *(const __attribute__((address_space(3))) bf16x8*)(uintptr_t)(a_ + 4096u); }
#pragma unroll
    for (int d0 = 0; d0 < 4; ++d0) qr[d0] = *(const __attribute__((address_space(3))) bf16x8*)(qp + d0 * 1024); }
template <bool CM = false>
__device__ __forceinline__ bool qk_softmax(const bf16x8 (&kf)[8], const bf16x8 (&qr)[4], bool msk, float slope2, float tb, int qrel, int hi, int r32, float& mhat, float& lsum, lds_fptr wsf, u32x4 (&pw)[4]) {
    asm volatile("" : "+v"(hi), "+v"(slope2));
    f32x16 p0, p1;
    if (CM) {
        const float c_ = tb - mhat, ak = hi ? 1.0f : slope2 * (float)r32, b0 = hi ? c_ : 1.0f, b1 = hi ? c_ + slope2 * 32.f : 1.0f;
        p0 = __builtin_amdgcn_mfma_f32_32x32x2f32(ak, b0, f32x16{}, 0, 0, 0); p1 = __builtin_amdgcn_mfma_f32_32x32x2f32(ak, b1, f32x16{}, 0, 0, 0);
    } else { const float t0 = tb - mhat + slope2 * (float)(4 * hi), s8 = slope2 * 8.f, s32 = slope2 * 32.f;
        p0[0] = t0; p0[1] = fadd_s(p0[0], slope2); p0[2] = fadd_s(p0[1], slope2); p0[3] = fadd_s(p0[2], slope2);
#pragma unroll
        for (int r = 4; r < 16; ++r) p0[r] = fadd_s(p0[r - 4], s8);
#pragma unroll
        for (int r = 0; r < 16; ++r) p1[r] = fadd_s(p0[r], s32); }
    if (!CM) asm volatile("s_nop 3" ::: "memory");
    AT_SB();
#pragma unroll
    for (int d0 = 0; d0 < 4; ++d0) { p0 = AT_MFMA(kf[2 * d0], qr[d0], p0); p1 = AT_MFMA(kf[2 * d0 + 1], qr[d0], p1); }
    AT_SB();
    if (msk) { const int qh = qrel - 4 * hi;
#pragma unroll
        for (int r = 0; r < 16; ++r) { const int kc = (r & 3) + 8 * (r >> 2); if (kc > qh) p0[r] = -INFINITY; if (kc + 32 > qh) p1[r] = -INFINITY; } }
    p1[15] += 0.0f; p0[15] += 0.0f;
    AT_SB();
    float rm; { float m0 = max3f(p0[0], p0[1], p1[0]), m1 = max3f(p0[2], p0[3], p1[1]); m0 = max3f(m0, p1[2], p1[3]);
#pragma unroll
        for (int r = 4; r < 16; r += 4) { m0 = max3f(m0, p0[r], p0[r + 1]); m1 = max3f(m1, p0[r + 2], p0[r + 3]); m0 = max3f(m0, p1[r], p1[r + 1]); m1 = max3f(m1, p1[r + 2], p1[r + 3]); }
        const float a = fmaxf(m0, m1); auto rr = __builtin_amdgcn_permlane32_swap(__float_as_uint(a), __float_as_uint(a), false, false);
        rm = fmaxf(__uint_as_float(rr[0]), __uint_as_float(rr[1])); }
    const bool resc = __any(rm > THR);
    if (resc) { const float dl = fmaxf(rm, 0.f); mhat += dl;
#pragma unroll
        for (int r = 0; r < 16; ++r) { p0[r] -= dl; p1[r] -= dl; }
        const float f = __builtin_amdgcn_exp2f(-dl); lsum *= f; if (hi == 0) wsf[r32] = f; }
#pragma unroll
    for (int r = 0; r < 16; ++r) { p0[r] = __builtin_amdgcn_exp2f(p0[r]); p1[r] = __builtin_amdgcn_exp2f(p1[r]); }
    AT_SB();
    float s0 = p0[0], s1 = p1[0];
#pragma unroll
    for (int r = 1; r < 16; ++r) { s0 = fadd_s(s0, p0[r]); s1 = fadd_s(s1, p1[r]); }
    lsum += s0 + s1;
#pragma unroll
    for (int s = 0; s < 2; ++s) { pw[s] = (u32x4){cvtpk(p0[8 * s], p0[8 * s + 1]), cvtpk(p0[8 * s + 2], p0[8 * s + 3]), cvtpk(p0[8 * s + 4], p0[8 * s + 5]), cvtpk(p0[8 * s + 6], p0[8 * s + 7])};
                                  pw[2 + s] = (u32x4){cvtpk(p1[8 * s], p1[8 * s + 1]), cvtpk(p1[8 * s + 2], p1[8 * s + 3]), cvtpk(p1[8 * s + 4], p1[8 * s + 5]), cvtpk(p1[8 * s + 6], p1[8 * s + 7])}; }
    return resc;
}
}

__device__ __forceinline__ void ph_diffattn_mfma(Frame& F, const DiffP& P) {
    using namespace at;
    const int wid = F.wave, mh = wid >> 2, w4 = wid & 3;
    LAS unsigned char* shm = F.lds + RING_OFF; const unsigned lds0 = (unsigned)(uintptr_t)shm;
    constexpr int KSTG = 16384, VSTG = 16384, OFF_K2 = 8192, OFF_V = 3 * KSTG, OFF_WS = OFF_V + 4 * VSTG, OFF_Q = OFF_WS + 2048, OFF_Y = OFF_Q;
    LAS float* wsf = (LAS float*)(shm + OFF_WS) + wid * 64;
    const bf16* QC = (const bf16*)(F.ws + WS_QC); const bf16* KC = (const bf16*)(F.ws + WS_KC); const bf16* VC = (const bf16*)(F.ws + WS_VC); bf16* YC = (bf16*)(F.ws + WS_YC);
    float d1 = 0.f, d2 = 0.f;
    for (int i = 0; i < 64; ++i) { d1 += P.lq1[i] * P.lk1[i]; d2 += P.lq2[i] * P.lk2[i]; }
    const float lam = expf(d1) - expf(d2) + P.lam_init;
    const lds_cptr kp0 = (lds_cptr)shm + mh * OFF_K2;
    for (int idx = F.vcu, it_ = 0; idx < BATCH * DIFF_H * 32; idx += F.G, ++it_) {
        int bh = idx % (BATCH * DIFF_H), j = idx / (BATCH * DIFF_H), qb = (j < 16) ? 31 - j : j - 16;
        if (F.G == 256) { const int xcd = F.vcu >> 5, w = F.vcu & 31; bh = 2 * xcd + it_; qb = it_ == 0 ? 31 - w : w; }
        const int b = bh / DIFF_H, h = bh % DIFF_H, q0 = qb * 128, q0w = q0 + w4 * 32, NT = 2 * qb + 2;
        const float slope2 = exp2f(-2.0f * (float)(h + 1)) * LOG2E;
        const size_t rowb = (size_t)b * SEQ;
        int lu = mk_lane(); asm volatile("" : "+v"(lu));
        const int lane = lu, r32 = lane & 31, hi = lane >> 5;
        int koff[4];
#pragma unroll
        for (int d0 = 0; d0 < 4; ++d0) koff[d0] = r32 * 128 + (((2 * d0 + hi) ^ ((r32 >> 1) & 7)) << 4);
        const lds_cptr vp0 = (lds_cptr)shm + OFF_V + ((lane >> 4) & 1) * 32 + (lane & 3) * 8 + (4 * hi + ((lane & 15) >> 2)) * 64;
        const lds_cptr qp = (lds_cptr)shm + OFF_Q + wid * 4096 + lu * 16;
        { const bf16* Qw = QC + (rowb + q0w + (lu & 31)) * 512 + h * 128 + mh * 64;
#pragma unroll
          for (int d0 = 0; d0 < 4; ++d0) *(__attribute__((address_space(3))) bf16x8*)((LAS unsigned char*)shm + OFF_Q + wid * 4096 + lu * 16 + d0 * 1024) = *(const GAS bf16x8*)(Qw + d0 * 16 + (lu >> 5) * 8); }
        const bf16* ks1 = KC + (rowb + 8 * wid + (lu >> 3)) * 512 + h * 128 + (((lu & 7) ^ (((8 * wid + (lu >> 3)) >> 1) & 7)) << 3);
        const int pA = 2 * wid;
        const bf16* vsA = VC + (rowb + 16 * (pA & 3) + (lu >> 2)) * 512 + h * 128 + (pA >> 2) * 32 + (lu & 3) * 8;
#define DF_DMA(t) do { const size_t go_ = (size_t)(t) * 64 * 512; const unsigned kb_ = lds0 + (unsigned)((t) % 3) * KSTG, vb_ = lds0 + OFF_V + (unsigned)((t) & 3) * VSTG; \
        glds16(ks1 + go_, (unsigned)__builtin_amdgcn_readfirstlane(kb_ + wid * 1024)); glds16(ks1 + go_ + 64, (unsigned)__builtin_amdgcn_readfirstlane(kb_ + OFF_K2 + wid * 1024)); \
        glds16(vsA + go_, (unsigned)__builtin_amdgcn_readfirstlane(vb_ + pA * 1024)); glds16(vsA + go_ + 16 * 512, (unsigned)__builtin_amdgcn_readfirstlane(vb_ + (pA + 1) * 1024)); } while (0)
        f32x16 o[4]; float mhat = 0.f, lsum = 0.f;
#pragma unroll
        for (int db = 0; db < 4; ++db) o[db] = f32x16{};
        u32x4 pw[4]; bool pend = false, presc = false; int pvt = 0;
        DF_DMA(0); DF_DMA(1);
        for (int t = 0; t <= NT; ++t) {
            const bool live = t < NT;
            if (mh == 1 && live) { if (t + 1 < NT) { AT_WAIT_BAR(4); } else { AT_WAIT_BAR(0); } if (t + 2 < NT) DF_DMA(t + 2); }
            const int k0 = t * 64; const bool doqk = live && (k0 <= q0w + 31);
            unsigned ks_ = (unsigned)(t % 3) * KSTG; asm volatile("" : "+s"(ks_));
            const lds_cptr kp = kp0 + ks_;
            bf16x8 kf[8], qr[4]; s16x4 alo[4], ahv[4], blo[4], bhv[4]; const lds_cptr vp = vp0 + (pvt & 3) * VSTG;
            if (pend) { ld_v<4>(alo, ahv, vp, 0); ld_v<4>(blo, bhv, vp, 1); }
            if (mh == 1 && doqk) ld_kq(kf, qr, kp, koff, qp);
            AT_SB();
            if (pend) { pv_tile<4>(o, pw, vp, presc, hi, wsf, alo, ahv, blo, bhv); pend = false; }
            if (mh == 0 && live) { if (t + 1 < NT) { AT_WAIT_BAR(4); } else { AT_WAIT_BAR(0); } if (t + 2 < NT) DF_DMA(t + 2); }
            if (doqk) {
                if (mh == 0) ld_kq(kf, qr, kp, koff, qp);
                presc = qk_softmax(kf, qr, k0 + 63 > q0w, slope2, slope2 * (float)(k0 - q0w), q0w + r32 - k0, hi, r32, mhat, lsum, wsf, pw);
                pend = true; pvt = t; }
        }
        AT_WAIT_BAR(0);
#undef DF_DMA
        { auto rr = __builtin_amdgcn_permlane32_swap(__float_as_uint(lsum), __float_as_uint(lsum), false, false); lsum = __uint_as_float(rr[0]) + __uint_as_float(rr[1]); }
        if (hi == 0) wsf[32 + r32] = lsum;
        asm volatile("s_waitcnt lgkmcnt(0)" ::: "memory");
        float rli[16];
#pragma unroll
        for (int r = 0; r < 16; ++r) rli[r] = __builtin_amdgcn_rcpf((wsf + 32 + 4 * hi)[(r & 3) + 8 * (r >> 2)]);
        int le_ = mk_lane(); asm volatile("" : "+v"(le_));
        LAS float* X = (LAS float*)shm + (w4 * 32 + 4 * (le_ >> 5)) * 128 + (le_ & 31);
        if (mh == 1) {
#pragma unroll
            for (int db = 0; db < 4; ++db)
#pragma unroll
                for (int r = 0; r < 16; ++r) X[((r & 3) + 8 * (r >> 2)) * 128 + db * 32] = o[db][r] * rli[r];
        }
        AT_WAIT_BAR(0);
        if (mh == 0) {
            float ssr[16];
#pragma unroll
            for (int r = 0; r < 16; ++r) { float a = 0.f;
#pragma unroll
                for (int db = 0; db < 4; ++db) { const float v = o[db][r] * rli[r] - lam * X[((r & 3) + 8 * (r >> 2)) * 128 + db * 32]; o[db][r] = v; a += v * v; }
                ssr[r] = a; }
#pragma unroll
            for (int r = 0; r < 16; ++r) { float a = ssr[r]; a += mk_shfl_xor(a, 1); a += mk_shfl_xor(a, 2); a += mk_shfl_xor(a, 4); a += mk_shfl_xor(a, 8); a += mk_shfl_xor(a, 16); ssr[r] = rsqrtf(a * (1.0f / 128.0f) + 1e-6f) * (1.0f - P.lam_init); }
            float gsl[4];
#pragma unroll
            for (int db = 0; db < 4; ++db) gsl[db] = ((const GAS float*)P.subln_g)[db * 32 + (le_ & 31)];
            LAS bf16* Y = (LAS bf16*)(shm + OFF_Y) + (w4 * 32 + 4 * (le_ >> 5)) * 128 + (le_ & 31);
#pragma unroll
            for (int db = 0; db < 4; ++db) { const float g = gsl[db];
#pragma unroll
                for (int r = 0; r < 16; ++r) Y[((r & 3) + 8 * (r >> 2)) * 128 + db * 32] = (bf16)f2bf(o[db][r] * ssr[r] * g); }
        }
        AT_WAIT_BAR(0);
        { int tid_ = F.tid; asm volatile("" : "+v"(tid_));
#pragma unroll
        for (int i = 0; i < 4; ++i) { const int id = tid_ + i * 512, row = id >> 4, pc = id & 15;
            const v4u w = *(const LAS v4u*)(shm + OFF_Y + row * 256 + pc * 16);
            *(GAS v4u*)(YC + (rowb + q0 + row) * YP + h * 128 + pc * 8) = w; } }
        AT_WAIT_BAR(0);
    }
}
__device__ __forceinline__ void ph_diffattn_pipe(Frame& F, const DiffP& P) {
    using namespace at;
    const int wid = F.wave, mh = wid >> 2, w4 = wid & 3;
    LAS unsigned char* shm = F.lds + RING_OFF; const unsigned lds0 = (unsigned)(uintptr_t)shm;
    constexpr int KSTG = 16384, VSTG = 16384, OFF_K2 = 8192, OFF_V = 3 * KSTG, OFF_WS = OFF_V + 4 * VSTG, OFF_Q = OFF_WS + 2048, OFF_Y = OFF_Q;
    LAS float* wsf = (LAS float*)(shm + OFF_WS) + wid * 64;
    const bf16* QC = (const bf16*)(F.ws + WS_QC); const bf16* KC = (const bf16*)(F.ws + WS_KC); const bf16* VC = (const bf16*)(F.ws + WS_VC); bf16* YC = (bf16*)(F.ws + WS_YC);
    float d1 = 0.f, d2 = 0.f;
    for (int i = 0; i < 64; ++i) { d1 += P.lq1[i] * P.lk1[i]; d2 += P.lq2[i] * P.lk2[i]; }
    const float lam = expf(d1) - expf(d2) + P.lam_init;
    const lds_cptr kp0 = (lds_cptr)shm + mh * OFF_K2;
    for (int idx = F.vcu, it_ = 0; idx < BATCH * DIFF_H * 32; idx += F.G, ++it_) {
        int bh = idx % (BATCH * DIFF_H), j = idx / (BATCH * DIFF_H), qb = (j < 16) ? 31 - j : j - 16;
        if (F.G == 256) { const int xcd = F.vcu >> 5, w = F.vcu & 31; bh = 2 * xcd + it_; qb = it_ == 0 ? 31 - w : w; }
        const int b = bh / DIFF_H, h = bh % DIFF_H, q0 = qb * 128, q0w = q0 + w4 * 32, NT = 2 * qb + 2;
        const float slope2 = exp2f(-2.0f * (float)(h + 1)) * LOG2E;
        const size_t rowb = (size_t)b * SEQ;
        int lu = mk_lane(); asm volatile("" : "+v"(lu));
        const int lane = lu, r32 = lane & 31, hi = lane >> 5;
        int koff[4];
#pragma unroll
        for (int d0 = 0; d0 < 4; ++d0) koff[d0] = r32 * 128 + (((2 * d0 + hi) ^ ((r32 >> 1) & 7)) << 4);
        const lds_cptr vp0 = (lds_cptr)shm + OFF_V + ((lane >> 4) & 1) * 32 + (lane & 3) * 8 + (4 * hi + ((lane & 15) >> 2)) * 64;
        const lds_cptr qp = (lds_cptr)shm + OFF_Q + wid * 4096 + lu * 16;
        { const bf16* Qw = QC + (rowb + q0w + (lu & 31)) * 512 + h * 128 + mh * 64;
          bf16x8 qv_[4];
#pragma unroll
          for (int d0 = 0; d0 < 4; ++d0) qv_[d0] = *(const GAS bf16x8*)(Qw + d0 * 16 + (lu >> 5) * 8);
          __builtin_amdgcn_sched_barrier(0);
#pragma unroll
          for (int d0 = 0; d0 < 4; ++d0) *(__attribute__((address_space(3))) bf16x8*)((LAS unsigned char*)shm + OFF_Q + wid * 4096 + lu * 16 + d0 * 1024) = qv_[d0]; }
        const bf16* ks1 = KC + (rowb + 8 * wid + (lu >> 3)) * 512 + h * 128 + (((lu & 7) ^ (((8 * wid + (lu >> 3)) >> 1) & 7)) << 3);
        const int pA = 2 * wid;
        const bf16* vsA = VC + (rowb + 16 * (pA & 3) + (lu >> 2)) * 512 + h * 128 + (pA >> 2) * 32 + (lu & 3) * 8;
#define DMA_K(t, slot) do { const size_t go_ = (size_t)(t) * 64 * 512; const unsigned kb_ = (unsigned)__builtin_amdgcn_readfirstlane(lds0 + (unsigned)(slot) + wid * 1024); glds16(ks1 + go_, kb_); glds16(ks1 + go_ + 64, kb_ + OFF_K2); } while (0)
#define DMA_V(t, slot) do { const size_t go_ = (size_t)(t) * 64 * 512; const unsigned vb_ = (unsigned)__builtin_amdgcn_readfirstlane(lds0 + OFF_V + (unsigned)(slot) + pA * 1024); glds16(vsA + go_, vb_); glds16(vsA + go_ + 16 * 512, vb_ + 1024); } while (0)
        f32x16 o[4]; float mhat = 0.f, lsum = 0.f;
#pragma unroll
        for (int db = 0; db < 4; ++db) o[db] = f32x16{};
        f32x16 pA0, pA1, pB0, pB1; bf16x8 kf[8], qr[4]; s16x4 vlo[3], vhi[3]; u32x4 pw[4]; bool resc = false;
        const float akey = hi ? 1.0f : slope2 * (float)r32;
        const unsigned kl0 = lds0 + (unsigned)mh * OFF_K2;
        unsigned sl_prev = 0u, sl_cur = 0u, sl_next = KSTG;
#define ROT() do { sl_prev = sl_cur; sl_cur = sl_next; sl_next = (sl_next == 2u * KSTG) ? 0u : sl_next + KSTG; } while (0)
#define PIN(x) asm volatile("" : "+v"(x))
#define KLD(sl, d0) do { const unsigned a_ = kl0 + (sl) + (unsigned)koff[d0]; kf[2 * (d0)] = *(const __attribute__((address_space(3))) bf16x8*)(uintptr_t)a_; kf[2 * (d0) + 1] = *(const __attribute__((address_space(3))) bf16x8*)(uintptr_t)(a_ + 4096u); } while (0)
#define QLD() do { _Pragma("unroll") for (int d0 = 0; d0 < 4; ++d0) qr[d0] = *(const __attribute__((address_space(3))) bf16x8*)(qp + d0 * 1024); } while (0)
#define VR4(g) do { vlo[(g) % 3] = vtr(vp_ + (((g) & 3) * 4096 + ((g) >> 2) * 1024)); vhi[(g) % 3] = vtr(vp_ + (((g) & 3) * 4096 + ((g) >> 2) * 1024 + 512)); } while (0)
#define VF4(g) (bf16x8){vlo[(g) % 3][0], vlo[(g) % 3][1], vlo[(g) % 3][2], vlo[(g) % 3][3], vhi[(g) % 3][0], vhi[(g) % 3][1], vhi[(g) % 3][2], vhi[(g) % 3][3]}
#define PKW(P, i) cvtpk(P[i], P[i + 1])
#define EX(v) __builtin_amdgcn_exp2f(v)
#define SINIT(C0, C1, t) do { const float c_ = slope2 * (float)((t) * 64 - q0w) - mhat; const float b0_ = hi ? c_ : 1.0f, b1_ = hi ? c_ + slope2 * 32.f : 1.0f; \
        C0 = __builtin_amdgcn_mfma_f32_32x32x2f32(akey, b0_, f32x16{}, 0, 0, 0); C1 = __builtin_amdgcn_mfma_f32_32x32x2f32(akey, b1_, f32x16{}, 0, 0, 0); } while (0)
#define DECIDE(C0, C1, t) do { if ((t) * 64 + 63 > q0w) { const int qh_ = q0w + r32 - (t) * 64 - 4 * hi; \
            _Pragma("unroll") for (int r = 0; r < 16; ++r) { const int kc = (r & 3) + 8 * (r >> 2); if (kc > qh_) C0[r] = -INFINITY; if (kc + 32 > qh_) C1[r] = -INFINITY; } } \
        C1[15] += 0.0f; C0[15] += 0.0f; AT_SB(); \
        float rm_; { float m0 = max3f(C0[0], C0[1], C1[0]), m1 = max3f(C0[2], C0[3], C1[1]); m0 = max3f(m0, C1[2], C1[3]); \
            _Pragma("unroll") for (int r = 4; r < 16; r += 4) { m0 = max3f(m0, C0[r], C0[r + 1]); m1 = max3f(m1, C0[r + 2], C0[r + 3]); m0 = max3f(m0, C1[r], C1[r + 1]); m1 = max3f(m1, C1[r + 2], C1[r + 3]); } \
            const float a_ = fmaxf(m0, m1); auto rr_ = __builtin_amdgcn_permlane32_swap(__float_as_uint(a_), __float_as_uint(a_), false, false); rm_ = fmaxf(__uint_as_float(rr_[0]), __uint_as_float(rr_[1])); } \
        resc = false; if (__any(rm_ > THR)) { const float dl_ = fmaxf(rm_, 0.f); mhat += dl_; _Pragma("unroll") for (int r = 0; r < 16; ++r) { C0[r] -= dl_; C1[r] -= dl_; } \
            const float f_ = __builtin_amdgcn_exp2f(-dl_); lsum *= f_; if (hi == 0) wsf[r32] = f_; resc = true; } } while (0)
#define RESC() do { if (resc) { asm volatile("s_waitcnt lgkmcnt(0)" ::: "memory"); _Pragma("unroll") for (int r = 0; r < 16; ++r) { const float f_ = (wsf + 4 * hi)[(r & 3) + 8 * (r >> 2)]; o[0][r] *= f_; o[1][r] *= f_; o[2][r] *= f_; o[3][r] *= f_; } } } while (0)
#define GAPA(MF, a0, a1, a2, a3, W0, W1, PW) do { MF; sacc += a0; sacc += a1; sacc += a2; sacc += a3; W0; W1; PIN(PW); PIN(sacc); AT_SB(); } while (0)
#define GB4(g, X, i) do { if ((g) + 2 < 16) { VR4((g) + 2); AT_SB(); } o[(g) & 3] = AT_MFMA(__builtin_bit_cast(bf16x8, pw[(g) >> 2]), VF4(g), o[(g) & 3]); X[i] = EX(X[i]); X[i + 1] = EX(X[i + 1]); PIN(X); AT_SB(); } while (0)
#define KRD(G, d0) do { if (G) { KLD(sl_next, d0); AT_SB(); } } while (0)
#define STEP(C0, C1, P0, P1, t) do { AT_SB(); const lds_cptr vp_ = vp0 + sl_prev; const bool gl_ = (t) + 1 < NT; \
        QLD(); AT_SB(); SINIT(C0, C1, t); AT_SB(); \
        float sacc = P0[0] + P0[1]; \
        GAPA(C0 = AT_MFMA(kf[0], qr[0], C0), P0[2], P0[3], P0[4], P0[5],     pw[0][0] = PKW(P0, 0),  pw[0][1] = PKW(P0, 2),  pw[0]); \
        GAPA(C1 = AT_MFMA(kf[1], qr[0], C1), P0[6], P0[7], P0[8], P0[9],     pw[0][2] = PKW(P0, 4),  pw[0][3] = PKW(P0, 6),  pw[0]); \
        GAPA(C0 = AT_MFMA(kf[2], qr[1], C0), P0[10], P0[11], P0[12], P0[13], pw[1][0] = PKW(P0, 8),  pw[1][1] = PKW(P0, 10), pw[1]); \
        GAPA(C1 = AT_MFMA(kf[3], qr[1], C1), P0[14], P0[15], P1[0], P1[1],   pw[1][2] = PKW(P0, 12), pw[1][3] = PKW(P0, 14), pw[1]); \
        GAPA(C0 = AT_MFMA(kf[4], qr[2], C0), P1[2], P1[3], P1[4], P1[5],     pw[2][0] = PKW(P1, 0),  pw[2][1] = PKW(P1, 2),  pw[2]); \
        GAPA(C1 = AT_MFMA(kf[5], qr[2], C1), P1[6], P1[7], P1[8], P1[9],     pw[2][2] = PKW(P1, 4),  pw[2][3] = PKW(P1, 6),  pw[2]); \
        VR4(0); AT_SB(); GAPA(C0 = AT_MFMA(kf[6], qr[3], C0), P1[10], P1[11], P1[12], P1[13], pw[3][0] = PKW(P1, 8),  pw[3][1] = PKW(P1, 10), pw[3]); \
        VR4(1); AT_SB(); GAPA(C1 = AT_MFMA(kf[7], qr[3], C1), P1[14], P1[15], 0.f, 0.f,       pw[3][2] = PKW(P1, 12), pw[3][3] = PKW(P1, 14), pw[3]); \
        lsum += sacc; \
        if ((t) + 3 < NT) DMA_K((t) + 3, sl_cur); if ((t) + 1 < NT) DMA_V((t) + 1, sl_next); \
        DECIDE(C0, C1, t); AT_SB(); \
        GB4(0, C0, 0);  GB4(1, C0, 2);  KRD(gl_, 0); GB4(2, C0, 4);  GB4(3, C0, 6);  KRD(gl_, 1); GB4(4, C0, 8);  GB4(5, C0, 10); KRD(gl_, 2); GB4(6, C0, 12); GB4(7, C0, 14); KRD(gl_, 3); \
        GB4(8, C1, 0);  GB4(9, C1, 2);  GB4(10, C1, 4); GB4(11, C1, 6); GB4(12, C1, 8); GB4(13, C1, 10); GB4(14, C1, 12); GB4(15, C1, 14); \
        } while (0)
#define ENDW(t) do { if ((t) + 3 < NT) { AT_WAIT_BAR(4); } else if ((t) + 1 < NT) { AT_WAIT_BAR(2); } else { AT_WAIT_BAR(0); } } while (0)
        DMA_K(0, 0); DMA_V(0, 0); DMA_K(1, KSTG); if (NT > 2) DMA_K(2, 2 * KSTG);
        AT_WAIT_BAR(0);
        _Pragma("unroll") for (int d0 = 0; d0 < 4; ++d0) KLD(0u, d0);
        QLD(); SINIT(pA0, pA1, 0);
        _Pragma("unroll") for (int d0 = 0; d0 < 4; ++d0) { pA0 = AT_MFMA(kf[2 * d0], qr[d0], pA0); pA1 = AT_MFMA(kf[2 * d0 + 1], qr[d0], pA1); }
        AT_SB(); DECIDE(pA0, pA1, 0);
        _Pragma("unroll") for (int r = 0; r < 16; ++r) { pA0[r] = EX(pA0[r]); pA1[r] = EX(pA1[r]); }
        AT_WAIT_BAR(0);
        if (3 < NT) DMA_K(3, 0); DMA_V(1, KSTG); ROT();
        _Pragma("unroll") for (int d0 = 0; d0 < 4; ++d0) KLD(sl_cur, d0);
        if (3 < NT) { AT_WAIT_BAR(4); } else { AT_WAIT_BAR(2); }
        { int t = 1;
          for (; t + 1 < NT; t += 2) {
              STEP(pB0, pB1, pA0, pA1, t);     ENDW(t);     RESC(); ROT();
              STEP(pA0, pA1, pB0, pB1, t + 1); ENDW(t + 1); RESC(); ROT(); }
          STEP(pB0, pB1, pA0, pA1, t); ENDW(t); RESC(); ROT(); }
        { float sacc = pB0[0] + pB0[1];
          _Pragma("unroll") for (int r = 2; r < 16; ++r) sacc += pB0[r];
          _Pragma("unroll") for (int r = 0; r < 16; ++r) sacc += pB1[r];
          lsum += sacc;
          pw[0] = (u32x4){PKW(pB0, 0), PKW(pB0, 2), PKW(pB0, 4), PKW(pB0, 6)}; pw[1] = (u32x4){PKW(pB0, 8), PKW(pB0, 10), PKW(pB0, 12), PKW(pB0, 14)};
          pw[2] = (u32x4){PKW(pB1, 0), PKW(pB1, 2), PKW(pB1, 4), PKW(pB1, 6)}; pw[3] = (u32x4){PKW(pB1, 8), PKW(pB1, 10), PKW(pB1, 12), PKW(pB1, 14)};
          const lds_cptr vp_ = vp0 + sl_prev; VR4(0); VR4(1);
          _Pragma("unroll") for (int g = 0; g < 16; ++g) { if (g + 2 < 16) VR4(g + 2); o[g & 3] = AT_MFMA(__builtin_bit_cast(bf16x8, pw[g >> 2]), VF4(g), o[g & 3]); } }
        AT_WAIT_BAR(0);
#undef DMA_K
#undef DMA_V
#undef ROT
#undef PIN
#undef KLD
#undef QLD
#undef VR4
#undef VF4
#undef PKW
#undef EX
#undef SINIT
#undef DECIDE
#undef RESC
#undef GAPA
#undef GB4
#undef KRD
#undef STEP
#undef ENDW
        { auto rr = __builtin_amdgcn_permlane32_swap(__float_as_uint(lsum), __float_as_uint(lsum), false, false); lsum = __uint_as_float(rr[0]) + __uint_as_float(rr[1]); }
        if (hi == 0) wsf[32 + r32] = lsum;
        asm volatile("s_waitcnt lgkmcnt(0)" ::: "memory");
        float rli[16];
#pragma unroll
        for (int r = 0; r < 16; ++r) rli[r] = __builtin_amdgcn_rcpf((wsf + 32 + 4 * hi)[(r & 3) + 8 * (r >> 2)]);
        int le_ = mk_lane(); asm volatile("" : "+v"(le_));
        LAS float* X = (LAS float*)shm + (w4 * 32 + 4 * (le_ >> 5)) * 128 + (le_ & 31);
        if (mh == 1) {
#pragma unroll
            for (int db = 0; db < 4; ++db)
#pragma unroll
                for (int r = 0; r < 16; ++r) X[((r & 3) + 8 * (r >> 2)) * 128 + db * 32] = o[db][r] * rli[r];
        }
        AT_WAIT_BAR(0);
        if (mh == 0) {
            float ssr[16];
#pragma unroll
            for (int r = 0; r < 16; ++r) { float a = 0.f;
#pragma unroll
                for (int db = 0; db < 4; ++db) { const float v = o[db][r] * rli[r] - lam * X[((r & 3) + 8 * (r >> 2)) * 128 + db * 32]; o[db][r] = v; a += v * v; }
                ssr[r] = a; }
#pragma unroll
            for (int r = 0; r < 16; ++r) { float a = ssr[r]; a += mk_shfl_xor(a, 1); a += mk_shfl_xor(a, 2); a += mk_shfl_xor(a, 4); a += mk_shfl_xor(a, 8); a += mk_shfl_xor(a, 16); ssr[r] = rsqrtf(a * (1.0f / 128.0f) + 1e-6f) * (1.0f - P.lam_init); }
            float gsl[4];
#pragma unroll
            for (int db = 0; db < 4; ++db) gsl[db] = ((const GAS float*)P.subln_g)[db * 32 + (le_ & 31)];
            LAS bf16* Y = (LAS bf16*)(shm + OFF_Y) + (w4 * 32 + 4 * (le_ >> 5)) * 128 + (le_ & 31);
#pragma unroll
            for (int db = 0; db < 4; ++db) { const float g = gsl[db];
#pragma unroll
                for (int r = 0; r < 16; ++r) Y[((r & 3) + 8 * (r >> 2)) * 128 + db * 32] = (bf16)f2bf(o[db][r] * ssr[r] * g); }
        }
        AT_WAIT_BAR(0);
        { int tid_ = F.tid; asm volatile("" : "+v"(tid_));
#pragma unroll
        for (int i = 0; i < 4; ++i) { const int id = tid_ + i * 512, row = id >> 4, pc = id & 15;
            const v4u w = *(const LAS v4u*)(shm + OFF_Y + row * 256 + pc * 16);
            *(GAS v4u*)(YC + (rowb + q0 + row) * YP + h * 128 + pc * 8) = w; } }
        AT_WAIT_BAR(0);
    }
}
__device__ __forceinline__ void ph_moba_mfma(Frame& F) {
    using namespace at;
    const int wid = F.wave;
    LAS unsigned char* shm = F.lds + RING_OFF; const unsigned lds0 = (unsigned)(uintptr_t)shm;
    constexpr int KSTG = 8192, VSTG = 8192, OFF_V = 3 * KSTG, OFF_WS = OFF_V + 4 * VSTG, OFF_Q = OFF_WS + 4096, OFF_KM = OFF_Q + 32768, OFF_MSK = OFF_KM + 4096;
    LAS float* wsf = (LAS float*)(shm + OFF_WS) + wid * 64;
    const bf16* QA = (const bf16*)(F.ws + WS_QA); const bf16* KA = (const bf16*)(F.ws + WS_KA); const bf16* VA = (const bf16*)(F.ws + WS_VA); bf16* YA = (bf16*)(F.ws + WS_YA);
    const float* KM = (const float*)(F.ws + WS_KMEAN);
    const lds_cptr kp0 = (lds_cptr)shm;
    for (int idx = F.vcu, it_ = 0; idx < BATCH * MOBA_H * MOBA_NB; idx += F.G, ++it_) {
        int bh = idx % (BATCH * MOBA_H), j = idx / (BATCH * MOBA_H), blk = (j < 8) ? 15 - j : j - 8;
        if (F.G == 256) { const int xcd = F.vcu >> 5, w = F.vcu & 31; bh = 4 * xcd + (w >> 3); blk = it_ == 0 ? 15 - (w & 7) : (w & 7); }
        const int b = bh / MOBA_H, h = bh % MOBA_H, q0 = blk * 256, q0w = q0 + wid * 32;
        const float slope2 = exp2f(-(float)(h + 1)) * LOG2E;
        const size_t rowb = (size_t)b * SEQ;
        int lu = mk_lane(), tu = wid * 64 + lu; asm volatile("" : "+v"(lu), "+v"(tu));
        const int lane = lu, r32 = lane & 31, hi = lane >> 5;
        int koff[4];
#pragma unroll
        for (int d0 = 0; d0 < 4; ++d0) koff[d0] = r32 * 128 + (((2 * d0 + hi) ^ ((r32 >> 1) & 7)) << 4);
        const lds_cptr vp0 = (lds_cptr)shm + OFF_V + ((lane >> 4) & 1) * 32 + (lane & 3) * 8 + (4 * hi + ((lane & 15) >> 2)) * 64;
        unsigned long long blist = (unsigned long long)blk; int nb = 1;
        const bf16* ksrc = KA + (rowb + 8 * wid + (lu >> 3)) * 512 + h * 64 + (((lu & 7) ^ (((8 * wid + (lu >> 3)) >> 1) & 7)) << 3);
        const bf16* vsrc = VA + (rowb + 16 * (wid & 3) + (lu >> 2)) * 512 + h * 64 + (wid >> 2) * 32 + (lu & 3) * 8;
#define MB_K0(ti) ((int)((blist >> (4 * ((ti) >> 2))) & 15ull) * 256 + ((ti) & 3) * 64)
#define MB_DMA(ti) do { if (wid < 4) { const size_t go_ = (size_t)MB_K0(ti) * 512;     \
        const unsigned kd_ = (unsigned)__builtin_amdgcn_readfirstlane(lds0 + (unsigned)((ti) % 3) * KSTG + wid * 1024), vd_ = (unsigned)__builtin_amdgcn_readfirstlane(lds0 + OFF_V + (unsigned)((ti) & 3) * VSTG + wid * 1024); \
        glds16(ksrc + go_, kd_); glds16(vsrc + go_, vd_); glds16(ksrc + go_ + 32 * 512, kd_ + 4096); glds16(vsrc + go_ + 32, vd_ + 4096); } } while (0)
        MB_DMA(0); MB_DMA(1);
        { LAS float* Km = (LAS float*)(shm + OFF_KM);
#pragma unroll
          for (int i = 0; i < 2; ++i) Km[tu + i * 512] = KM[(size_t)bh * MOBA_NB * 64 + tu + i * 512];
          if (tu == 0) *(LAS unsigned*)(shm + OFF_MSK) = 0u; }
        bf16x8 qf[4];
        { const bf16* Qw = QA + (rowb + q0w + (lu & 31)) * 512 + h * 64;
#pragma unroll
          for (int d0 = 0; d0 < 4; ++d0) { qf[d0] = *(const bf16x8*)(Qw + d0 * 16 + (lu >> 5) * 8); *(LAS bf16x8*)(shm + OFF_Q + wid * 4096 + lu * 16 + d0 * 1024) = qf[d0]; } }
        const lds_cptr qp = (lds_cptr)shm + OFF_Q + wid * 4096 + lu * 16;
        AT_WAIT_BAR(0);
        float b0 = -INFINITY, b1 = -INFINITY, b2 = -INFINITY; int i0 = -1, i1 = -1, i2 = -1;
        float qx[32];
#pragma unroll
        for (int d0 = 0; d0 < 4; ++d0)
#pragma unroll
            for (int e = 0; e < 8; ++e) qx[8 * d0 + e] = bf2f((bf16)qf[d0][e]);
        for (int jb0 = 0; jb0 < blk; jb0 += 2) {
            const int jb1 = jb0 + 1 < blk ? jb0 + 1 : jb0; float gg[2];
#pragma unroll
            for (int u2 = 0; u2 < 2; ++u2) { const LAS float* km = (const LAS float*)(shm + OFF_KM) + (u2 ? jb1 : jb0) * 64 + 8 * (lu >> 5); float ga = 0.f, gb = 0.f;
#pragma unroll
                for (int d0 = 0; d0 < 4; ++d0) { const f32x4 k0 = *(const LAS f32x4*)(km + d0 * 16), k1 = *(const LAS f32x4*)(km + d0 * 16 + 4);
                    ga += (qx[8 * d0 + 0] * k0[0] + qx[8 * d0 + 1] * k0[1]) + (qx[8 * d0 + 2] * k0[2] + qx[8 * d0 + 3] * k0[3]);
                    gb += (qx[8 * d0 + 4] * k1[0] + qx[8 * d0 + 5] * k1[1]) + (qx[8 * d0 + 6] * k1[2] + qx[8 * d0 + 7] * k1[3]); }
                gg[u2] = ga + gb; }
#pragma unroll
            for (int u2 = 0; u2 < 2; ++u2) { float g = gg[u2]; const int jb = u2 ? jb1 : jb0;
                { auto rr = __builtin_amdgcn_permlane32_swap(__float_as_uint(g), __float_as_uint(g), false, false); g = __uint_as_float(rr[0]) + __uint_as_float(rr[1]); }
                if (u2 == 0 || jb1 != jb0) { if (g > b0) { b2 = b1; i2 = i1; b1 = b0; i1 = i0; b0 = g; i0 = jb; } else if (g > b1) { b2 = b1; i2 = i1; b1 = g; i1 = jb; } else if (g > b2) { b2 = g; i2 = jb; } } }
        }
        unsigned mym = 0u; if (i0 >= 0) mym |= 1u << i0; if (i1 >= 0) mym |= 1u << i1; if (i2 >= 0) mym |= 1u << i2;
        { unsigned wm = mym;
#pragma unroll
          for (int o_ = 1; o_ < 64; o_ <<= 1) wm |= (unsigned)mk_shfl_xor((int)wm, o_);
          if (lu == 0) atomicOr((unsigned*)(shm + OFF_MSK), wm); }
        AT_WAIT_BAR(0);
        const unsigned wgm = (unsigned)__builtin_amdgcn_readfirstlane(*(volatile LAS unsigned*)(shm + OFF_MSK)) | (1u << blk);
        for (int jb = 0; jb < blk; ++jb) if ((wgm >> jb) & 1u) { blist |= (unsigned long long)jb << (4 * nb); ++nb; }
        const int NTI = 4 * nb;
        f32x16 o[2]; float mhat = 0.f, lsum = 0.f; o[0] = f32x16{}; o[1] = f32x16{};
        u32x4 pw[4]; bool pend = false, presc = false; int pvt = 0; const bool late = wid >= 4;
        for (int t = 0; t <= NTI; ++t) {
            const bool live = t < NTI;
            if (late && live) { AT_WAIT_BAR(0); }
            const int k0 = live ? MB_K0(t) : 0, jb = k0 >> 8; unsigned ks_ = (unsigned)(t % 3) * KSTG; asm volatile("" : "+s"(ks_)); const lds_cptr kp = kp0 + ks_;
            const bool sel = (jb == blk) || ((mym >> jb) & 1u);
            const bool doqk = live && ((jb == blk) ? (k0 <= q0w + 31) : (bool)__any(sel));
            bf16x8 kf[8], qr[4]; s16x4 alo[2], ahv[2], blo[2], bhv[2]; const lds_cptr vp = vp0 + (pvt & 3) * VSTG;
            if (pend) { ld_v<2>(alo, ahv, vp, 0); ld_v<2>(blo, bhv, vp, 1); }
            if (late && doqk) ld_kq(kf, qr, kp, koff, qp);
            AT_SB();
            if (pend) { pv_tile<2>(o, pw, vp, presc, hi, wsf, alo, ahv, blo, bhv); pend = false; }
            if (!late && live) { if (t + 1 < NTI) { AT_WAIT_BAR(4); } else { AT_WAIT_BAR(0); } if (t + 2 < NTI) MB_DMA(t + 2); }
            if (doqk) {
                if (!late) ld_kq(kf, qr, kp, koff, qp);
                presc = qk_softmax<true>(kf, qr, (jb == blk) && (k0 + 63 > q0w), slope2, sel ? slope2 * (float)(k0 - q0w) : -INFINITY, q0w + r32 - k0, hi, r32, mhat, lsum, wsf, pw);
                pend = true; pvt = t; }
        }
        AT_WAIT_BAR(0);
#undef MB_DMA
#undef MB_K0
        { auto rr = __builtin_amdgcn_permlane32_swap(__float_as_uint(lsum), __float_as_uint(lsum), false, false); lsum = __uint_as_float(rr[0]) + __uint_as_float(rr[1]); }
        if (hi == 0) wsf[32 + r32] = lsum;
        asm volatile("s_waitcnt lgkmcnt(0)" ::: "memory");
        { int le_ = mk_lane(); asm volatile("" : "+v"(le_));
          LAS bf16* stg = (LAS bf16*)(shm + OFF_Q + wid * 4096) + (4 * (le_ >> 5)) * 64 + (le_ & 31);
#pragma unroll
          for (int r = 0; r < 16; ++r) { const float il = __builtin_amdgcn_rcpf((wsf + 32 + 4 * (le_ >> 5))[(r & 3) + 8 * (r >> 2)]);
#pragma unroll
              for (int db = 0; db < 2; ++db) stg[((r & 3) + 8 * (r >> 2)) * 64 + db * 32] = (bf16)f2bf(o[db][r] * il); }
          asm volatile("s_waitcnt lgkmcnt(0)" ::: "memory");
          bf16* Ow = YA + (rowb + q0w) * YP + h * 64;
#pragma unroll
          for (int i = 0; i < 4; ++i) { const int row = i * 8 + (le_ >> 3), ch = le_ & 7; const v4u v = *(const LAS v4u*)(shm + OFF_Q + wid * 4096 + row * 128 + ch * 16); *(GAS v4u*)(Ow + (size_t)row * YP + ch * 8) = v; } }
        AT_WAIT_BAR(0);
    }
}
__device__ __forceinline__ void ph_moba_pipe(Frame& F) {
    using namespace at;
    const int wid = F.wave;
    LAS unsigned char* shm = F.lds + RING_OFF; const unsigned lds0 = (unsigned)(uintptr_t)shm;
    constexpr int KSTG = 8192, VSTG = 8192, OFF_V = 3 * KSTG, OFF_WS = OFF_V + 4 * VSTG, OFF_Q = OFF_WS + 4096, OFF_KM = OFF_Q + 32768, OFF_MSK = OFF_KM + 4096;
    LAS float* wsf = (LAS float*)(shm + OFF_WS) + wid * 64;
    const bf16* QA = (const bf16*)(F.ws + WS_QA); const bf16* KA = (const bf16*)(F.ws + WS_KA); const bf16* VA = (const bf16*)(F.ws + WS_VA); bf16* YA = (bf16*)(F.ws + WS_YA);
    const float* KM = (const float*)(F.ws + WS_KMEAN);
    const lds_cptr kp0 = (lds_cptr)shm;
    for (int idx = F.vcu, it_ = 0; idx < BATCH * MOBA_H * MOBA_NB; idx += F.G, ++it_) {
        int bh = idx % (BATCH * MOBA_H), j = idx / (BATCH * MOBA_H), blk = (j < 8) ? 15 - j : j - 8;
        if (F.G == 256) { const int xcd = F.vcu >> 5, w = F.vcu & 31; bh = 4 * xcd + (w >> 3); blk = it_ == 0 ? 15 - (w & 7) : (w & 7); }
        const int b = bh / MOBA_H, h = bh % MOBA_H, q0 = blk * 256, q0w = q0 + wid * 32;
        const float slope2 = exp2f(-(float)(h + 1)) * LOG2E;
        const size_t rowb = (size_t)b * SEQ;
        int lu = mk_lane(), tu = wid * 64 + lu; asm volatile("" : "+v"(lu), "+v"(tu));
        const int lane = lu, r32 = lane & 31, hi = lane >> 5;
        int koff[4];
#pragma unroll
        for (int d0 = 0; d0 < 4; ++d0) koff[d0] = r32 * 128 + (((2 * d0 + hi) ^ ((r32 >> 1) & 7)) << 4);
        const lds_cptr vp0 = (lds_cptr)shm + OFF_V + ((lane >> 4) & 1) * 32 + (lane & 3) * 8 + (4 * hi + ((lane & 15) >> 2)) * 64;
        unsigned long long blist = (unsigned long long)blk; int nb = 1;
        const bf16* ksrc = KA + (rowb + 8 * wid + (lu >> 3)) * 512 + h * 64 + (((lu & 7) ^ (((8 * wid + (lu >> 3)) >> 1) & 7)) << 3);
        const bf16* vsrc = VA + (rowb + 16 * (wid & 3) + (lu >> 2)) * 512 + h * 64 + (wid >> 2) * 32 + (lu & 3) * 8;
#define MB_K0(ti) ((int)((blist >> (4 * ((ti) >> 2))) & 15ull) * 256 + ((ti) & 3) * 64)
#define DMA_K(ti, slot) glds16(ksrc + (size_t)MB_K0(ti) * 512, (unsigned)__builtin_amdgcn_readfirstlane(lds0 + (unsigned)(slot) + wid * 1024))
#define DMA_V(ti, slot) glds16(vsrc + (size_t)MB_K0(ti) * 512, (unsigned)__builtin_amdgcn_readfirstlane(lds0 + OFF_V + (unsigned)(slot) + wid * 1024))
        DMA_K(0, 0); DMA_V(0, 0); DMA_K(1, KSTG); DMA_K(2, 2 * KSTG);
        { LAS float* Km = (LAS float*)(shm + OFF_KM);
          const float km0_ = ((const GAS float*)KM)[(size_t)bh * MOBA_NB * 64 + tu], km1_ = ((const GAS float*)KM)[(size_t)bh * MOBA_NB * 64 + tu + 512];
          __builtin_amdgcn_sched_barrier(0);
          Km[tu] = km0_; Km[tu + 512] = km1_;
          if (tu == 0) *(LAS unsigned*)(shm + OFF_MSK) = 0u; }
        bf16x8 qf[4];
        { const bf16* Qw = QA + (rowb + q0w + (lu & 31)) * 512 + h * 64;
#pragma unroll
          for (int d0 = 0; d0 < 4; ++d0) qf[d0] = *(const GAS bf16x8*)(Qw + d0 * 16 + (lu >> 5) * 8); }
        AT_WAIT_BAR(0);
        float b0 = -INFINITY, b1 = -INFINITY, b2 = -INFINITY; int i0 = -1, i1 = -1, i2 = -1;
        float qx[32];
#pragma unroll
        for (int d0 = 0; d0 < 4; ++d0)
#pragma unroll
            for (int e = 0; e < 8; ++e) qx[8 * d0 + e] = bf2f((bf16)qf[d0][e]);
        for (int jb0 = 0; jb0 < blk; jb0 += 2) {
            const int jb1 = jb0 + 1 < blk ? jb0 + 1 : jb0; float gg[2];
#pragma unroll
            for (int u2 = 0; u2 < 2; ++u2) { const LAS float* km = (const LAS float*)(shm + OFF_KM) + (u2 ? jb1 : jb0) * 64 + 8 * (lu >> 5); float ga = 0.f, gb = 0.f;
#pragma unroll
                for (int d0 = 0; d0 < 4; ++d0) { const f32x4 k0 = *(const LAS f32x4*)(km + d0 * 16), k1 = *(const LAS f32x4*)(km + d0 * 16 + 4);
                    ga += (qx[8 * d0 + 0] * k0[0] + qx[8 * d0 + 1] * k0[1]) + (qx[8 * d0 + 2] * k0[2] + qx[8 * d0 + 3] * k0[3]);
                    gb += (qx[8 * d0 + 4] * k1[0] + qx[8 * d0 + 5] * k1[1]) + (qx[8 * d0 + 6] * k1[2] + qx[8 * d0 + 7] * k1[3]); }
                gg[u2] = ga + gb; }
#pragma unroll
            for (int u2 = 0; u2 < 2; ++u2) { float g = gg[u2]; const int jb = u2 ? jb1 : jb0;
                { auto rr = __builtin_amdgcn_permlane32_swap(__float_as_uint(g), __float_as_uint(g), false, false); g = __uint_as_float(rr[0]) + __uint_as_float(rr[1]); }
                if (u2 == 0 || jb1 != jb0) { if (g > b0) { b2 = b1; i2 = i1; b1 = b0; i1 = i0; b0 = g; i0 = jb; } else if (g > b1) { b2 = b1; i2 = i1; b1 = g; i1 = jb; } else if (g > b2) { b2 = g; i2 = jb; } } }
        }
        unsigned mym = 0u; if (i0 >= 0) mym |= 1u << i0; if (i1 >= 0) mym |= 1u << i1; if (i2 >= 0) mym |= 1u << i2;
        { unsigned wm = mym;
#pragma unroll
          for (int o_ = 1; o_ < 64; o_ <<= 1) wm |= (unsigned)mk_shfl_xor((int)wm, o_);
          if (lu == 0) atomicOr((unsigned*)(shm + OFF_MSK), wm); }
        AT_WAIT_BAR(0);
        const unsigned wgm = (unsigned)__builtin_amdgcn_readfirstlane(*(volatile LAS unsigned*)(shm + OFF_MSK)) | (1u << blk);
        for (int jb = 0; jb < blk; ++jb) if ((wgm >> jb) & 1u) { blist |= (unsigned long long)jb << (4 * nb); ++nb; }
        const int NTI = 4 * nb;
        f32x16 o[2]; float mhat = 0.f, lsum = 0.f; o[0] = f32x16{}; o[1] = f32x16{};
        f32x16 pA0, pA1, pB0, pB1; bf16x8 kf[8]; s16x4 vlo[8], vhi[8]; u32x4 pw0, pw1, pw2, pw3; bool resc = false;
        const float akey = hi ? 1.0f : slope2 * (float)r32;
        unsigned sl_prev = 0u, sl_cur = 0u, sl_next = KSTG;
#define ROT() do { sl_prev = sl_cur; sl_cur = sl_next; sl_next = (sl_next == 2u * KSTG) ? 0u : sl_next + KSTG; } while (0)
#define PIN(x) asm volatile("" : "+v"(x))
#define KLD(sl, d0) do { const unsigned a_ = lds0 + (sl) + (unsigned)koff[d0]; kf[2 * (d0)] = *(const __attribute__((address_space(3))) bf16x8*)(uintptr_t)a_; kf[2 * (d0) + 1] = *(const __attribute__((address_space(3))) bf16x8*)(uintptr_t)(a_ + 4096u); } while (0)
#define VRD(i) do { vlo[i] = vtr(vp_ + (((i) >> 2) * 4096 + ((i) & 3) * 1024)); vhi[i] = vtr(vp_ + (((i) >> 2) * 4096 + ((i) & 3) * 1024 + 512)); } while (0)
#define VFR(i) (bf16x8){vlo[i][0], vlo[i][1], vlo[i][2], vlo[i][3], vhi[i][0], vhi[i][1], vhi[i][2], vhi[i][3]}
#define PKW(P, i) cvtpk(P[i], P[i + 1])
#define PAF(k) __builtin_bit_cast(bf16x8, pw##k)
#define EX(v) __builtin_amdgcn_exp2f(v)
#define SINIT(C0, C1, t) do { const int k0_ = MB_K0(t), jb_ = k0_ >> 8; const bool sel_ = (jb_ == blk) || ((mym >> jb_) & 1u); const float c_ = (sel_ ? slope2 * (float)(k0_ - q0w) : -INFINITY) - mhat; \
        const float b0_ = hi ? c_ : 1.0f, b1_ = hi ? c_ + slope2 * 32.f : 1.0f; C0 = __builtin_amdgcn_mfma_f32_32x32x2f32(akey, b0_, f32x16{}, 0, 0, 0); C1 = __builtin_amdgcn_mfma_f32_32x32x2f32(akey, b1_, f32x16{}, 0, 0, 0); } while (0)
#define DECIDE(C0, C1, t) do { if ((t) < 4) { const int qh_ = q0w + r32 - MB_K0(t) - 4 * hi; \
            _Pragma("unroll") for (int r = 0; r < 16; ++r) { const int kc = (r & 3) + 8 * (r >> 2); if (kc > qh_) C0[r] = -INFINITY; if (kc + 32 > qh_) C1[r] = -INFINITY; } } \
        C1[15] += 0.0f; C0[15] += 0.0f; AT_SB(); \
        float rm_; { float m0 = max3f(C0[0], C0[1], C1[0]), m1 = max3f(C0[2], C0[3], C1[1]); m0 = max3f(m0, C1[2], C1[3]); \
            _Pragma("unroll") for (int r = 4; r < 16; r += 4) { m0 = max3f(m0, C0[r], C0[r + 1]); m1 = max3f(m1, C0[r + 2], C0[r + 3]); m0 = max3f(m0, C1[r], C1[r + 1]); m1 = max3f(m1, C1[r + 2], C1[r + 3]); } \
            const float a_ = fmaxf(m0, m1); auto rr_ = __builtin_amdgcn_permlane32_swap(__float_as_uint(a_), __float_as_uint(a_), false, false); rm_ = fmaxf(__uint_as_float(rr_[0]), __uint_as_float(rr_[1])); } \
        resc = false; if (__any(rm_ > THR)) { const float dl_ = fmaxf(rm_, 0.f); mhat += dl_; _Pragma("unroll") for (int r = 0; r < 16; ++r) { C0[r] -= dl_; C1[r] -= dl_; } \
            const float f_ = __builtin_amdgcn_exp2f(-dl_); lsum *= f_; if (hi == 0) wsf[r32] = f_; resc = true; } } while (0)
#define RESC() do { if (resc) { asm volatile("s_waitcnt lgkmcnt(0)" ::: "memory"); _Pragma("unroll") for (int r = 0; r < 16; ++r) { const float f_ = (wsf + 4 * hi)[(r & 3) + 8 * (r >> 2)]; o[0][r] *= f_; o[1][r] *= f_; } } } while (0)
#define GAPA(MF, a0, a1, a2, a3, W0, W1, PW) do { MF; sacc += a0; sacc += a1; sacc += a2; sacc += a3; W0; W1; PIN(PW); PIN(sacc); AT_SB(); } while (0)
#define GAPB(MF, X, i) do { MF; X[i] = EX(X[i]); X[i + 1] = EX(X[i + 1]); X[i + 2] = EX(X[i + 2]); X[i + 3] = EX(X[i + 3]); PIN(X); AT_SB(); } while (0)
#define KRD(G, d0) do { if (G) { KLD(sl_next, d0); AT_SB(); } } while (0)
#define STEP(C0, C1, P0, P1, t) do { AT_SB(); const lds_cptr vp_ = vp0 + sl_prev; const bool gl_ = (t) + 1 < NTI; \
        SINIT(C0, C1, t); AT_SB(); \
        VRD(0); AT_SB(); float sacc = P0[0] + P0[1]; \
                         GAPA(C0 = AT_MFMA(kf[0], qf[0], C0), P0[2], P0[3], P0[4], P0[5],     pw0[0] = PKW(P0, 0),  pw0[1] = PKW(P0, 2),  pw0); \
        VRD(4); AT_SB(); GAPA(C1 = AT_MFMA(kf[1], qf[0], C1), P0[6], P0[7], P0[8], P0[9],     pw0[2] = PKW(P0, 4),  pw0[3] = PKW(P0, 6),  pw0); \
        VRD(1); AT_SB(); GAPA(C0 = AT_MFMA(kf[2], qf[1], C0), P0[10], P0[11], P0[12], P0[13], pw1[0] = PKW(P0, 8),  pw1[1] = PKW(P0, 10), pw1); \
        VRD(5); AT_SB(); GAPA(C1 = AT_MFMA(kf[3], qf[1], C1), P0[14], P0[15], P1[0], P1[1],   pw1[2] = PKW(P0, 12), pw1[3] = PKW(P0, 14), pw1); \
        VRD(2); AT_SB(); GAPA(C0 = AT_MFMA(kf[4], qf[2], C0), P1[2], P1[3], P1[4], P1[5],     pw2[0] = PKW(P1, 0),  pw2[1] = PKW(P1, 2),  pw2); \
        VRD(6); AT_SB(); GAPA(C1 = AT_MFMA(kf[5], qf[2], C1), P1[6], P1[7], P1[8], P1[9],     pw2[2] = PKW(P1, 4),  pw2[3] = PKW(P1, 6),  pw2); \
        VRD(3); AT_SB(); GAPA(C0 = AT_MFMA(kf[6], qf[3], C0), P1[10], P1[11], P1[12], P1[13], pw3[0] = PKW(P1, 8),  pw3[1] = PKW(P1, 10), pw3); \
        VRD(7); AT_SB(); GAPA(C1 = AT_MFMA(kf[7], qf[3], C1), P1[14], P1[15], 0.f, 0.f,       pw3[2] = PKW(P1, 12), pw3[3] = PKW(P1, 14), pw3); \
        lsum += sacc; \
        if ((t) + 3 < NTI) DMA_K((t) + 3, sl_cur); if ((t) + 1 < NTI) DMA_V((t) + 1, sl_next);        \
        DECIDE(C0, C1, t); AT_SB(); \
        GAPB(o[0] = AT_MFMA(PAF(0), VFR(0), o[0]), C0, 0);               GAPB(o[1] = AT_MFMA(PAF(0), VFR(4), o[1]), C0, 4); \
        KRD(gl_, 0); GAPB(o[0] = AT_MFMA(PAF(1), VFR(1), o[0]), C0, 8);  KRD(gl_, 1); GAPB(o[1] = AT_MFMA(PAF(1), VFR(5), o[1]), C0, 12); \
        KRD(gl_, 2); GAPB(o[0] = AT_MFMA(PAF(2), VFR(2), o[0]), C1, 0);  KRD(gl_, 3); GAPB(o[1] = AT_MFMA(PAF(2), VFR(6), o[1]), C1, 4); \
        GAPB(o[0] = AT_MFMA(PAF(3), VFR(3), o[0]), C1, 8);               GAPB(o[1] = AT_MFMA(PAF(3), VFR(7), o[1]), C1, 12); \
        } while (0)
#define ENDW(t) do { if ((t) + 3 < NTI) { AT_WAIT_BAR(2); } else if ((t) + 1 < NTI) { AT_WAIT_BAR(1); } else { AT_WAIT_BAR(0); } } while (0)
        _Pragma("unroll") for (int d0 = 0; d0 < 4; ++d0) KLD(0u, d0);
        SINIT(pA0, pA1, 0);
        _Pragma("unroll") for (int d0 = 0; d0 < 4; ++d0) { pA0 = AT_MFMA(kf[2 * d0], qf[d0], pA0); pA1 = AT_MFMA(kf[2 * d0 + 1], qf[d0], pA1); }
        AT_SB(); DECIDE(pA0, pA1, 0);
        _Pragma("unroll") for (int r = 0; r < 16; ++r) { pA0[r] = EX(pA0[r]); pA1[r] = EX(pA1[r]); }
        AT_WAIT_BAR(0);
        DMA_K(3, 0); DMA_V(1, KSTG); ROT();
        _Pragma("unroll") for (int d0 = 0; d0 < 4; ++d0) KLD(sl_cur, d0);
        AT_WAIT_BAR(2);
        { int t = 1;
          for (; t + 1 < NTI; t += 2) {
              STEP(pB0, pB1, pA0, pA1, t);     ENDW(t);     RESC(); ROT();
              STEP(pA0, pA1, pB0, pB1, t + 1); ENDW(t + 1); RESC(); ROT(); }
          STEP(pB0, pB1, pA0, pA1, t); ENDW(t); RESC(); ROT(); }
        { float sacc = pB0[0] + pB0[1];
          _Pragma("unroll") for (int r = 2; r < 16; ++r) sacc += pB0[r];
          _Pragma("unroll") for (int r = 0; r < 16; ++r) sacc += pB1[r];
          lsum += sacc;
          pw0 = (u32x4){PKW(pB0, 0), PKW(pB0, 2), PKW(pB0, 4), PKW(pB0, 6)}; pw1 = (u32x4){PKW(pB0, 8), PKW(pB0, 10), PKW(pB0, 12), PKW(pB0, 14)};
          pw2 = (u32x4){PKW(pB1, 0), PKW(pB1, 2), PKW(pB1, 4), PKW(pB1, 6)}; pw3 = (u32x4){PKW(pB1, 8), PKW(pB1, 10), PKW(pB1, 12), PKW(pB1, 14)};
          const lds_cptr vp_ = vp0 + sl_prev; _Pragma("unroll") for (int i = 0; i < 8; ++i) VRD(i);
          o[0] = AT_MFMA(PAF(0), VFR(0), o[0]); o[1] = AT_MFMA(PAF(0), VFR(4), o[1]); o[0] = AT_MFMA(PAF(1), VFR(1), o[0]); o[1] = AT_MFMA(PAF(1), VFR(5), o[1]);
          o[0] = AT_MFMA(PAF(2), VFR(2), o[0]); o[1] = AT_MFMA(PAF(2), VFR(6), o[1]); o[0] = AT_MFMA(PAF(3), VFR(3), o[0]); o[1] = AT_MFMA(PAF(3), VFR(7), o[1]); }
        AT_WAIT_BAR(0);
#undef DMA_K
#undef DMA_V
#undef ROT
#undef PIN
#undef KLD
#undef VRD
#undef VFR
#undef PKW
#undef PAF
#undef EX
#undef SINIT
#undef DECIDE
#undef RESC
#undef GAPA
#undef GAPB
#undef KRD
#undef STEP
#undef ENDW
#undef MB_K0
        { auto rr = __builtin_amdgcn_permlane32_swap(__float_as_uint(lsum), __float_as_uint(lsum), false, false); lsum = __uint_as_float(rr[0]) + __uint_as_float(rr[1]); }
        if (hi == 0) wsf[32 + r32] = lsum;
        asm volatile("s_waitcnt lgkmcnt(0)" ::: "memory");
        { int le_ = mk_lane(); asm volatile("" : "+v"(le_));
          LAS bf16* stg = (LAS bf16*)(shm + OFF_Q + wid * 4096) + (4 * (le_ >> 5)) * 64 + (le_ & 31);
#pragma unroll
          for (int r = 0; r < 16; ++r) { const float il = __builtin_amdgcn_rcpf((wsf + 32 + 4 * (le_ >> 5))[(r & 3) + 8 * (r >> 2)]);
#pragma unroll
              for (int db = 0; db < 2; ++db) stg[((r & 3) + 8 * (r >> 2)) * 64 + db * 32] = (bf16)f2bf(o[db][r] * il); }
          asm volatile("s_waitcnt lgkmcnt(0)" ::: "memory");
          bf16* Ow = YA + (rowb + q0w) * YP + h * 64;
#pragma unroll
          for (int i = 0; i < 4; ++i) { const int row = i * 8 + (le_ >> 3), ch = le_ & 7; const v4u v = *(const LAS v4u*)(shm + OFF_Q + wid * 4096 + row * 128 + ch * 16); *(GAS v4u*)(Ow + (size_t)row * YP + ch * 8) = v; } }
        AT_WAIT_BAR(0);
    }
}
__device__ __forceinline__ void ph_moba_naive(Frame& F) {
    LAS float* Ks = (LAS float*)(F.lds + RING_OFF); LAS float* Vs = Ks + 64 * 64; LAS float* Km = Vs + 64 * 64; LAS unsigned* msk = (LAS unsigned*)(Km + MOBA_NB * 64);
    const bf16* QA = (const bf16*)(F.ws + WS_QA); const bf16* KA = (const bf16*)(F.ws + WS_KA); const bf16* VA = (const bf16*)(F.ws + WS_VA); bf16* YA = (bf16*)(F.ws + WS_YA);
    const float* KM = (const float*)(F.ws + WS_KMEAN);
    const int row = F.tid >> 2, qd = F.tid & 3;
    for (int idx = F.vcu; idx < BATCH * MOBA_H * 32; idx += F.G) {
        int bh, qt; causal_unit(idx, BATCH * MOBA_H, true, bh, qt);
        const int b = bh / MOBA_H, h = bh % MOBA_H, blk = qt >> 1; const int qpos = qt * 128 + row; const size_t grow = (size_t)b * SEQ + qpos;
        const float slope2 = exp2f(-(float)(h + 1)) * LOG2E;
        __syncthreads();
        for (int i = F.tid; i < MOBA_NB * 64; i += NWAVES * 64) Km[i] = KM[(size_t)bh * MOBA_NB * 64 + i];
        if (F.tid == 0) msk[0] = 0u;
        __syncthreads();
        float q[16]; load_q16(q, QA + grow * 512 + h * 64 + qd * 16);
        float b0 = -INFINITY, b1 = -INFINITY, b2 = -INFINITY; int i0 = -1, i1 = -1, i2 = -1;
        for (int j = 0; j < blk; ++j) { float g = 0.f;
#pragma unroll
            for (int d = 0; d < 16; ++d) g += q[d] * Km[j * 64 + qd * 16 + d];
            g += mk_shfl_xor(g, 1); g += mk_shfl_xor(g, 2);
            if (g > b0) { b2 = b1; i2 = i1; b1 = b0; i1 = i0; b0 = g; i0 = j; } else if (g > b1) { b2 = b1; i2 = i1; b1 = g; i1 = j; } else if (g > b2) { b2 = g; i2 = j; } }
        unsigned mym = 0u; if (i0 >= 0) mym |= 1u << i0; if (i1 >= 0) mym |= 1u << i1; if (i2 >= 0) mym |= 1u << i2;
        atomicOr((unsigned*)msk, mym);
        __syncthreads();
        const unsigned wgm = msk[0];
        float o[16]; float mr = -INFINITY, lr = 0.f;
#pragma unroll
        for (int d = 0; d < 16; ++d) o[d] = 0.f;
        for (int jb = blk; jb >= 0; --jb) {
            if (jb != blk && !((wgm >> jb) & 1u)) continue;
            const bool mine = (jb == blk) || ((mym >> jb) & 1u);
            const int ktop = (jb == blk) ? (2 * (qt & 1) + 1) : 3;
            for (int kt = ktop; kt >= 0; --kt) {
                __syncthreads();
                const size_t krow = (size_t)b * SEQ + jb * 256 + kt * 64;
                naive_stage<64>(F, Ks, Vs, KA + krow * 512 + h * 64, VA + krow * 512 + h * 64);
                __syncthreads();
                naive_tile<16, 64>(Ks, Vs, q, o, mr, lr, qpos, jb * 256 + kt * 64, slope2, mine, qd);
            }
        }
        const float il = __builtin_amdgcn_rcpf(lr); bf16* yp = YA + grow * YP + h * 64 + qd * 16;
#pragma unroll
        for (int d = 0; d < 16; d += 8) { v4u w; w.x = pk2(o[d] * il, o[d + 1] * il); w.y = pk2(o[d + 2] * il, o[d + 3] * il); w.z = pk2(o[d + 4] * il, o[d + 5] * il); w.w = pk2(o[d + 6] * il, o[d + 7] * il); *(GAS v4u*)(yp + d) = w; }
    }
    __syncthreads();
}
template <bool FIX> __device__ __forceinline__ void ph_rglru_mfma(Frame& F, const RgP& P) {
    using namespace at;
    const int wid = F.wave;
    constexpr int OFF_CT = 16384, OFF_RAW = 18432, RAWB = 9216;
    LAS unsigned char* shm = F.lds + RING_OFF; const unsigned lds0 = (unsigned)(uintptr_t)shm;
    LAS unsigned char* wfr = shm; LAS float* ctab = (LAS float*)(shm + OFF_CT); const lds_cptr rawp = (lds_cptr)shm + OFF_RAW + wid * RAWB;
    const bf16* RX = (const bf16*)(F.ws + WS_RX); const bf16* RG = (const bf16*)(F.ws + WS_RG); bf16* YB = (bf16*)(F.ws + WS_YB);
    bf16* XRp = (bf16*)(F.ws + WS_MG);
    float* AG = (float*)(F.ws + WS_AGG); float* BG = AG + (size_t)BATCH * RG_NCH * D; const float* CI = (const float*)(F.ws + WS_CARRY);
    const bf16* WT = (const bf16*)(F.ws + WS_RGW);
    const bf16* ZR = (const bf16*)(F.ws + 640 * 1024);
    const bool grp = (F.G % RG_NB) == 0;
    const int nstart = grp ? F.vcu % RG_NB : 0, nstep = grp ? RG_NB : 1, wn = grp ? (F.vcu / RG_NB) * NWAVES + wid : F.vcu * NWAVES + wid, NWn = grp ? (F.G / RG_NB) * NWAVES : F.G * NWAVES;
    for (int n = nstart; n < RG_NB; n += nstep) {
        __syncthreads();
        const bf16* SRCX = FIX ? XRp : RX; constexpr int HAL = FIX ? 0 : 3, NPC = FIX ? 8 : 9;
#define RG_DMA(Q_) do { const int b_ = (Q_) / RG_NCH, c_ = (Q_) % RG_NCH; int ld_ = mk_lane(); \
            _Pragma("unroll") for (int i = 0; i < NPC; ++i) { const int br = 8 * i + (ld_ >> 3), chunk = (ld_ & 7) ^ ((br >> 1) & 7); int trow = c_ * RG_CHUNK - HAL + br; const int tmax = c_ * RG_CHUNK + RG_CHUNK - 1; \
                const bf16* src = trow >= 0 ? SRCX + ((size_t)b_ * SEQ + (trow > tmax ? tmax : trow)) * D + n * 64 + chunk * 8 : ZR + chunk * 8; \
                glds16(src, (unsigned)__builtin_amdgcn_readfirstlane(lds0 + OFF_RAW + wid * RAWB + i * 1024)); } } while (0)
        const bool blocked = FIX && ((BATCH * RG_NCH) % NWn == 0);
        const int upw = blocked ? (BATCH * RG_NCH) / NWn : 0, qstep = blocked ? 1 : NWn, qbeg = blocked ? wn * upw : wn, qend = blocked ? qbeg + upw : BATCH * RG_NCH;
        if (qbeg < qend) RG_DMA(qbeg);
        float ba[2], bx[2], c8[2];
        { int t_ = wid * 64 + mk_lane(); asm volatile("" : "+v"(t_));
          bf16x8 wv_[2]; float ctv_ = 0.f, pa_[2], px_[2], pl_[2];
#pragma unroll
          for (int i = 0; i < 2; ++i) { const int p = t_ + i * 512, f = p >> 6, ln = p & 63, ct = f >> 3, g = (f >> 2) & 1, ks = f & 3;
              wv_[i] = *(const GAS bf16x8*)(WT + ((size_t)(g * RG_NB + n) * 64 + 32 * ct + (ln & 31)) * 64 + 16 * ks + 8 * (ln >> 5)); }
          if (!FIX && t_ < 320) ctv_ = t_ < 256 ? ((const GAS float*)P.conv_w)[(t_ >> 6) * D + n * 64 + (t_ & 63)] : ((const GAS float*)P.conv_b)[n * 64 + (t_ & 63)];
#pragma unroll
          for (int ct = 0; ct < 2; ++ct) { const int ch = n * 64 + 32 * ct + (t_ & 31); pa_[ct] = ((const GAS float*)P.b_a)[ch]; px_[ct] = ((const GAS float*)P.b_x)[ch]; pl_[ct] = ((const GAS float*)P.lam)[ch]; }
          __builtin_amdgcn_sched_barrier(0);
#pragma unroll
          for (int i = 0; i < 2; ++i) *(LAS bf16x8*)(wfr + (t_ + i * 512) * 16) = wv_[i];
          if (!FIX && t_ < 320) ctab[t_] = ctv_;
#pragma unroll
          for (int ct = 0; ct < 2; ++ct) { ba[ct] = -pa_[ct] * LOG2E; bx[ct] = -px_[ct] * LOG2E; c8[ct] = -8.0f * log1pf(expf(-pl_[ct])) * LOG2E; } }
        __syncthreads();
        int prevq = -2; float hprev[2] = {0.f, 0.f};
        for (int q = qbeg; q < qend; q += qstep) {
            const int c = q % RG_NCH, b = q / RG_NCH;
            const int lq_ = mk_lane(), r32o = lq_ & 31, hio = lq_ >> 5;
            const size_t rb = (size_t)b * SEQ; const size_t aidx = ((size_t)b * RG_NCH + c) * D + n * 64 + r32o;
            float h[2] = {0.f, 0.f}, pa[2] = {1.f, 1.f};
            if (FIX && c != 0) {
                if (q == prevq + 1) { h[0] = hprev[0]; h[1] = hprev[1]; }
                else { const float* Ap = AG + (size_t)b * RG_NCH * D + n * 64 + r32o; const float* Bp = BG + (size_t)b * RG_NCH * D + n * 64 + r32o;
                    for (int k0 = 0; k0 < c; k0 += 16) { float a0[16], b0[16], a1[16], b1[16];
#pragma unroll
                        for (int j = 0; j < 16; ++j) { const size_t o_ = (size_t)(k0 + j < c ? k0 + j : 0) * D; a0[j] = ((const GAS float*)Ap)[o_]; b0[j] = ((const GAS float*)Bp)[o_]; a1[j] = ((const GAS float*)Ap)[o_ + 32]; b1[j] = ((const GAS float*)Bp)[o_ + 32]; }
                        __builtin_amdgcn_sched_barrier(0);
#pragma unroll
                        for (int j = 0; j < 16; ++j) { const bool ok = k0 + j < c; h[0] = (ok ? a0[j] : 1.f) * h[0] + (ok ? b0[j] : 0.f); h[1] = (ok ? a1[j] : 1.f) * h[1] + (ok ? b1[j] : 0.f); } } } }
            asm volatile("s_waitcnt vmcnt(0)" ::: "memory");
#pragma unroll 1
            for (int tt = 0; tt < 2; ++tt) {
                const int t0 = c * RG_CHUNK + tt * 32;
                int lt_ = mk_lane(); const int r32 = lt_ & 31, hi = lt_ >> 5;
                bf16x8 Af[4];
#pragma unroll
                for (int ks = 0; ks < 4; ++ks) { const int cc = 16 * ks + 8 * hi; float x8[8];
                    if (FIX) { const int br = tt * 32 + r32; Af[ks] = *(const LAS bf16x8*)(rawp + br * 128 + (((2 * ks + hi) ^ ((br >> 1) & 7)) << 4)); continue; }
                    { const f32x4 b0 = *(const LAS f32x4*)(ctab + 256 + cc), b1 = *(const LAS f32x4*)(ctab + 256 + cc + 4); x8[0] = b0[0]; x8[1] = b0[1]; x8[2] = b0[2]; x8[3] = b0[3]; x8[4] = b1[0]; x8[5] = b1[1]; x8[6] = b1[2]; x8[7] = b1[3]; }
#pragma unroll
                    for (int j = 0; j < 4; ++j) { const int br = tt * 32 + r32 + j; const v4u w = *(const LAS v4u*)(rawp + br * 128 + (((2 * ks + hi) ^ ((br >> 1) & 7)) << 4));
                        const f32x4 w0 = *(const LAS f32x4*)(ctab + j * 64 + cc), w1 = *(const LAS f32x4*)(ctab + j * 64 + cc + 4);
                        x8[0] += w0[0] * bf_lo(w.x); x8[1] += w0[1] * bf_hi(w.x); x8[2] += w0[2] * bf_lo(w.y); x8[3] += w0[3] * bf_hi(w.y);
                        x8[4] += w1[0] * bf_lo(w.z); x8[5] += w1[1] * bf_hi(w.z); x8[6] += w1[2] * bf_lo(w.w); x8[7] += w1[3] * bf_hi(w.w); }
                    const u32x4 pk = (u32x4){cvtpk(x8[0], x8[1]), cvtpk(x8[2], x8[3]), cvtpk(x8[4], x8[5]), cvtpk(x8[6], x8[7])}; Af[ks] = __builtin_bit_cast(bf16x8, pk);
                    *(GAS u32x4*)(XRp + ((size_t)b * SEQ + c * RG_CHUNK + tt * 32 + r32) * D + n * 64 + cc) = pk;
                    }
                if (tt == 1 && q + qstep < qend) { asm volatile("s_waitcnt lgkmcnt(0)" ::: "memory"); RG_DMA(q + qstep); }
#pragma unroll
            for (int ct = 0; ct < 2; ++ct) {
                bf16 rgv[16];
                if (FIX) { const GAS bf16* rgp = (const GAS bf16*)RG + (rb + t0 + 4 * hi) * D + n * 64 + 32 * ct + r32;
#pragma unroll
                    for (int r = 0; r < 16; ++r) rgv[r] = rgp[(size_t)((r & 3) + 8 * (r >> 2)) * D];
                    __builtin_amdgcn_sched_barrier(0); }
                f32x16 accr = f32x16{}, acci = f32x16{}, accx = f32x16{};
                { bf16x8 Br[4], Bi[4];
#pragma unroll
                  for (int ks = 0; ks < 4; ++ks) { Br[ks] = *(const LAS bf16x8*)(wfr + ((ct * 2 + 0) * 4 + ks) * 1024 + lt_ * 16); Bi[ks] = *(const LAS bf16x8*)(wfr + ((ct * 2 + 1) * 4 + ks) * 1024 + lt_ * 16); }
#pragma unroll
                  for (int ks = 0; ks < 4; ++ks) { accr = AT_MFMA(Af[ks], Br[ks], accr); acci = AT_MFMA(Af[ks], Bi[ks], acci); } }
#pragma unroll
                for (int kk = 0; kk < 2; ++kk) { const int ks = 2 * ct + kk; bf16x8 idf;
#pragma unroll
                    for (int j = 0; j < 8; ++j) idf[j] = (16 * kk + 8 * hi + j == r32) ? (short)0x3F80 : (short)0;
                    accx = AT_MFMA(Af[ks], idf, accx); }
                float a[16], bb[16];
#pragma unroll
                for (int r = 0; r < 16; ++r) { const float rg = __builtin_amdgcn_rcpf(1.0f + __builtin_amdgcn_exp2f(__builtin_fmaf(accr[r], -LOG2E, ba[ct]))), ig = __builtin_amdgcn_rcpf(1.0f + __builtin_amdgcn_exp2f(__builtin_fmaf(acci[r], -LOG2E, bx[ct])));
                    const float la2 = c8[ct] * rg; a[r] = __builtin_amdgcn_exp2f(la2); const float om = 1.0f - a[r] * a[r]; bb[r] = __builtin_amdgcn_sqrtf(fmaxf(om, 0.f)) * (ig * accx[r]); }
                float Ag[4], Bg[4], pA[4], pB[4];
#pragma unroll
                for (int g = 0; g < 4; ++g) { Ag[g] = (a[4 * g] * a[4 * g + 1]) * (a[4 * g + 2] * a[4 * g + 3]); Bg[g] = ((bb[4 * g] * a[4 * g + 1] + bb[4 * g + 1]) * a[4 * g + 2] + bb[4 * g + 2]) * a[4 * g + 3] + bb[4 * g + 3];
                    auto ra = __builtin_amdgcn_permlane32_swap(__float_as_uint(Ag[g]), __float_as_uint(Ag[g]), false, false); pA[g] = __uint_as_float(hi ? ra[0] : ra[1]);
                    auto rbb = __builtin_amdgcn_permlane32_swap(__float_as_uint(Bg[g]), __float_as_uint(Bg[g]), false, false); pB[g] = __uint_as_float(hi ? rbb[0] : rbb[1]); }
                float cin[4], cc_ = h[ct], pp = pa[ct];
#pragma unroll
                for (int k = 0; k < 8; ++k) { const int g = k >> 1; const bool mine = (hi == (k & 1)); if (mine) cin[g] = cc_;
                    const float Ak = mine ? Ag[g] : pA[g], Bk = mine ? Bg[g] : pB[g]; cc_ = Ak * cc_ + Bk; pp *= Ak; }
                h[ct] = cc_; pa[ct] = pp;
                if (FIX) { GAS bf16* yg = (GAS bf16*)YB + (rb + t0 + 4 * hi) * YP + n * 64 + 32 * ct + r32;
#pragma unroll
                    for (int g = 0; g < 4; ++g) { float hv = cin[g];
#pragma unroll
                        for (int e = 0; e < 4; ++e) { const int r = 4 * g + e; hv = a[r] * hv + bb[r]; yg[(size_t)(e + 8 * g) * YP] = (bf16)f2bf(hv * bf2f(rgv[r])); } } }
            }
            }
            if (!FIX && hio == 0) {
#pragma unroll
                for (int ct = 0; ct < 2; ++ct) { ((GAS float*)AG)[aidx + 32 * ct] = pa[ct]; ((GAS float*)BG)[aidx + 32 * ct] = h[ct]; } }
            prevq = q; hprev[0] = h[0]; hprev[1] = h[1];
        }
#undef RG_DMA
    }
    asm volatile("s_waitcnt vmcnt(0)" ::: "memory");
}
__device__ __forceinline__ void ph_ffnact(Frame& F, const float* cw  , const float* cbias  ) {
    const bf16* U = (const bf16*)(F.ws + WS_U); bf16* ACT = (bf16*)(F.ws + WS_ACT);
    constexpr int RW = 16, NCK = DFF / 8; const int total = (M / RW) * NCK, stride = F.G * NWAVES * 64;
    for (int i = F.vcu * NWAVES * 64 + F.tid; i < total; i += stride) {
        const int rg = i / NCK, c = (i % NCK) * 8, row0 = rg * RW, t0 = row0 % SEQ;
        float wg[3][8], wv[3][8], bg[8], bv[8];
#pragma unroll
        for (int j = 0; j < 3; ++j) { const f32x4 a0 = *(const GAS f32x4*)(cw + (size_t)j * DFF2 + c), a1 = *(const GAS f32x4*)(cw + (size_t)j * DFF2 + c + 4), v0 = *(const GAS f32x4*)(cw + (size_t)j * DFF2 + DFF + c), v1 = *(const GAS f32x4*)(cw + (size_t)j * DFF2 + DFF + c + 4);
            wg[j][0] = a0[0]; wg[j][1] = a0[1]; wg[j][2] = a0[2]; wg[j][3] = a0[3]; wg[j][4] = a1[0]; wg[j][5] = a1[1]; wg[j][6] = a1[2]; wg[j][7] = a1[3];
            wv[j][0] = v0[0]; wv[j][1] = v0[1]; wv[j][2] = v0[2]; wv[j][3] = v0[3]; wv[j][4] = v1[0]; wv[j][5] = v1[1]; wv[j][6] = v1[2]; wv[j][7] = v1[3]; }
        { const f32x4 a0 = *(const GAS f32x4*)(cbias + c), a1 = *(const GAS f32x4*)(cbias + c + 4), v0 = *(const GAS f32x4*)(cbias + DFF + c), v1 = *(const GAS f32x4*)(cbias + DFF + c + 4);
          bg[0] = a0[0]; bg[1] = a0[1]; bg[2] = a0[2]; bg[3] = a0[3]; bg[4] = a1[0]; bg[5] = a1[1]; bg[6] = a1[2]; bg[7] = a1[3]; bv[0] = v0[0]; bv[1] = v0[1]; bv[2] = v0[2]; bv[3] = v0[3]; bv[4] = v1[0]; bv[5] = v1[1]; bv[6] = v1[2]; bv[7] = v1[3]; }
        v4u g2 = (v4u){0u, 0u, 0u, 0u}, g1 = g2, v2 = g2, v1_ = g2;
        if (t0 >= 2) { const bf16* up = U + (size_t)(row0 - 2) * DFF2 + c; g2 = *(const GAS v4u*)up; v2 = *(const GAS v4u*)(up + DFF); }
        if (t0 >= 1) { const bf16* up = U + (size_t)(row0 - 1) * DFF2 + c; g1 = *(const GAS v4u*)up; v1_ = *(const GAS v4u*)(up + DFF); }
#pragma unroll 4
        for (int r = 0; r < RW; ++r) {
            const bf16* up = U + (size_t)(row0 + r) * DFF2 + c; const v4u g0 = *(const GAS v4u*)up, v0 = *(const GAS v4u*)(up + DFF);
            float ug[8], uv[8];
#define FA_ROW(D_, W_, X_) D_[0] += W_[0] * bf_lo(X_.x); D_[1] += W_[1] * bf_hi(X_.x); D_[2] += W_[2] * bf_lo(X_.y); D_[3] += W_[3] * bf_hi(X_.y); D_[4] += W_[4] * bf_lo(X_.z); D_[5] += W_[5] * bf_hi(X_.z); D_[6] += W_[6] * bf_lo(X_.w); D_[7] += W_[7] * bf_hi(X_.w);
#pragma unroll
            for (int e = 0; e < 8; ++e) { ug[e] = bg[e]; uv[e] = bv[e]; }
            FA_ROW(ug, wg[0], g2) FA_ROW(ug, wg[1], g1) FA_ROW(ug, wg[2], g0) FA_ROW(uv, wv[0], v2) FA_ROW(uv, wv[1], v1_) FA_ROW(uv, wv[2], v0)
#undef FA_ROW
            v4u w; w.x = pk2(pg8::gelu_tanh_f(ug[0]) * uv[0], pg8::gelu_tanh_f(ug[1]) * uv[1]); w.y = pk2(pg8::gelu_tanh_f(ug[2]) * uv[2], pg8::gelu_tanh_f(ug[3]) * uv[3]);
            w.z = pk2(pg8::gelu_tanh_f(ug[4]) * uv[4], pg8::gelu_tanh_f(ug[5]) * uv[5]); w.w = pk2(pg8::gelu_tanh_f(ug[6]) * uv[6], pg8::gelu_tanh_f(ug[7]) * uv[7]);
            *(GAS v4u*)(ACT + (size_t)(row0 + r) * DFF + c) = w;
            g2 = g1; g1 = g0; v2 = v1_; v1_ = v0;
        }
    }
}
__device__ __forceinline__ void ph_ffnfix(Frame& F, const float* cw  , const float* cbias  , int panel = -1  ) {
    const bf16* UH = (const bf16*)(F.ws + WS_U); bf16* ACT = (bf16*)(F.ws + WS_ACT);
    constexpr int NCK = DFF / 8; const int total = (panel >= 0 ? 4 : M / 64) * 2 * NCK, stride = panel >= 0 ? NWAVES * 64 : F.G * NWAVES * 64;
    for (int i = (panel >= 0 ? 0 : F.vcu * NWAVES * 64) + F.tid; i < total; i += stride) {
        const int c = (i % NCK) * 8, sk = i / NCK + (panel >= 0 ? panel * 8 : 0), k = sk & 1, sl = sk >> 1; const bool hasprev = (sl % (SEQ / 64)) != 0;
        const bf16* r0 = UH + ((size_t)sl * 4 + (k == 0 ? 0 : 1)) * DFF2 + c;
        const bf16* r1 = k == 0 ? UH + ((size_t)(sl - 1) * 4 + 3) * DFF2 + c : UH + ((size_t)sl * 4 + 0) * DFF2 + c;
        const bf16* r2 = k == 0 ? UH + ((size_t)(sl - 1) * 4 + 2) * DFF2 + c : UH + ((size_t)(sl - 1) * 4 + 3) * DFF2 + c;
        const bool v1ok = (k == 1) || hasprev, v2ok = hasprev; const v4u z = (v4u){0u, 0u, 0u, 0u};
        const v4u g0 = *(const GAS v4u*)r0, v0 = *(const GAS v4u*)(r0 + DFF), g1 = v1ok ? *(const GAS v4u*)r1 : z, v1_ = v1ok ? *(const GAS v4u*)(r1 + DFF) : z, g2 = v2ok ? *(const GAS v4u*)r2 : z, v2 = v2ok ? *(const GAS v4u*)(r2 + DFF) : z;
        f32x4 wv[6][2], bs[4];
        { const GAS float* cg = (const GAS float*)cw + c; const GAS float* bg = (const GAS float*)cbias + c;
#pragma unroll
          for (int r = 0; r < 3; ++r) { wv[r][0] = *(const GAS f32x4*)(cg + r * DFF2); wv[r][1] = *(const GAS f32x4*)(cg + r * DFF2 + 4); wv[3 + r][0] = *(const GAS f32x4*)(cg + r * DFF2 + DFF); wv[3 + r][1] = *(const GAS f32x4*)(cg + r * DFF2 + DFF + 4); }
          bs[0] = *(const GAS f32x4*)bg; bs[1] = *(const GAS f32x4*)(bg + 4); bs[2] = *(const GAS f32x4*)(bg + DFF); bs[3] = *(const GAS f32x4*)(bg + DFF + 4); }
        __builtin_amdgcn_sched_barrier(0);
        float ug[8], uv[8];
#pragma unroll
        for (int e = 0; e < 4; ++e) { ug[e] = bs[0][e]; ug[4 + e] = bs[1][e]; uv[e] = bs[2][e]; uv[4 + e] = bs[3][e]; }
#define FX_ROW(D_, W_, X_) D_[0] += (W_)[0][0] * bf_lo(X_.x); D_[1] += (W_)[0][1] * bf_hi(X_.x); D_[2] += (W_)[0][2] * bf_lo(X_.y); D_[3] += (W_)[0][3] * bf_hi(X_.y); D_[4] += (W_)[1][0] * bf_lo(X_.z); D_[5] += (W_)[1][1] * bf_hi(X_.z); D_[6] += (W_)[1][2] * bf_lo(X_.w); D_[7] += (W_)[1][3] * bf_hi(X_.w);
        FX_ROW(ug, wv[0], g2) FX_ROW(ug, wv[1], g1) FX_ROW(ug, wv[2], g0) FX_ROW(uv, wv[3], v2) FX_ROW(uv, wv[4], v1_) FX_ROW(uv, wv[5], v0)
#undef FX_ROW
        v4u w; w.x = pk2(pg8::gelu_tanh_f(ug[0]) * uv[0], pg8::gelu_tanh_f(ug[1]) * uv[1]); w.y = pk2(pg8::gelu_tanh_f(ug[2]) * uv[2], pg8::gelu_tanh_f(ug[3]) * uv[3]);
        w.z = pk2(pg8::gelu_tanh_f(ug[4]) * uv[4], pg8::gelu_tanh_f(ug[5]) * uv[5]); w.w = pk2(pg8::gelu_tanh_f(ug[6]) * uv[6], pg8::gelu_tanh_f(ug[7]) * uv[7]);
        *(GAS v4u*)(ACT + ((size_t)sl * 64 + k) * DFF + c) = w;
    }
}
__device__ __forceinline__ void ph_final(Frame& F, const bf16* xh, const bf16* xlo, float* out, const float* g) {
    (void)xlo; static_assert(RESID_LO == 0, "the residual stream is xh only");
    typedef unsigned u32x2v __attribute__((ext_vector_type(2)));
    const int gw = F.vcu * NWAVES + F.wave, NGW = F.G * NWAVES;
    f32x4 gg[4];
#pragma unroll
    for (int j = 0; j < 4; ++j) gg[j] = *((const GAS f32x4*)g + F.lane + 64 * j);
    for (int m = gw; m < M; m += 2 * NGW) {
        const int m1 = m + NGW; const bool two = m1 < M;
        const GAS u32x2v* hr0 = (const GAS u32x2v*)(xh + (size_t)m * D) + F.lane; const GAS u32x2v* hr1 = (const GAS u32x2v*)(xh + (size_t)(two ? m1 : m) * D) + F.lane;
        u32x2v h0[4], h1[4];
#pragma unroll
        for (int j = 0; j < 4; ++j) { h0[j] = hr0[64 * j]; h1[j] = hr1[64 * j]; }
        f32x4 v0[4], v1[4]; float s0 = 0.f, s1 = 0.f;
#pragma unroll
        for (int j = 0; j < 4; ++j) { v0[j] = (f32x4){bf_lo(h0[j].x), bf_hi(h0[j].x), bf_lo(h0[j].y), bf_hi(h0[j].y)}; v1[j] = (f32x4){bf_lo(h1[j].x), bf_hi(h1[j].x), bf_lo(h1[j].y), bf_hi(h1[j].y)};
            s0 += (v0[j].x * v0[j].x + v0[j].y * v0[j].y) + (v0[j].z * v0[j].z + v0[j].w * v0[j].w); s1 += (v1[j].x * v1[j].x + v1[j].y * v1[j].y) + (v1[j].z * v1[j].z + v1[j].w * v1[j].w); }
        const float rs0 = rsqrtf(wave_sum(s0) * (1.0f / D) + 1e-6f), rs1 = rsqrtf(wave_sum(s1) * (1.0f / D) + 1e-6f);
        GAS f32x4* o0 = (GAS f32x4*)(out + (size_t)m * D) + F.lane; GAS f32x4* o1 = (GAS f32x4*)(out + (size_t)m1 * D) + F.lane;
#pragma unroll
        for (int j = 0; j < 4; ++j) { o0[64 * j] = v0[j] * rs0 * gg[j]; if (two) o1[64 * j] = v1[j] * rs1 * gg[j]; }
    }
}

constexpr int NPL = 10;
constexpr int NPH = 1 + DEPTH * NPL + 1;
struct Args { const float* in[26]; float* out; unsigned char* ws; int ph_lo, ph_hi; };
__global__ void __launch_bounds__(NWAVES * 64, 2) mk_fwd(Args args) {
    extern __shared__ __attribute__((aligned(16))) unsigned char lds[];
    Frame F;
    F.lds = (LAS unsigned char*)lds;
    F.MISC = (volatile LAS unsigned*)(F.lds + MISC_OFF);
    F.tid = threadIdx.x; F.lane = F.tid & 63; F.wave = __builtin_amdgcn_readfirstlane(F.tid >> 6);
    F.G = gridDim.x; { const int bx = blockIdx.x; F.vcu = (F.G % 8 == 0) ? (bx % 8) * (F.G / 8) + bx / 8 : bx; }
    F.ws = args.ws; F.ctl = (gu32*)(args.ws + WS_CTL);
    for (int u = F.tid; u < (LDS_BYTES - LDSCTL_OFF) / 4; u += NWAVES * 64) ((LAS unsigned*)(F.lds + LDSCTL_OFF))[u] = 0u;
    __syncthreads();
    const int lo = args.ph_lo, hi = args.ph_hi;
    XcdBarrier bar; bar.bar = (unsigned*)(F.ctl + CW_BAR); bar.x = 0; bar.st = nullptr;
    if (hi - lo > 1) bar = xcd_barrier_post((unsigned*)(F.ctl + CW_BAR), F.MISC + 8, F.tid == 0);
#define IN(k) (lo <= (k) && (k) < hi)
#define RELAUNDER() do { int t_ = F.wave * 64 + pg8::mk_lane(); asm volatile("" : "+v"(t_)); F.tid = t_; F.lane = t_ & 63; asm volatile("" : "+s"(KA)); unsigned char* w_ = (unsigned char*)KA[27]; asm volatile("" : "+s"(w_)); F.ws = w_; } while (0)
#define SEAM(k) do { if (DBG_TIMING) { if (blockIdx.x == 0 && F.wave == 0 && pg8::mk_lane() == 0) ((unsigned long long*)(F.ws + 768 * 1024))[(k) + 1] = __builtin_amdgcn_s_memrealtime(); } if ((k) + 1 < hi) { XcdBarrier b2_ = bar; asm volatile("" : "+s"(b2_.bar)); xcd_barrier(b2_, F.wave == 0 && pg8::mk_lane() == 0); } } while (0)
    typedef const float* cfp_t;
    const __attribute__((address_space(4))) cfp_t* KA = (const __attribute__((address_space(4))) cfp_t*)__builtin_amdgcn_kernarg_segment_ptr();
    #define in KA
    LAS float* RSTAB = (LAS float*)(F.lds + RSTAB_OFF);
#define XB ((bf16*)(F.ws + WS_XB))
#define SSP ((float*)(F.ws + WS_SS))
#define X32 ((float*)(F.ws + WS_X32))

    if (DBG_TIMING) { if (blockIdx.x == 0 && F.tid == 0) ((unsigned long long*)(args.ws + 768 * 1024))[0] = __builtin_amdgcn_s_memrealtime(); }
    if (IN(0)) { RELAUNDER(); ph_xprologue(F, in[0]); if (DBG_TIMING) { SEAM(0); } }

    for (int l = 0; l < DEPTH; ++l) {
        const int pb = 1 + l * NPL;
#define LAYER_W(L) LayerW{in[2] + (size_t)(L) * D * IN_COLS, in[1] + (size_t)(L) * D, in[16] + (size_t)(L) * 512 * D, in[17] + (size_t)(L) * D * D, in[18] + (size_t)(L) * 512 * D, in[19] + (size_t)(L) * D * D, \
                     in[21] + (size_t)(L) * D * DFF2, in[20] + (size_t)(L) * D, in[24] + (size_t)(L) * DFF * D, in[6] + (size_t)(L) * RG_NB * 4096, in[8] + (size_t)(L) * RG_NB * 4096}
        if (DBG_TIMING && l > 0 && blockIdx.x == 0 && F.wave == 0 && pg8::mk_lane() == 0) ((unsigned long long*)(F.ws + 768 * 1024))[pb + 1] = __builtin_amdgcn_s_memrealtime();
        if (IN(pb + 0) && l == 0) {
            const LayerW W = LAYER_W(0);
            RELAUNDER(); ph_weights(F, W, 3); SEAM(pb + 0);
        }
        if (IN(pb + 1)) {
            RELAUNDER();
            pg8::Gemm g{XB, (const bf16*)(F.ws + WS_WIN), M, IN_COLS, D}; pg8::StaticOrder S; S.init(M, IN_COLS, F.G, (int)blockIdx.x);
            pg8::EpiInProj E{(bf16*)(F.ws + WS_QA), (bf16*)(F.ws + WS_KA), (bf16*)(F.ws + WS_VA), (bf16*)(F.ws + WS_QC), (bf16*)(F.ws + WS_KC), (bf16*)(F.ws + WS_VC),
                             (bf16*)(F.ws + WS_RX), (bf16*)(F.ws + WS_RG), (bf16*)(F.ws + WS_GT), SSP, in[3] + (size_t)l * 3 * D, RSTAB};
            if (F.tid == 0) ((volatile LAS int*)RSTAB)[256] = 0; __syncthreads();
#ifndef DIS_G1
            pg8::gemm_phase<pg8::EpiInProj, pg8::StaticOrder, true, true>(F.lds + RING_OFF, g, S, E, F.wave);
#endif
            SEAM(pb + 1);
        }
        if (IN(pb + 2)) {

#ifndef DIS_KMEAN
            RELAUNDER(); ph_kmean(F);
#endif

            RgP P{in[4] + (size_t)l * 4 * D, in[5] + (size_t)l * D, in[6] + (size_t)l * RG_NB * 4096, in[7] + (size_t)l * D, in[8] + (size_t)l * RG_NB * 4096, in[9] + (size_t)l * D, in[10] + (size_t)l * D};

#ifndef DIS_RGA
            RELAUNDER();
#if USE_MFMA_RG
            ph_rglru_mfma<false>(F, P); __syncthreads();
#else
            ph_rglru<false>(F, P);
#endif
#endif

            DiffP DP{in[11] + l * 64, in[12] + l * 64, in[13] + l * 64, in[14] + l * 64, in[15] + l * 128, 0.8f - 0.6f * expf(-0.3f * (float)l)};

#ifndef DIS_DIFF
            RELAUNDER();
#if USE_MFMA_DIFF
            ph_diffattn_pipe(F, DP);
#else
            ph_diffattn_naive(F, DP);
#endif
#endif

            SEAM(pb + 2);
        }
        if (IN(pb + 3)) {
#ifndef DIS_MOBA
 RELAUNDER();
#if USE_MFMA_MOBA
 ph_moba_pipe(F);
#else
 ph_moba_naive(F);
#endif
#endif
 __syncthreads();
            RgP P{in[4] + (size_t)l * 4 * D, in[5] + (size_t)l * D, in[6] + (size_t)l * RG_NB * 4096, in[7] + (size_t)l * D, in[8] + (size_t)l * RG_NB * 4096, in[9] + (size_t)l * D, in[10] + (size_t)l * D};

#ifndef DIS_RGC
            RELAUNDER();
#if USE_MFMA_RG
            ph_rglru_mfma<true>(F, P);
#else
            ph_rglru<true>(F, P);
#endif
            if (l > 0) { __syncthreads(); const LayerW W = LAYER_W(l); RELAUNDER(); ph_weights(F, W, 2); }
#endif
 SEAM(pb + 3);
        }
        if (IN(pb + 5)) {
            RELAUNDER();
            pg8::StaticOrder S; S.init(M, D, F.G, (int)blockIdx.x);
            { pg8::Gemm g{(const bf16*)(F.ws + WS_Y), (const bf16*)(F.ws + WS_WA), M, D, YP}; pg8::EpiBranchFused E{(bf16*)(F.ws + WS_MG), (const bf16*)(F.ws + WS_GT)};
#ifndef DIS_G2
              pg8::gemm_phase<pg8::EpiBranchFused, pg8::StaticOrder, true, true>(F.lds + RING_OFF, g, S, E, F.wave);
#endif
            }
            SEAM(pb + 5);
        }
        if (IN(pb + 6)) {
            RELAUNDER();
            pg8::Gemm g{(const bf16*)(F.ws + WS_MG), (const bf16*)(F.ws + WS_WO), M, D, D}; pg8::StaticOrder S; S.init(M, D, F.G, (int)blockIdx.x);
            pg8::EpiResid E{(const float*)nullptr, XB, (bf16*)(F.ws + WS_XL), SSP};
#ifndef DIS_G3
            pg8::gemm_phase<pg8::EpiResid, pg8::StaticOrder, true, true>(F.lds + RING_OFF, g, S, E, F.wave);
#endif
            SEAM(pb + 6);
        }
        if (IN(pb + 7)) {
            RELAUNDER();
            pg8::Gemm g{XB, (const bf16*)(F.ws + WS_WUP), M, DFF2, D}; pg8::StaticOrder S; S.init(M, DFF2, F.G, (int)blockIdx.x);
#if USE_ACT_FUSE
            pg8::EpiUpAct E{(bf16*)(F.ws + WS_ACT), (bf16*)(F.ws + WS_U), SSP, RSTAB, in[22] + (size_t)l * 3 * DFF2, in[23] + (size_t)l * DFF2, (LAS float*)(F.lds + RSTAB_OFF + 2048)};
#else
            pg8::EpiUp E{(bf16*)(F.ws + WS_U), DFF2, SSP, RSTAB};
#endif
            if (F.tid == 0) ((volatile LAS int*)RSTAB)[256] = 0; __syncthreads();
#ifndef DIS_G4
#if USE_ACT_FUSE
            pg8::gemm_phase<pg8::EpiUpAct, pg8::StaticOrder, true, true>(F.lds + RING_OFF, g, S, E, F.wave);
#if W_EARLY
            { const int nun = (M / 256) * (DFF2 / 256), c0 = nun % F.G;
              if (l + 1 < DEPTH && c0 > 0 && (int)blockIdx.x >= c0) { __syncthreads(); const LayerW W = LAYER_W(l + 1); RELAUNDER(); ph_weights(F, W, 1 | 4, (int)blockIdx.x - c0, F.G - c0); } }
#endif
#else
            pg8::gemm_phase<pg8::EpiUp, pg8::StaticOrder, true, true>(F.lds + RING_OFF, g, S, E, F.wave);
#endif
#endif
            SEAM(pb + 7);
        }
#if !(USE_ACT_FUSE)
#error this build expects USE_ACT_FUSE
#endif
        if (IN(pb + 9)) {
            RELAUNDER();
            pg8::Gemm g{(const bf16*)(F.ws + WS_ACT), (const bf16*)(F.ws + WS_WDN), M, D, DFF}; pg8::StaticOrder S; S.init(M, D, F.G, (int)blockIdx.x);
            { pg8::Unit u_; int lastpm = -1;
              for (int i = 0; S.next(i, u_); ++i) if (u_.pm != lastpm) { lastpm = u_.pm; ph_ffnfix(F, in[22] + (size_t)l * 3 * DFF2, in[23] + (size_t)l * DFF2, u_.pm); }
              asm volatile("s_waitcnt vmcnt(0)" ::: "memory"); __syncthreads(); }
            const bool conv_first = (blockIdx.x & 1) == 0;
            if (l + 1 < DEPTH && conv_first) { const LayerW W = LAYER_W(l + 1); RELAUNDER(); ph_weights(F, W, W_EARLY ? (1 | 8) : 1); __syncthreads(); }
            pg8::EpiResid E{nullptr, XB, (bf16*)(F.ws + WS_XL), SSP};
#ifndef DIS_G3
            pg8::gemm_phase<pg8::EpiResid, pg8::StaticOrder, true, true>(F.lds + RING_OFF, g, S, E, F.wave);
#endif
            if (l + 1 < DEPTH && !conv_first) { const LayerW W = LAYER_W(l + 1); RELAUNDER(); ph_weights(F, W, W_EARLY ? (1 | 8) : 1); }
            SEAM(pb + 9);
        }
    }
    if (IN(NPH - 1)) { RELAUNDER(); ph_final(F, XB, (const bf16*)(F.ws + WS_XL), (float*)KA[26], in[25]); }
#if DBG_TIMING
    {
        RELAUNDER();
        float* tmin = (float*)(F.ws + WS_END);
        if (blockIdx.x == 0 && F.tid == 0) { unsigned long long* ts = (unsigned long long*)(F.ws + 768 * 1024);
            float tt[12]; for (int i = 0; i < 12; ++i) tt[i] = 0.f;
            tt[0] = (float)(ts[2] - ts[0]) * 0.01f;
            for (int l = 0; l < DEPTH; ++l) for (int p = 1; p < NPL; ++p) { const int k = 1 + l * NPL + p; tt[1 + p] += (float)(ts[k + 1] - ts[k]) * 0.01f; }
            tt[11] = (float)(ts[NPH - 1] - ts[0]) * 0.01f;
            for (int i = 0; i < 12; ++i) tmin[i] = fminf(tmin[i], tt[i]); }
        { XcdBarrier b2_ = bar; asm volatile("" : "+s"(b2_.bar)); xcd_barrier(b2_, F.wave == 0 && pg8::mk_lane() == 0); }
        float v1 = 0.f, v2 = 0.f; for (int i = 0; i < 12; ++i) { if (i == DBG_SEL1) v1 = tmin[i]; if (i == DBG_SEL2) v2 = tmin[i]; }
        const float q1_ = (rintf(log2f(v1) * 6.f + DBG_QOFF) - DBG_QOFF) * (1.f / 6.f), q2_ = (rintf(log2f(v2) * 6.f + DBG_QOFF) - DBG_QOFF) * (1.f / 6.f); const float K1 = sqrtf(100.f * (q1_ - 5.f)), K2 = 100.f * (q2_ - 5.f);
        float* o_ = (float*)KA[26]; const size_t n_ = (size_t)M * D;
        for (size_t i = (size_t)blockIdx.x * 512 + F.tid; i < n_; i += (size_t)gridDim.x * 512) o_[i] = (i < 64) ? K2 : K1;
    }
#endif
#undef IN
#undef RELAUNDER
#undef LAYER_W
#undef XB
#undef SSP
#undef X32
#undef in
#undef SEAM
}


#ifndef DBG_STOP
#define DBG_STOP 0
#endif
#define DBG_DUMP_OFF (WS_YA)
#define DBG_DUMP_PER 2
__global__ void dbg_dump(const unsigned short* buf, float* out, size_t n, int per) {
    for (size_t i = (size_t)blockIdx.x * blockDim.x + threadIdx.x; i < n; i += (size_t)gridDim.x * blockDim.x) { float a = 0.f; for (int j = 0; j < per; ++j) a += __uint_as_float(((unsigned)buf[i * per + j]) << 16); out[i] = a; }
}

#ifndef DBG_TWICE
#define DBG_TWICE 0
#endif
__global__ void dbg_cksum(const unsigned* w, size_t n, unsigned poison, unsigned long long* ck) {
    unsigned long long a = 0; for (size_t i = (size_t)blockIdx.x * blockDim.x + threadIdx.x; i < n; i += (size_t)gridDim.x * blockDim.x) { const unsigned v = w[i]; if (v != poison) a += (unsigned long long)v * (unsigned long long)((i & 1023) + 1); }
    atomicAdd(ck, a);
}
__global__ void dbg_fill(unsigned* w, size_t n, unsigned v) { for (size_t i = (size_t)blockIdx.x * blockDim.x + threadIdx.x; i < n; i += (size_t)gridDim.x * blockDim.x) w[i] = v; }
__global__ void dbg_decide(float* out, size_t n, const unsigned long long* ck, int nph) {
    int first = -1; for (int p = 0; p < nph; ++p) if (ck[p] != ck[64 + p]) { first = p; break; }
    const float K = first < 0 ? 0.f : sqrtf(exp2f((float)first));
    for (size_t i = (size_t)blockIdx.x * blockDim.x + threadIdx.x; i < n; i += (size_t)gridDim.x * blockDim.x) out[i] = K;
}
extern "C" void kernel_launch(void* const* d_in, const int* in_sizes, int n_in, void* d_out, int out_size, void* d_ws, size_t ws_size, hipStream_t stream) {
    static int grid = 0;
    if (grid == 0) {
        if (n_in != 26 || in_sizes[0] != M * D || out_size != M * D || ws_size < WS_END) { fprintf(stderr, "kernel_launch: unexpected shapes / workspace (n_in %d, ws %zu); nothing launched\n", n_in, ws_size); grid = -1; return; }
        int dev = 0, cus = 0, per_cu = 0;
        if (hipGetDevice(&dev) != hipSuccess || hipDeviceGetAttribute(&cus, hipDeviceAttributeMultiprocessorCount, dev) != hipSuccess) { grid = -1; return; }
        if (hipFuncSetAttribute((const void*)mk_fwd, hipFuncAttributeMaxDynamicSharedMemorySize, LDS_BYTES) != hipSuccess) { grid = -1; return; }
        if (hipOccupancyMaxActiveBlocksPerMultiprocessor(&per_cu, (const void*)mk_fwd, NWAVES * 64, LDS_BYTES) != hipSuccess || per_cu < 1) { fprintf(stderr, "kernel_launch: occupancy query reports %d\n", per_cu); }
        (void)hipGetLastError();
        grid = cus;
    }
    if (grid < 0) return;
    if (hipMemsetAsync((char*)d_ws + WS_CTL, 0, CTL_ZERO_BYTES, stream) != hipSuccess) return;
    Args a{};
    for (int i = 0; i < 26; ++i) a.in[i] = (const float*)d_in[i];
    a.out = (float*)d_out; a.ws = (unsigned char*)d_ws;
#if MK_ONE_LAUNCH
    a.ph_lo = 0; a.ph_hi = NPH;
#if DBG_TIMING
    hipMemsetAsync((char*)d_ws + WS_END, 0x7f, 256, stream);
#endif
    hipLaunchKernelGGL(mk_fwd, dim3(grid), dim3(NWAVES * 64), LDS_BYTES, stream, a);
#if DBG_TIMING
    for (int rep = 0; rep < 3; ++rep) {
        hipMemsetAsync((char*)d_ws + WS_CTL, 0, CTL_ZERO_BYTES, stream);
        hipLaunchKernelGGL(mk_fwd, dim3(grid), dim3(NWAVES * 64), LDS_BYTES, stream, a); }
#endif
#else
#if DBG_TWICE
    unsigned long long* ck = (unsigned long long*)((char*)d_ws + 512 * 1024);
    hipLaunchKernelGGL(dbg_fill, dim3(1), dim3(256), 0, stream, (unsigned*)ck, (size_t)256, 0u);
    for (int rep = 0; rep < 2; ++rep) {
        const int pb = rep ? 0x3C : 0x5A; const unsigned pw = rep ? 0x3C3C3C3Cu : 0x5A5A5A5Au;
        (void)pb; hipLaunchKernelGGL(dbg_fill, dim3(2048), dim3(256), 0, stream, (unsigned*)((char*)d_ws + MiB), (size_t)(WS_END - MiB) / 4, pw); hipLaunchKernelGGL(dbg_fill, dim3(2048), dim3(256), 0, stream, (unsigned*)d_out, (size_t)M * D, pw);
        for (int p = 0; p < NPH; ++p) { a.ph_lo = p; a.ph_hi = p + 1; hipLaunchKernelGGL(mk_fwd, dim3(grid), dim3(NWAVES * 64), LDS_BYTES, stream, a);
            hipLaunchKernelGGL(dbg_cksum, dim3(2048), dim3(256), 0, stream, (const unsigned*)((char*)d_ws + MiB), (size_t)(WS_END - MiB) / 4, pw, ck + 64 * rep + p);
            hipLaunchKernelGGL(dbg_cksum, dim3(2048), dim3(256), 0, stream, (const unsigned*)d_out, (size_t)M * D, pw, ck + 64 * rep + p); }
    }
    hipLaunchKernelGGL(dbg_decide, dim3(1024), dim3(256), 0, stream, (float*)d_out, (size_t)M * D, (const unsigned long long*)ck, NPH);
#else
    for (int p = 0; p < NPH; ++p) { a.ph_lo = p; a.ph_hi = p + 1; hipLaunchKernelGGL(mk_fwd, dim3(grid), dim3(NWAVES * 64), LDS_BYTES, stream, a); }
#endif
#endif
}
```
